# Optimizing an MI355X kernel written in HIP

```python
import math
import jax
import jax.numpy as jnp
from jax import lax
import numpy as np

D_MODEL = 2048
BATCH = 2
SEQ = 4096
DEPTH = 2

CHUNK = 64
D_RNN = D_MODEL
LRU_HEADS = 8
LRU_BLOCK = D_RNN // LRU_HEADS
LRU_C = 8.0
CONV_W = 4
D_POOL = D_MODEL // 2
POOL_WINDOWS = (2, 4, 8, 16)
POOL_GROUPS = len(POOL_WINDOWS)
POOL_GW = D_POOL // POOL_GROUPS
N_BRANCH = 2
D_IN = 2 * D_RNN + D_POOL + N_BRANCH * D_MODEL
D_FF = 5632
FFN_CONV_W = 3
N_ADA = 6
EPS = 1e-6

kernel_name = "hybrid_rglru_pool_streaming_trunk"


def rms_norm(x, g):
    xf = x.astype(jnp.float32)
    y = xf * lax.rsqrt(jnp.mean(xf * xf, axis=-1, keepdims=True) + EPS)
    return (y * g.astype(jnp.float32)).astype(x.dtype)


def causal_dwconv(x, w, b):
    k_w = w.shape[0]
    s = x.shape[1]
    xp = jnp.pad(x, ((0, 0), (k_w - 1, 0), (0, 0)))
    y = b
    for k in range(k_w):
        y = y + xp[:, k:k + s] * w[k]
    return y


def _lru_combine(left, right):
    a1, b1 = left
    a2, b2 = right
    return a1 * a2, a2 * b1 + b2


def rg_lru(x, wa, ba, wx, bx, lam):
    bsz, s, _ = x.shape
    xh = x.reshape(bsz, s, LRU_HEADS, LRU_BLOCK)
    r = jax.nn.sigmoid((jnp.einsum('bshi,hij->bshj', xh, wa).reshape(bsz, s, D_RNN) + ba).astype(jnp.float32))
    i = jax.nn.sigmoid((jnp.einsum('bshi,hij->bshj', xh, wx).reshape(bsz, s, D_RNN) + bx).astype(jnp.float32))
    log_a = LRU_C * r * jax.nn.log_sigmoid(lam.astype(jnp.float32))
    a = jnp.exp(log_a)
    inp = jnp.sqrt(-jnp.expm1(2.0 * log_a)) * (i * x.astype(jnp.float32))
    _, h = lax.associative_scan(_lru_combine, (a, inp), axis=1)
    return h.astype(x.dtype)


def multiscale_pool(x, w, b, scale):
    bsz, s, _ = x.shape
    xg = x.reshape(bsz, s, POOL_GROUPS, POOL_GW).astype(jnp.float32)
    pos = jnp.arange(s, dtype=jnp.float32)
    pooled = []
    for g, win in enumerate(POOL_WINDOWS):
        xi = xg[:, :, g]
        cs0 = jnp.pad(jnp.cumsum(xi, axis=1), ((0, 0), (1, 0), (0, 0)))
        upper = cs0[:, 1:]
        lower = jnp.pad(cs0[:, :s + 1 - win], ((0, 0), (win - 1, 0), (0, 0)))
        count = jnp.minimum(pos + 1.0, float(win))[None, :, None]
        pooled.append((upper - lower) / count - xi)
    p = jnp.stack(pooled, axis=2).astype(x.dtype)
    y = jnp.einsum('bsgc,gcd->bsgd', p, w).reshape(bsz, s, D_POOL) + b
    return y * scale


def setup_inputs(seed: int = 0) -> dict:
    key = jax.random.key(seed)
    ks = jax.random.split(key, 32)
    L, D = DEPTH, D_MODEL
    f32 = jnp.float32

    def nrm(k, shape, fan_in, mult=1.0):
        return jax.random.normal(k, shape, f32) * (mult * fan_in ** -0.5)

    def small(k, shape, s=0.02):
        return jax.random.normal(k, shape, f32) * s

    u = jax.random.uniform(ks[10], (L, D_RNN), f32, 0.9, 0.999)
    sig = u ** (1.0 / LRU_C)
    lam = jnp.log(sig) - jnp.log1p(-sig)

    return {
        "x": jax.random.normal(ks[0], (BATCH, SEQ, D), f32),
        "c": jax.random.normal(ks[1], (BATCH, D), f32),
        "ada_w": nrm(ks[2], (L, D, N_ADA * D), D, 0.5),
        "ada_b": small(ks[3], (L, N_ADA * D)),
        "norm_mix_g": 1.0 + small(ks[4], (L, D)),
        "w_in": nrm(ks[5], (L, D, D_IN), D),
        "b_in": small(ks[6], (L, D_IN)),
        "conv_w": nrm(ks[7], (L, CONV_W, D_RNN), CONV_W),
        "conv_b": small(ks[8], (L, D_RNN)),
        "lru_wa": nrm(ks[9], (L, LRU_HEADS, LRU_BLOCK, LRU_BLOCK), LRU_BLOCK),
        "lru_ba": small(ks[11], (L, D_RNN)),
        "lru_wx": nrm(ks[12], (L, LRU_HEADS, LRU_BLOCK, LRU_BLOCK), LRU_BLOCK),
        "lru_bx": small(ks[13], (L, D_RNN)),
        "lru_lambda": lam,
        "pool_w": nrm(ks[14], (L, POOL_GROUPS, POOL_GW, POOL_GW), POOL_GW),
        "pool_b": small(ks[15], (L, D_POOL)),
        "pool_scale": 1.0 + small(ks[16], (L, D_POOL), 0.1),
        "proj_a": nrm(ks[17], (L, D_RNN, D), D_RNN),
        "proj_b": nrm(ks[18], (L, D_POOL, D), D_POOL),
        "w_out": nrm(ks[19], (L, D, D), D),
        "norm_ffn_g": 1.0 + small(ks[20], (L, D)),
        "w_up": nrm(ks[21], (L, D, 2 * D_FF), D),
        "ffn_conv_w": nrm(ks[22], (L, FFN_CONV_W, 2 * D_FF), FFN_CONV_W),
        "ffn_conv_b": small(ks[23], (L, 2 * D_FF)),
        "w_down": nrm(ks[24], (L, D_FF, D), D_FF),
        "final_g": 1.0 + small(ks[25], (D,)),
    }


def reference(x, c, ada_w, ada_b, norm_mix_g, w_in, b_in, conv_w, conv_b,
              lru_wa, lru_ba, lru_wx, lru_bx, lru_lambda, pool_w, pool_b,
              pool_scale, proj_a, proj_b, w_out, norm_ffn_g, w_up, ffn_conv_w,
              ffn_conv_b, w_down, final_g):
    c_act = jax.nn.silu(c)
    for l in range(DEPTH):
        mod = c_act @ ada_w[l] + ada_b[l]
        sh1, sc1, gt1, sh2, sc2, gt2 = [m[:, None, :] for m in jnp.split(mod, N_ADA, axis=-1)]

        h = rms_norm(x, norm_mix_g[l]) * (1.0 + sc1) + sh1
        z = h @ w_in[l] + b_in[l]
        x_rnn, g_rnn, x_pool, g_br = jnp.split(
            z, [D_RNN, 2 * D_RNN, 2 * D_RNN + D_POOL], axis=-1)
        xr = causal_dwconv(x_rnn, conv_w[l], conv_b[l])
        ya = rg_lru(xr, lru_wa[l], lru_ba[l], lru_wx[l], lru_bx[l], lru_lambda[l])
        ya = ya * jax.nn.gelu(g_rnn)
        yb = multiscale_pool(x_pool, pool_w[l], pool_b[l], pool_scale[l])
        gate_a, gate_b = jnp.split(jax.nn.sigmoid(g_br), N_BRANCH, axis=-1)
        merged = gate_a * (ya @ proj_a[l]) + gate_b * (yb @ proj_b[l])
        x = x + gt1 * (merged @ w_out[l])

        h = rms_norm(x, norm_ffn_g[l]) * (1.0 + sc2) + sh2
        up = causal_dwconv(h @ w_up[l], ffn_conv_w[l], ffn_conv_b[l])
        u_act, u_lin = jnp.split(up, 2, axis=-1)
        x = x + gt2 * ((jax.nn.silu(u_act) * u_lin) @ w_down[l])

    return rms_norm(x, final_g)
```

```cpp
#include <hip/hip_runtime.h>
#include <cstdio>
#include <cstdint>

#ifndef PROBE_PH
#define PROBE_PH -1
#endif
#ifndef P1_GEMM_WGS
#define P1_GEMM_WGS 232
#endif
#ifndef P5_GEMM_WGS
#define P5_GEMM_WGS 240
#endif
#ifndef MK_ONE_LAUNCH
#define MK_ONE_LAUNCH 1
#endif

#define GAS __attribute__((address_space(1)))
#define LAS __attribute__((address_space(3)))
typedef unsigned short bf16_t;
typedef short bf16x8 __attribute__((ext_vector_type(8)));
typedef float f32x4 __attribute__((ext_vector_type(4)));
typedef float f32x2 __attribute__((ext_vector_type(2)));
typedef unsigned u32x4 __attribute__((ext_vector_type(4)));
typedef unsigned u32x2 __attribute__((ext_vector_type(2)));

constexpr int NB = 2, SEQ = 4096, DM = 2048, M = NB * SEQ, DRNN = 2048, DPOOL = 1024, DIN = 9216, DFF = 5632, DUP = 11264, NADA = 12288, NL = 2;
constexpr float EPS = 1e-6f;
constexpr int NWAVES = 8;
constexpr int LDS_BYTES = 147456;
constexpr int RING_BYTES = 131072;
constexpr int MISC_OFF = RING_BYTES + 320;

constexpr size_t MiB = 1u << 20;
constexpr size_t WS_CTL = 0, CTL_ZERO_BYTES = 4 * MiB;
constexpr size_t WS_MOD = 1 * MiB;
constexpr size_t WS_GM1 = WS_MOD + (size_t)NL * NB * NADA * 4;
constexpr size_t WS_GT1 = WS_GM1 + (size_t)NL * NB * DM * 4;
constexpr size_t WS_GM2 = WS_GT1 + (size_t)NL * NB * DM * 4;
constexpr size_t WS_GT2 = WS_GM2 + (size_t)NL * NB * DM * 4;
constexpr size_t WS_LRUK = WS_GT2 + (size_t)NL * NB * DM * 4;
constexpr size_t WS_BIAS1 = WS_LRUK + (size_t)NL * DRNN * 4;
constexpr size_t WS_BIAS2 = WS_BIAS1 + (size_t)NL * NB * DIN * 4;
constexpr size_t WS_SS = WS_BIAS2 + (size_t)NL * NB * DUP * 4;
static_assert(WS_SS + 8 * (size_t)M * 4 <= 2 * MiB, "small region");
constexpr size_t WS_AGG = 2 * MiB;
constexpr size_t WS_FSS = 3 * MiB;
constexpr size_t WS_W = 4 * MiB;
constexpr size_t W_BT1 = 0, W_BTG = 36 * MiB, W_BTP = 38 * MiB, W_BT3 = 39 * MiB, W_BT4 = 51 * MiB, W_BT5 = 59 * MiB, W_BT6 = 103 * MiB, W_LAYER = 125 * MiB;
static_assert((size_t)DIN * DM * 2 == 36 * MiB && (size_t)DUP * DM * 2 == 44 * MiB && (size_t)DM * DFF * 2 == 22 * MiB, "weight sizes");
constexpr size_t WS_X = WS_W + 2 * W_LAYER;
constexpr size_t WS_PB1 = WS_X;
constexpr size_t WS_PB2 = WS_X + 16 * MiB;
static_assert((size_t)NL * NB * 32 * DIN * 4 <= 16 * MiB && (size_t)NL * NB * 32 * DUP * 4 <= 16 * MiB, "partial bias rows");
constexpr size_t WS_XG = WS_X + 64 * MiB;
constexpr size_t WS_XRNN = WS_XG + 32 * MiB;
constexpr size_t WS_GG = WS_XRNN + 32 * MiB;
constexpr size_t WS_XPOOL = WS_GG + 32 * MiB;
constexpr size_t WS_RATIO = WS_XPOOL + 16 * MiB;
constexpr size_t WS_GB = WS_RATIO + 32 * MiB;
constexpr size_t WS_XR = WS_GB + 32 * MiB;
constexpr size_t WS_MERGED = WS_XR;
constexpr size_t WS_PP = WS_XR + 32 * MiB;
constexpr size_t WS_YAB = WS_PP + 16 * MiB;
constexpr size_t WS_AA = WS_YAB + 48 * MiB;
constexpr size_t WS_BB = WS_AA + 64 * MiB;
constexpr size_t WS_ACT = WS_AA;
constexpr size_t WS_UH = WS_ACT + 88 * MiB;
constexpr size_t WS_END = WS_BB + 64 * MiB;
static_assert(WS_UH + (size_t)128 * 4 * DUP * 4 <= WS_END, "ws map");
constexpr int CW_BAR = 4096;
constexpr int CW_CVT = 8192;

__device__ __forceinline__ unsigned cvt_pk_bf16(float lo, float hi) { unsigned r; asm("v_cvt_pk_bf16_f32 %0, %1, %2" : "=v"(r) : "v"(lo), "v"(hi)); return r; }
__device__ __forceinline__ float bf_lo(unsigned w) { return __uint_as_float(w << 16); }
__device__ __forceinline__ float bf_hi(unsigned w) { return __uint_as_float(w & 0xffff0000u); }
__device__ __forceinline__ float bf1(bf16_t h) { return __uint_as_float((unsigned)h << 16); }
__device__ __forceinline__ float fexp2(float x) { return __builtin_amdgcn_exp2f(x); }
__device__ __forceinline__ float frcp(float x) { return __builtin_amdgcn_rcpf(x); }
__device__ __forceinline__ float sigmoid_f(float x) { return frcp(1.f + fexp2(-1.4426950409f * x)); }
__device__ __forceinline__ float gelu_tanh_f(float x) { const float t = x + 0.044715f * x * x * x; return x * frcp(1.f + fexp2(-2.3022082f * t)); }
__device__ __forceinline__ float wave_sum(float v) {
#pragma unroll
    for (int o = 1; o < 64; o <<= 1) v += __shfl_xor(v, o);
    return v;
}
template <int CTRL> __device__ __forceinline__ float dpp0(float x) { return __builtin_bit_cast(float, __builtin_amdgcn_update_dpp(0, __builtin_bit_cast(int, x), CTRL, 0xf, 0xf, true)); }

namespace pg8 {
constexpr int BM = 256, BK = 64, HALF = 128, HTB = HALF * BK * 2, STAGE_BYTES = 8 * HTB, NXCD = 8, WGM = 4;
__host__ __device__ __forceinline__ int lds_byte(int r, int c) { const int st = (r >> 4) * 2 + (c >> 5), rr = r & 15, cc = c & 31, ob = rr * 64 + cc * 2; return st * 1024 + (ob ^ (((ob >> 9) & 1) << 5)); }
__host__ __device__ __forceinline__ void stage_rc(int b, int& R, int& C) { const int st = b / 1024, sb = b % 1024, swz = sb ^ (((sb >> 9) & 1) << 5); R = (st >> 1) * 16 + swz / 64; C = (st & 1) * 32 + (swz % 64) / 2; }
__host__ __device__ __forceinline__ int perm32(int rho) { const int n = rho >> 4, i = rho & 15; return 8 * (i >> 2) + 4 * n + (i & 3); }

struct Unit { int pm, pn; };
struct Gemm { const bf16_t* A; const bf16_t* Bt; int lda, ldb, nt, nM, nN, a_sh, a_mul; };

struct StaticOrder {
    int nM, nN, nwg, G, c;
    __device__ void init(int nM_, int nN_, int G_, int c_) { nM = nM_; nN = nN_; nwg = nM * nN; G = G_; c = c_; }
    __device__ bool next(int i, Unit& u) const {
        const long L = (long)i * G + c; if (L >= nwg) return false;
        int wgid = (int)L; { const int q = nwg / NXCD, r = nwg % NXCD, xcd = wgid % NXCD, off = wgid / NXCD; wgid = (xcd < r ? xcd * (q + 1) : r * (q + 1) + (xcd - r) * q) + off; }
        const int nig = WGM * nN, gid = wgid / nig, fm = gid * WGM, gsz = (nM - fm) < WGM ? (nM - fm) : WGM;
        u.pm = fm + ((wgid % nig) % gsz); u.pn = (wgid % nig) / gsz; return true;
    }
};

template <class Epi, bool ALIGN_EPI, class Sched = StaticOrder>
__device__ __forceinline__ void gemm_phase(LAS unsigned char* lds, const Gemm g, const Sched& S, const Epi& E) {
    int tid = threadIdx.x; asm volatile("" : "+v"(tid)); tid &= 511;
    const int wid = __builtin_amdgcn_readfirstlane(tid >> 6), lane = tid & 63, wr = wid >> 2, wc = wid & 3, fr = lane & 15, fq = lane >> 4;
    const int nt = g.nt;
    unsigned voffA[2], voffB[2];
#pragma unroll
    for (int i = 0; i < 2; ++i) { int R, C; stage_rc(tid * 16 + i * 8192, R, C); const int Rb = Epi::PERM == 2 ? ((R >> 5) * 64 + perm32(R & 31)) : Epi::PERM == 1 ? ((R & ~31) + perm32(R & 31)) : R;
        voffA[i] = (unsigned)(R * g.lda + C) * 2u; voffB[i] = (unsigned)(Rb * g.ldb + C) * 2u; }
    const size_t kstep = (size_t)(BK * 2);
    const size_t hstepA = (size_t)HALF * g.lda * 2, hstepB = (size_t)(Epi::PERM == 2 ? 32 : HALF) * g.ldb * 2;
    const size_t tstepA = 2 * hstepA, tstepB = (size_t)BM * g.ldb * 2;
    const unsigned ldsw = (unsigned)wid * 1024u;
    const int aoff = lds_byte(wr * 64 + fr, fq * 8), boff = lds_byte(wc * 32 + fr, fq * 8);
#define PG8_SA(b, h) (((b) * 2 + (h)) * HTB)
#define PG8_SB(b, h) ((4 + (b) * 2 + (h)) * HTB)
#define PG8_STAGE(bufoff, gbase, voff) do { _Pragma("unroll") for (int _i = 0; _i < 2; ++_i) \
        __builtin_amdgcn_global_load_lds((const unsigned*)((const char*)(gbase) + (voff)[_i]), (LAS unsigned*)(lds + (bufoff) + ldsw + _i * 8192), 16, 0, 0); } while (0)
#define PG8_LDA(dst, b, h) do { _Pragma("unroll") for (int m = 0; m < 4; ++m) _Pragma("unroll") for (int k = 0; k < 2; ++k) dst[m][k] = *(const LAS bf16x8*)(lds + PG8_SA(b, h) + aoff + m * 2048 + k * 1024); } while (0)
#define PG8_LDB(dst, b, h) do { _Pragma("unroll") for (int n = 0; n < 2; ++n) _Pragma("unroll") for (int k = 0; k < 2; ++k) dst[n][k] = *(const LAS bf16x8*)(lds + PG8_SB(b, h) + boff + n * 2048 + k * 1024); } while (0)
#define PG8_MMA(ai, bj, At, Bt) do { __builtin_amdgcn_s_setprio(1); _Pragma("unroll") for (int m = 0; m < 4; ++m) _Pragma("unroll") for (int n = 0; n < 2; ++n) _Pragma("unroll") for (int k = 0; k < 2; ++k) \
        acc[ai][bj][m][n] = __builtin_amdgcn_mfma_f32_16x16x32_bf16(Bt[n][k], At[m][k], acc[ai][bj][m][n], 0, 0, 0); __builtin_amdgcn_s_setprio(0); } while (0)
#define PG8_WAIT_V(n) asm volatile("s_waitcnt vmcnt(" #n ")" ::: "memory")
#define PG8_WAIT_L(n) asm volatile("s_waitcnt lgkmcnt(" #n ")" ::: "memory")
#define PG8_BAR __builtin_amdgcn_s_barrier()
#define PG8_SCHED __builtin_amdgcn_sched_barrier(0)
#define PG8_ABASE(u) ((const char*)g.A + (size_t)(u).pm * tstepA + (size_t)(((u).pn >> g.a_sh) * g.a_mul) * 2)
#define PG8_BBASE(u) ((const char*)g.Bt + (size_t)(u).pn * tstepB)
    Unit cur, nxt; int ui = 0;
    if (!S.next(0, cur)) return;
    f32x4 acc[2][2][4][2];
#pragma unroll
    for (int a = 0; a < 2; ++a)
#pragma unroll
        for (int b = 0; b < 2; ++b)
#pragma unroll
            for (int m = 0; m < 4; ++m)
#pragma unroll
                for (int n = 0; n < 2; ++n) acc[a][b][m][n] = (f32x4){0.f, 0.f, 0.f, 0.f};
    bf16x8 At[4][2], B0[2][2], B1[2][2];
    const char* cA = PG8_ABASE(cur); const char* cB = PG8_BBASE(cur);
    PG8_STAGE(PG8_SB(0, 0), cB, voffB); PG8_STAGE(PG8_SB(0, 1), cB + hstepB, voffB); PG8_STAGE(PG8_SA(0, 0), cA, voffA); PG8_STAGE(PG8_SA(0, 1), cA + hstepA, voffA);
    if (wr == 1) PG8_BAR;
    PG8_WAIT_V(2); PG8_BAR;
    PG8_STAGE(PG8_SB(1, 0), cB + kstep, voffB); PG8_STAGE(PG8_SA(1, 0), cA + kstep, voffA); PG8_STAGE(PG8_SB(1, 1), cB + hstepB + kstep, voffB);
    PG8_WAIT_V(6); PG8_BAR;
    for (;;) {
        const bool has_next = S.next(ui + 1, nxt);
        const char* nA = has_next ? PG8_ABASE(nxt) : cA; const char* nB = has_next ? PG8_BBASE(nxt) : cB;
#pragma unroll 1
        for (int t = 0; t < nt; t += 2) {
            const bool last = (t == nt - 2);
            if constexpr (Epi::MIDK) { if (t == E.midk_t) E.mid(acc, cur, wr, wc, fr, fq); }
            const char* a1 = cA + (size_t)(t + 1) * kstep;
            const char* a2 = last ? nA : cA + (size_t)(t + 2) * kstep; const char* b2 = last ? nB : cB + (size_t)(t + 2) * kstep;
            const char* a3 = a2 + kstep; const char* b3 = b2 + kstep;
            PG8_LDB(B0, 0, 0); PG8_LDB(B1, 0, 1); PG8_SCHED; PG8_LDA(At, 0, 0); PG8_STAGE(PG8_SA(1, 1), a1 + hstepA, voffA);
            PG8_WAIT_V(8); PG8_WAIT_L(0); PG8_BAR; PG8_MMA(0, 0, At, B0); PG8_MMA(0, 1, At, B1); PG8_BAR; PG8_SCHED;
            PG8_LDA(At, 0, 1); PG8_STAGE(PG8_SB(0, 0), b2, voffB); PG8_STAGE(PG8_SB(0, 1), b2 + hstepB, voffB); PG8_STAGE(PG8_SA(0, 0), a2, voffA);
            PG8_WAIT_V(8); PG8_WAIT_L(0); PG8_BAR; PG8_MMA(1, 0, At, B0); PG8_MMA(1, 1, At, B1); PG8_BAR; PG8_SCHED;
            PG8_LDB(B0, 1, 0); PG8_LDB(B1, 1, 1); PG8_SCHED; PG8_LDA(At, 1, 0); PG8_STAGE(PG8_SA(0, 1), a2 + hstepA, voffA);
            PG8_WAIT_V(8); PG8_WAIT_L(0); PG8_BAR; PG8_MMA(0, 0, At, B0); PG8_MMA(0, 1, At, B1); PG8_BAR; PG8_SCHED;
            PG8_LDA(At, 1, 1); PG8_STAGE(PG8_SB(1, 0), b3, voffB); PG8_STAGE(PG8_SB(1, 1), b3 + hstepB, voffB); PG8_STAGE(PG8_SA(1, 0), a3, voffA);
            PG8_WAIT_V(8); PG8_WAIT_L(0); PG8_BAR; PG8_MMA(1, 0, At, B0); PG8_MMA(1, 1, At, B1); PG8_BAR; PG8_SCHED;
        }
        if constexpr (ALIGN_EPI) { if (wr == 0) PG8_BAR; }
        if constexpr (!Epi::AFTER_DRAIN) { E(acc, cur, ui, wr, wc, fr, fq); }
        if (!has_next) break;
#pragma unroll
        for (int a = 0; a < 2; ++a)
#pragma unroll
            for (int b = 0; b < 2; ++b)
#pragma unroll
                for (int m = 0; m < 4; ++m)
#pragma unroll
                    for (int n = 0; n < 2; ++n) acc[a][b][m][n] = (f32x4){0.f, 0.f, 0.f, 0.f};
        cur = nxt; cA = nA; cB = nB; ++ui;
        if constexpr (ALIGN_EPI) { if (wr == 1) PG8_BAR; }
    }
    PG8_WAIT_V(0);
    if constexpr (!ALIGN_EPI) { if (wr == 0) PG8_BAR; }
    PG8_BAR;
    if constexpr (Epi::AFTER_DRAIN) { E.fused(acc, cur, wr, wc, fr, fq, lds, wid, lane); }
#undef PG8_SA
#undef PG8_SB
#undef PG8_STAGE
#undef PG8_LDA
#undef PG8_LDB
#undef PG8_MMA
#undef PG8_WAIT_V
#undef PG8_WAIT_L
#undef PG8_BAR
#undef PG8_SCHED
#undef PG8_ABASE
#undef PG8_BBASE
}

typedef f32x4 Acc[2][2][4][2];
__device__ __forceinline__ float ror8_1(float x) { float r; asm volatile("s_nop 1\n\tv_mov_b32_dpp %0, %1 row_ror:8 row_mask:0xf bank_mask:0xf" : "=v"(r) : "v"(x)); return r; }
__device__ __forceinline__ f32x4 ror8(const f32x4 v) { f32x4 r; r[0] = ror8_1(v[0]); r[1] = ror8_1(v[1]); r[2] = ror8_1(v[2]); r[3] = ror8_1(v[3]); return r; }
__device__ __forceinline__ f32x4 sel4(bool c, const f32x4 a, const f32x4 b) { f32x4 r;
#pragma unroll
    for (int i = 0; i < 4; ++i) r[i] = c ? a[i] : b[i]; return r; }
__device__ __forceinline__ void ld_lines(const float* p, int ldf, bool lo, int fr7, f32x4& n0, f32x4& n1, int hoff = 16) {
    const float* q = p + (size_t)fr7 * ldf + (lo ? 0 : hoff); const f32x4 A = __builtin_nontemporal_load((const f32x4*)q), B = __builtin_nontemporal_load((const f32x4*)(q + (size_t)8 * ldf));
    n0 = sel4(lo, A, ror8(B)); n1 = sel4(lo, ror8(A), B); }
__device__ __forceinline__ void st_lines(float* p, int ldf, bool lo, int fr7, const f32x4 n0, const f32x4 n1, int hoff = 16) {
    float* q = p + (size_t)fr7 * ldf + (lo ? 0 : hoff); *(f32x4*)q = sel4(lo, n0, ror8(n1)); *(f32x4*)(q + (size_t)8 * ldf) = sel4(lo, ror8(n0), n1); }
__device__ __forceinline__ u32x4 asu(const f32x4 v) { return __builtin_bit_cast(u32x4, v); }
__device__ __forceinline__ f32x4 asf(const u32x4 v) { return __builtin_bit_cast(f32x4, v); }
__device__ __forceinline__ void st_lines16(bf16_t* p, int ld, bool lo, int fr7, const u32x4 h0, const u32x4 h1) {
    bf16_t* q = p + (size_t)fr7 * ld + (lo ? 0 : 32); *(u32x4*)q = asu(sel4(lo, asf(h0), ror8(asf(h1)))); *(u32x4*)(q + (size_t)8 * ld) = asu(sel4(lo, ror8(asf(h0)), asf(h1))); }
__device__ __forceinline__ void ld_lines16(const bf16_t* p, int ld, bool lo, int fr7, u32x4& h0, u32x4& h1) {
    const bf16_t* q = p + (size_t)fr7 * ld + (lo ? 0 : 32); const f32x4 A = asf(*(const u32x4*)q), B = asf(*(const u32x4*)(q + (size_t)8 * ld));
    h0 = asu(sel4(lo, A, ror8(B))); h1 = asu(sel4(lo, ror8(A), B)); }

constexpr int TAB_OFF = RING_BYTES + 1024;

__device__ __forceinline__ float row_rstd(const float* ss, int row) {
    float s = 0.f;
#pragma unroll
    for (int j = 0; j < 8; ++j) s += ss[(size_t)j * M + row];
    return __builtin_amdgcn_rsqf(s * (1.0f / DM) + EPS);
}
__device__ __forceinline__ u32x4 pack8(const f32x4 a, const f32x4 b) { u32x4 w; w.x = cvt_pk_bf16(a[0], a[1]); w.y = cvt_pk_bf16(a[2], a[3]); w.z = cvt_pk_bf16(b[0], b[1]); w.w = cvt_pk_bf16(b[2], b[3]); return w; }
__device__ __forceinline__ void unpack8(const u32x4 w, f32x4& a, f32x4& b) { a = (f32x4){bf_lo(w.x), bf_hi(w.x), bf_lo(w.y), bf_hi(w.y)}; b = (f32x4){bf_lo(w.z), bf_hi(w.z), bf_lo(w.w), bf_hi(w.w)}; }

__device__ __forceinline__ void fill_rstd_tab(LAS unsigned char* lds, const StaticOrder& S, const float* ss, int tid) {
    LAS float* tab = (LAS float*)(lds + TAB_OFF); Unit u;
    for (int i = 0; i < 8 && S.next(i, u); ++i) if (tid < 256) tab[i * 256 + tid] = row_rstd(ss, u.pm * BM + tid);
    __syncthreads();
}
constexpr int BTAB_OFF = RING_BYTES + 9216;
__device__ __forceinline__ void fill_bias_tab(LAS unsigned char* lds, const StaticOrder& S, const float* pb, int ncols, int tid) {
    LAS float* bt = (LAS float*)(lds + BTAB_OFF); Unit u;
    for (int i = 0; i < 6 && S.next(i, u); ++i) if (tid < 256) { const float* p = pb + (size_t)((u.pm >> 4) * 32) * ncols + u.pn * BM + tid; float s = 0.f;
#pragma unroll 8
        for (int kb = 0; kb < 32; ++kb) s += p[(size_t)kb * ncols];
        bt[i * 256 + tid] = s; }
    __syncthreads();
}
struct EpiZ {
    static constexpr int PERM = 2; static constexpr bool AFTER_DRAIN = false, MIDK = false;
    const LAS float* tab; const LAS float* btab; bf16_t* xrnn; bf16_t* gg; bf16_t* xpool; bf16_t* rg; int midk_t;
    __device__ __forceinline__ void mid(Acc&, const Unit&, int, int, int, int) const {}
    __device__ __forceinline__ void operator()(const Acc& acc, const Unit& u, int ui, int wr, int wc, int fr, int fq) const {
        { int t_ = threadIdx.x; asm volatile("" : "+v"(t_)); fr = t_ & 15; fq = (t_ >> 4) & 3; }
        const int row0 = u.pm * BM + wr * 64, b = u.pm >> 4, lc0 = wc * 64 + 8 * fq; const bool lo = fr < 8; const int fr7 = fr & 7;
        const LAS float* rtab = tab + ui * 256 + wr * 64 + fr;
        const LAS float* bp = btab + ui * 256 + lc0;
        f32x4 bv[2][2];
#pragma unroll
        for (int bj = 0; bj < 2; ++bj)
#pragma unroll
            for (int n = 0; n < 2; ++n) bv[bj][n] = *(const LAS f32x4*)(bp + 32 * bj + 4 * n);
        bf16_t* d0; int ld, mode = 0;
        if (u.pn < 8) { d0 = xrnn + u.pn * BM + lc0; ld = DRNN; }
        else if (u.pn < 16) { d0 = gg + (u.pn - 8) * BM + lc0; ld = DRNN; mode = 1; }
        else if (u.pn < 20) { d0 = xpool + (u.pn - 16) * BM + lc0; ld = DPOOL; }
        else { d0 = rg + (u.pn - 20) * BM + lc0; ld = 2 * DM; mode = 2; }
#pragma unroll
        for (int ai = 0; ai < 2; ++ai)
#pragma unroll
            for (int m = 0; m < 4; ++m) { const int rowg = row0 + ai * HALF + m * 16; const float rs = rtab[ai * HALF + m * 16];
                f32x4 z[2][2];
#pragma unroll
                for (int bj = 0; bj < 2; ++bj)
#pragma unroll
                    for (int n = 0; n < 2; ++n) z[bj][n] = acc[ai][bj][m][n] * rs + bv[bj][n];
                if (mode == 1) {
#pragma unroll
                    for (int bj = 0; bj < 2; ++bj)
#pragma unroll
                        for (int n = 0; n < 2; ++n)
#pragma unroll
                            for (int i = 0; i < 4; ++i) z[bj][n][i] = gelu_tanh_f(z[bj][n][i]);
                } else if (mode == 2) {
#pragma unroll
                    for (int n = 0; n < 2; ++n)
#pragma unroll
                        for (int i = 0; i < 4; ++i) { const float eu = fexp2(-1.4426950409f * z[0][n][i]), ev = fminf(fexp2(-1.4426950409f * z[1][n][i]), 1e30f);
                            z[1][n][i] = frcp(1.f + ev); z[0][n][i] = (1.f + ev) * frcp(1.f + eu); }
                }
                st_lines16(d0 + (size_t)rowg * ld, ld, lo, fr7, pack8(z[0][0], z[0][1]), pack8(z[1][0], z[1][1])); }
    }
};

struct GateOrder {
    int c;
    __device__ bool next(int i, Unit& u) const { if (i >= 2 || c >= 256) return false; const int pmi = c >> 4; u.pn = c & 15; u.pm = ((pmi < 8) ? pmi : pmi + 8) + 8 * i; return true; }
};
constexpr int SCAN_OFF = RING_BYTES + 9216;
template <int CTRL> __device__ __forceinline__ float dpp_old(float oldv, float x) { return __builtin_bit_cast(float, __builtin_amdgcn_update_dpp(__builtin_bit_cast(int, oldv), __builtin_bit_cast(int, x), CTRL, 0xf, 0xf, false)); }
__device__ __forceinline__ float bcast15(float x) { return __builtin_bit_cast(float, __builtin_amdgcn_ds_swizzle(__builtin_bit_cast(int, x), 0x1F0)); }
struct EpiGates {
    static constexpr int PERM = 2; static constexpr bool AFTER_DRAIN = false, MIDK = false;
    const float* ba; const float* bx; const float* lruk; const bf16_t* xr; const bf16_t* gg; bf16_t* yab; unsigned long long* aggu; LAS unsigned char* lds; int midk_t;
    __device__ __forceinline__ void mid(Acc&, const Unit&, int, int, int, int) const {}
    __device__ __forceinline__ void operator()(const Acc& acc, const Unit& u, int ui, int wr, int wc, int fr, int fq) const {
        int tid; { int t_ = threadIdx.x; asm volatile("" : "+v"(t_)); tid = t_ & 511; fr = t_ & 15; fq = (t_ >> 4) & 3; }
        const int b = u.pm >> 4, pmb = u.pm & 15;
        const int row0 = u.pm * BM + wr * 64 + fr, chl0 = wc * 32 + 8 * fq, ch0 = u.pn * HALF + chl0;
        LAS float* CH = (LAS float*)(lds + SCAN_OFF); LAS float* CARRY = CH + 1024;
        f32x4 Pf[2][4][2], Hf[2][4][2];
        f32x4 vba[2], vbx[2], vk[2];
#pragma unroll
        for (int n = 0; n < 2; ++n) { vba[n] = *(const f32x4*)(ba + ch0 + 4 * n); vbx[n] = *(const f32x4*)(bx + ch0 + 4 * n); vk[n] = *(const f32x4*)(lruk + ch0 + 4 * n); }
#pragma unroll
        for (int ai = 0; ai < 2; ++ai) {
            f32x4 Pc[2] = {(f32x4){1.f, 1.f, 1.f, 1.f}, (f32x4){1.f, 1.f, 1.f, 1.f}}, Hc[2] = {(f32x4){0.f, 0.f, 0.f, 0.f}, (f32x4){0.f, 0.f, 0.f, 0.f}};
            const bf16_t* px = xr + (size_t)(row0 + ai * HALF) * DRNN + ch0; asm volatile("" : "+v"(px));
#pragma unroll
            for (int m = 0; m < 4; ++m) { const u32x4 xw = *(const u32x4*)px; px += 16 * DRNN; f32x4 xv[2]; unpack8(xw, xv[0], xv[1]);
#pragma unroll
                for (int n = 0; n < 2; ++n) {
#pragma unroll
                    for (int i = 0; i < 4; ++i) { const float r = sigmoid_f(acc[ai][0][m][n][i] + vba[n][i]), g = sigmoid_f(acc[ai][1][m][n][i] + vbx[n][i]);
                        float P = fexp2(1.4426950409f * vk[n][i] * r), H = __builtin_amdgcn_sqrtf(fmaxf(1.f - P * P, 0.f)) * (g * xv[n][i]);
                        { const float Pp = dpp_old<0x111>(1.f, P), Hp = dpp_old<0x111>(0.f, H); H = P * Hp + H; P = P * Pp; }
                        { const float Pp = dpp_old<0x112>(1.f, P), Hp = dpp_old<0x112>(0.f, H); H = P * Hp + H; P = P * Pp; }
                        { const float Pp = dpp_old<0x114>(1.f, P), Hp = dpp_old<0x114>(0.f, H); H = P * Hp + H; P = P * Pp; }
                        { const float Pp = dpp_old<0x118>(1.f, P), Hp = dpp_old<0x118>(0.f, H); H = P * Hp + H; P = P * Pp; }
                        const float Pt = bcast15(P), Ht = bcast15(H);
                        Hf[ai][m][n][i] = P * Hc[n][i] + H; Pf[ai][m][n][i] = P * Pc[n][i];
                        Hc[n][i] = Pt * Hc[n][i] + Ht; Pc[n][i] = Pt * Pc[n][i]; }
                    asm volatile("" : "+v"(Hf[ai][m][n]), "+v"(Pf[ai][m][n]), "+v"(Hc[n]), "+v"(Pc[n]) :: "memory"); } }
            if (fr == 0) {
#pragma unroll
                for (int n = 0; n < 2; ++n) { *(LAS f32x4*)(CH + ((2 * ai + wr) * 2 + 0) * 128 + chl0 + 4 * n) = Pc[n]; *(LAS f32x4*)(CH + ((2 * ai + wr) * 2 + 1) * 128 + chl0 + 4 * n) = Hc[n]; } }
        }
        asm volatile("s_waitcnt lgkmcnt(0)" ::: "memory"); __builtin_amdgcn_s_barrier(); asm volatile("" ::: "memory");
        {
            const int tc = tid & 127, jg = tid >> 7;
            unsigned long long* gbase = aggu + (size_t)(b * 16) * DRNN + u.pn * HALF + tc;
            if (jg == 0) { float P = 1.f, H = 0.f;
#pragma unroll
                for (int c = 0; c < 4; ++c) { const float p = CH[(c * 2 + 0) * 128 + tc], h = CH[(c * 2 + 1) * 128 + tc]; H = p * H + h; P = p * P; }
                __hip_atomic_store(gbase + (size_t)pmb * DRNN, ((unsigned long long)__float_as_uint(H) << 32) | (unsigned long long)__float_as_uint(-P), __ATOMIC_RELAXED, __HIP_MEMORY_SCOPE_AGENT); }
            float Pq = 1.f, Hq = 0.f;
            if (4 * jg < pmb) {
                unsigned long long gq[4]; unsigned spins = 0;
                for (;;) { bool ok = true;
#pragma unroll
                    for (int j = 0; j < 4; ++j) { gq[j] = 0x80000000ull; if (4 * jg + j < pmb) { gq[j] = __hip_atomic_load(gbase + (size_t)(4 * jg + j) * DRNN, __ATOMIC_RELAXED, __HIP_MEMORY_SCOPE_AGENT); ok = ok && ((gq[j] >> 31) & 1ull); } }
                    if (__all(ok) || ++spins > (1u << 20)) break;
                    __builtin_amdgcn_s_sleep(4); }
#pragma unroll
                for (int j = 0; j < 4; ++j) if (4 * jg + j < pmb) { const float p = -__uint_as_float((unsigned)gq[j]), h = __uint_as_float((unsigned)(gq[j] >> 32)); Hq = p * Hq + h; Pq = p * Pq; }
            }
            LAS float* PART = (LAS float*)(lds + TAB_OFF);
            PART[(jg * 2 + 0) * 128 + tc] = Pq; PART[(jg * 2 + 1) * 128 + tc] = Hq;
        }
        asm volatile("s_waitcnt lgkmcnt(0)" ::: "memory"); __builtin_amdgcn_s_barrier(); asm volatile("" ::: "memory");
        if (tid < 128) { const LAS float* PART = (const LAS float*)(lds + TAB_OFF); float hin = 0.f;
#pragma unroll
            for (int jg = 0; jg < 4; ++jg) hin = PART[(jg * 2 + 0) * 128 + tid] * hin + PART[(jg * 2 + 1) * 128 + tid];
            CARRY[tid] = hin; }
        asm volatile("s_waitcnt lgkmcnt(0)" ::: "memory"); __builtin_amdgcn_s_barrier(); asm volatile("" ::: "memory");
#pragma unroll
        for (int ai = 0; ai < 2; ++ai) {
            f32x4 hp[2];
#pragma unroll
            for (int n = 0; n < 2; ++n) { hp[n] = *(const LAS f32x4*)(CARRY + chl0 + 4 * n);
#pragma unroll
                for (int c = 0; c < 3; ++c) if (c < 2 * ai + wr) hp[n] = *(const LAS f32x4*)(CH + (c * 2 + 0) * 128 + chl0 + 4 * n) * hp[n] + *(const LAS f32x4*)(CH + (c * 2 + 1) * 128 + chl0 + 4 * n); }
            const bf16_t* pg = gg + (size_t)(row0 + ai * HALF) * DRNN + ch0; bf16_t* py = yab + (size_t)(row0 + ai * HALF) * 3072 + ch0; asm volatile("" : "+v"(pg), "+v"(py));
#pragma unroll
            for (int m = 0; m < 4; ++m) { const u32x4 gw = __builtin_nontemporal_load((const u32x4*)pg); pg += 16 * DRNN; f32x4 g0, g1; unpack8(gw, g0, g1);
                *(u32x4*)py = pack8((Hf[ai][m][0] + Pf[ai][m][0] * hp[0]) * g0, (Hf[ai][m][1] + Pf[ai][m][1] * hp[1]) * g1); py += 16 * 3072; asm volatile("" ::: "memory"); }
        }
    }
};

struct EpiPool {
    static constexpr int PERM = 2; static constexpr bool AFTER_DRAIN = false, MIDK = false;
    const float* pb; const float* ps; bf16_t* yab; int midk_t;
    __device__ __forceinline__ void mid(Acc&, const Unit&, int, int, int, int) const {}
    __device__ __forceinline__ void operator()(const Acc& acc, const Unit& u, int ui, int wr, int wc, int fr, int fq) const {
        { int t_ = threadIdx.x; asm volatile("" : "+v"(t_)); fr = t_ & 15; fq = (t_ >> 4) & 3; }
        const int c0 = u.pn * BM + wc * 64 + 8 * fq; const bool lo = fr < 8; const int fr7 = fr & 7;
        f32x4 bv[2][2], sv[2][2];
#pragma unroll
        for (int bj = 0; bj < 2; ++bj)
#pragma unroll
            for (int n = 0; n < 2; ++n) { bv[bj][n] = *(const f32x4*)(pb + c0 + 32 * bj + 4 * n); sv[bj][n] = *(const f32x4*)(ps + c0 + 32 * bj + 4 * n); }
#pragma unroll
        for (int ai = 0; ai < 2; ++ai)
#pragma unroll
            for (int m = 0; m < 4; ++m) { bf16_t* p = yab + (size_t)(u.pm * BM + ai * HALF + wr * 64 + m * 16) * 3072 + 2048 + c0;
                st_lines16(p, 3072, lo, fr7, pack8((acc[ai][0][m][0] + bv[0][0]) * sv[0][0], (acc[ai][0][m][1] + bv[0][1]) * sv[0][1]), pack8((acc[ai][1][m][0] + bv[1][0]) * sv[1][0], (acc[ai][1][m][1] + bv[1][1]) * sv[1][1]));
                asm volatile("" ::: "memory"); }
    }
};

struct EpiMerge {
    static constexpr int PERM = 2; static constexpr bool AFTER_DRAIN = false, MIDK = true;
    const bf16_t* rg; bf16_t* merged; int midk_t;
    __device__ __forceinline__ void mid(Acc& acc, const Unit& u, int wr, int wc, int fr, int fq) const {
        { int t_ = threadIdx.x; asm volatile("" : "+v"(t_)); fr = t_ & 15; fq = (t_ >> 4) & 3; }
        const int rc0 = 256 * (2 * u.pn + (wc >> 1)) + 128 * (wc & 1) + 8 * fq;
#pragma unroll
        for (int ai = 0; ai < 2; ++ai)
#pragma unroll
            for (int m = 0; m < 4; ++m) {
                const bf16_t* pr = rg + (size_t)(u.pm * BM + ai * HALF + wr * 64 + m * 16 + fr) * (2 * DM) + rc0; const u32x4 h0 = __builtin_nontemporal_load((const u32x4*)pr), h1 = __builtin_nontemporal_load((const u32x4*)(pr + 64));
                f32x4 a, b; unpack8(h0, a, b); acc[ai][0][m][0] *= a; acc[ai][0][m][1] *= b; unpack8(h1, a, b); acc[ai][1][m][0] *= a; acc[ai][1][m][1] *= b;
                asm volatile("" ::: "memory"); }
    }
    __device__ __forceinline__ void operator()(const Acc& acc, const Unit& u, int ui, int wr, int wc, int fr, int fq) const {
        { int t_ = threadIdx.x; asm volatile("" : "+v"(t_)); fr = t_ & 15; fq = (t_ >> 4) & 3; }
        const int c0 = u.pn * BM + wc * 64 + 8 * fq; const bool lo = fr < 8; const int fr7 = fr & 7;
        const int rc0 = 256 * (2 * u.pn + (wc >> 1)) + 128 * (wc & 1) + 8 * fq + 32;
#pragma unroll
        for (int ai = 0; ai < 2; ++ai)
#pragma unroll
            for (int m = 0; m < 4; ++m) { const size_t goff = (size_t)(u.pm * BM + ai * HALF + wr * 64 + m * 16) * DM + c0;
                const bf16_t* pr = rg + (size_t)(u.pm * BM + ai * HALF + wr * 64 + m * 16 + fr) * (2 * DM) + rc0; const u32x4 h0 = __builtin_nontemporal_load((const u32x4*)pr), h1 = __builtin_nontemporal_load((const u32x4*)(pr + 64)); f32x4 a0, b0, a1, b1; unpack8(h0, a0, b0); unpack8(h1, a1, b1);
                st_lines16(merged + goff, DM, lo, fr7, pack8(acc[ai][0][m][0] * a0, acc[ai][0][m][1] * b0), pack8(acc[ai][1][m][0] * a1, acc[ai][1][m][1] * b1));
                asm volatile("" ::: "memory"); }
    }
};

template <bool F32SRC>
struct EpiResid {
    static constexpr int PERM = 2; static constexpr bool AFTER_DRAIN = true, MIDK = false;
    const float* xsrc_f;
    const bf16_t* xsrc_b; const float* gsrc;
    bf16_t* xg; const float* gt; const float* gm; float* ss; int midk_t;
    __device__ __forceinline__ void mid(Acc&, const Unit&, int, int, int, int) const {}
    __device__ __forceinline__ void operator()(const Acc&, const Unit&, int, int, int, int, int) const {}
    __device__ __forceinline__ void fused(const Acc& acc, const Unit& u, int wr, int wc, int fr, int fq, LAS unsigned char* lds, int wid, int lane) const {
        { int t_ = threadIdx.x; asm volatile("" : "+v"(t_)); fr = t_ & 15; fq = (t_ >> 4) & 3; }
        const int b = u.pm >> 4, col0 = u.pn * BM + wc * 64 + 8 * fq;
        LAS float* P = (LAS float*)lds;
        const bool lo = fr < 8; const int fr7 = fr & 7;
        f32x4 gv[2][2], gmv[2][2], rgv[2][2];
#pragma unroll
        for (int bj = 0; bj < 2; ++bj)
#pragma unroll
            for (int n = 0; n < 2; ++n) { const size_t ci = (size_t)b * DM + col0 + 32 * bj + 4 * n; gv[bj][n] = *(const f32x4*)(gt + ci); gmv[bj][n] = *(const f32x4*)(gm + ci);
                if constexpr (!F32SRC) { const f32x4 gs = *(const f32x4*)(gsrc + ci); rgv[bj][n] = (f32x4){1.0f / gs[0], 1.0f / gs[1], 1.0f / gs[2], 1.0f / gs[3]}; } else rgv[bj][n] = (f32x4){1.f, 1.f, 1.f, 1.f}; }
#pragma unroll
        for (int ai = 0; ai < 2; ++ai)
#pragma unroll
            for (int m = 0; m < 4; ++m) { const size_t goff = (size_t)(u.pm * BM + ai * HALF + wr * 64 + m * 16) * DM + col0;
                float q = 0.f; u32x4 pk[2]; f32x4 x[2][2];
                if constexpr (F32SRC) {
#pragma unroll
                    for (int bj = 0; bj < 2; ++bj) ld_lines(xsrc_f + goff + 32 * bj, DM, lo, fr7, x[bj][0], x[bj][1], 4);
                } else { u32x4 h0, h1; ld_lines16(xsrc_b + goff, DM, lo, fr7, h0, h1); unpack8(h0, x[0][0], x[0][1]); unpack8(h1, x[1][0], x[1][1]);
#pragma unroll
                    for (int bj = 0; bj < 2; ++bj) { x[bj][0] *= rgv[bj][0]; x[bj][1] *= rgv[bj][1]; } }
#pragma unroll
                for (int bj = 0; bj < 2; ++bj) { const f32x4 y0 = x[bj][0] + gv[bj][0] * acc[ai][bj][m][0], y1 = x[bj][1] + gv[bj][1] * acc[ai][bj][m][1];
                    q += ((y0[0] * y0[0] + y0[1] * y0[1]) + (y0[2] * y0[2] + y0[3] * y0[3])) + ((y1[0] * y1[0] + y1[1] * y1[1]) + (y1[2] * y1[2] + y1[3] * y1[3]));
                    pk[bj] = pack8(y0 * gmv[bj][0], y1 * gmv[bj][1]); }
                st_lines16(xg + goff, DM, lo, fr7, pk[0], pk[1]);
                q += __shfl_xor(q, 16); q += __shfl_xor(q, 32); if (fq == 0) P[(ai * HALF + wr * 64 + m * 16 + fr) * 4 + wc] = q;
                asm volatile("" ::: "memory"); }
        asm volatile("s_waitcnt lgkmcnt(0)" ::: "memory"); __builtin_amdgcn_s_barrier(); asm volatile("" ::: "memory");
        const int t = wid * 64 + lane;
        if (t < 256) { const float s = (P[t * 4 + 0] + P[t * 4 + 1]) + (P[t * 4 + 2] + P[t * 4 + 3]); ss[(size_t)u.pn * M + u.pm * BM + t] = s; }
    }
};

struct EpiFinal {
    static constexpr int PERM = 2; static constexpr bool AFTER_DRAIN = true, MIDK = false;
    const bf16_t* xsrc_b; const float* gsrc; float* out; const float* gt; const float* fg; unsigned* fss; int midk_t;
    __device__ __forceinline__ void mid(Acc&, const Unit&, int, int, int, int) const {}
    __device__ __forceinline__ void operator()(const Acc&, const Unit&, int, int, int, int, int) const {}
    __device__ __forceinline__ void fused(const Acc& acc, const Unit& u, int wr, int wc, int fr, int fq, LAS unsigned char* lds, int wid, int lane) const {
        { int t_ = threadIdx.x; asm volatile("" : "+v"(t_)); fr = t_ & 15; fq = (t_ >> 4) & 3; }
        const int b = u.pm >> 4, col0 = u.pn * BM + wc * 64 + 8 * fq;
        LAS float* P = (LAS float*)lds;
        const bool lo = fr < 8; const int fr7 = fr & 7;
        f32x4 xn[2][2][4][2]; f32x4 gv[2][2], rgv[2][2];
#pragma unroll
        for (int bj = 0; bj < 2; ++bj)
#pragma unroll
            for (int n = 0; n < 2; ++n) { const size_t ci = (size_t)b * DM + col0 + 32 * bj + 4 * n; gv[bj][n] = *(const f32x4*)(gt + ci); const f32x4 gs = *(const f32x4*)(gsrc + ci); rgv[bj][n] = (f32x4){1.0f / gs[0], 1.0f / gs[1], 1.0f / gs[2], 1.0f / gs[3]}; }
#pragma unroll
        for (int ai = 0; ai < 2; ++ai)
#pragma unroll
            for (int m = 0; m < 4; ++m) { const size_t goff = (size_t)(u.pm * BM + ai * HALF + wr * 64 + m * 16) * DM + col0; float q = 0.f;
                u32x4 h0, h1; ld_lines16(xsrc_b + goff, DM, lo, fr7, h0, h1); f32x4 xs[2][2]; unpack8(h0, xs[0][0], xs[0][1]); unpack8(h1, xs[1][0], xs[1][1]);
#pragma unroll
                for (int bj = 0; bj < 2; ++bj) { const f32x4 x0 = xs[bj][0] * rgv[bj][0], x1 = xs[bj][1] * rgv[bj][1];
                    const f32x4 v0 = x0 + gv[bj][0] * acc[ai][bj][m][0], v1 = x1 + gv[bj][1] * acc[ai][bj][m][1]; xn[ai][bj][m][0] = v0; xn[ai][bj][m][1] = v1;
                    q += ((v0[0] * v0[0] + v0[1] * v0[1]) + (v0[2] * v0[2] + v0[3] * v0[3])) + ((v1[0] * v1[0] + v1[1] * v1[1]) + (v1[2] * v1[2] + v1[3] * v1[3]));
                    asm volatile("" : "+v"(xn[ai][bj][m][0]), "+v"(xn[ai][bj][m][1]), "+v"(q) :: "memory"); }
                q += __shfl_xor(q, 16); q += __shfl_xor(q, 32); if (fq == 0) P[(ai * HALF + wr * 64 + m * 16 + fr) * 4 + wc] = q; }
        asm volatile("s_waitcnt lgkmcnt(0)" ::: "memory"); __builtin_amdgcn_s_barrier(); asm volatile("" ::: "memory");
        const int t = wid * 64 + lane;
        if (t < 256) {
            const float s = (P[t * 4 + 0] + P[t * 4 + 1]) + (P[t * 4 + 2] + P[t * 4 + 3]);
            unsigned* w0 = fss + (size_t)u.pm * BM + t;
            __hip_atomic_store(w0 + (size_t)u.pn * M, __float_as_uint(-s), __ATOMIC_RELAXED, __HIP_MEMORY_SCOPE_AGENT);
            unsigned wv[8]; unsigned spins = 0;
            for (;;) { bool ok = true;
#pragma unroll
                for (int j = 0; j < 8; ++j) { wv[j] = __hip_atomic_load(w0 + (size_t)j * M, __ATOMIC_RELAXED, __HIP_MEMORY_SCOPE_AGENT); ok = ok && (wv[j] >> 31); }
                if (__all(ok) || ++spins > (1u << 20)) break;
                __builtin_amdgcn_s_sleep(4); }
            float tot = 0.f;
#pragma unroll
            for (int j = 0; j < 8; ++j) tot += -__uint_as_float(wv[j]);
            P[1024 + t] = __builtin_amdgcn_rsqf(tot * (1.0f / DM) + EPS);
        }
        asm volatile("s_waitcnt lgkmcnt(0)" ::: "memory"); __builtin_amdgcn_s_barrier(); asm volatile("" ::: "memory");
        f32x4 fv[2][2];
#pragma unroll
        for (int bj = 0; bj < 2; ++bj)
#pragma unroll
            for (int n = 0; n < 2; ++n) fv[bj][n] = *(const f32x4*)(fg + col0 + 32 * bj + 4 * n);
#pragma unroll
        for (int ai = 0; ai < 2; ++ai)
#pragma unroll
            for (int m = 0; m < 4; ++m) { const size_t goff = (size_t)(u.pm * BM + ai * HALF + wr * 64 + m * 16) * DM + col0; const float rs = P[1024 + ai * HALF + wr * 64 + m * 16 + fr];
#pragma unroll
                for (int bj = 0; bj < 2; ++bj) st_lines(out + goff + 32 * bj, DM, lo, fr7, xn[ai][bj][m][0] * rs * fv[bj][0], xn[ai][bj][m][1] * rs * fv[bj][1], 4);
                asm volatile("" ::: "memory"); }
    }
};

struct EpiUp {
    static constexpr int PERM = 1; static constexpr bool AFTER_DRAIN = false, MIDK = false;
    const LAS float* tab; const LAS float* btab; const float* cw; const float* cbias; bf16_t* act; float* uh; int midk_t;
    __device__ __forceinline__ void mid(Acc&, const Unit&, int, int, int, int) const {}
    __device__ __forceinline__ void operator()(const Acc& acc, const Unit& u, int ui, int wr, int wc, int fr, int fq) const {
        { int t_ = threadIdx.x; asm volatile("" : "+v"(t_)); fr = t_ & 15; fq = (t_ >> 4) & 3; }
        const int b = u.pm >> 4, lc0 = wc * 32 + 8 * fq;
        const LAS float* rtab = tab + ui * 256 + wr * 64 + fr;
        u32x2 keep[2][4];
#pragma unroll
        for (int n = 0; n < 2; ++n) {
            const int lc = lc0 + 4 * n, ca = u.pn * HALF + lc;
            f32x4 w0[2], w1[2], w2[2], cb[2], bv[2];
#pragma unroll
            for (int bj = 0; bj < 2; ++bj) { const int nc = bj * DFF + ca;
                w0[bj] = *(const f32x4*)(cw + nc); w1[bj] = *(const f32x4*)(cw + DUP + nc); w2[bj] = *(const f32x4*)(cw + 2 * DUP + nc); cb[bj] = *(const f32x4*)(cbias + nc);
                bv[bj] = *(const LAS f32x4*)(btab + ui * 256 + bj * HALF + lc); }
#pragma unroll
            for (int ai = 0; ai < 2; ++ai) {
                const int rbase = u.pm * BM + ai * HALF + wr * 64, sb = rbase >> 6;
                f32x4 pu[2] = {(f32x4){0.f, 0.f, 0.f, 0.f}, (f32x4){0.f, 0.f, 0.f, 0.f}};
#pragma unroll
                for (int m = 0; m < 4; ++m) { const int row = rbase + m * 16 + fr; const float rs = rtab[ai * HALF + m * 16];
                    f32x4 cv[2];
#pragma unroll
                    for (int bj = 0; bj < 2; ++bj) { const f32x4 uu = acc[ai][bj][m][n] * rs + bv[bj];
                        if (m == 0 && fr < 2) *(f32x4*)(uh + ((size_t)sb * 4 + fr) * DUP + u.pn * BM + bj * HALF + lc) = uu;
                        if (m == 3 && fr >= 14) *(f32x4*)(uh + ((size_t)sb * 4 + 2 + (fr - 14)) * DUP + u.pn * BM + bj * HALF + lc) = uu;
                        f32x4 c = cb[bj] + w2[bj] * uu;
#pragma unroll
                        for (int i = 0; i < 4; ++i) { const float u1 = dpp_old<0x111>(dpp0<0x10F>(pu[bj][i]), uu[i]), u2 = dpp_old<0x112>(dpp0<0x10E>(pu[bj][i]), uu[i]);
                            c[i] += w1[bj][i] * u1 + w0[bj][i] * u2; }
                        cv[bj] = c; pu[bj] = uu; }
                    f32x4 o;
#pragma unroll
                    for (int i = 0; i < 4; ++i) o[i] = cv[0][i] * sigmoid_f(cv[0][i]) * cv[1][i];
                    { u32x2 w; w.x = cvt_pk_bf16(o[0], o[1]); w.y = cvt_pk_bf16(o[2], o[3]);
                      if (n == 0) keep[ai][m] = w; else if (!(m == 0 && fr < 2)) { u32x4 w4; w4.x = keep[ai][m].x; w4.y = keep[ai][m].y; w4.z = w.x; w4.w = w.y; *(u32x4*)(act + (size_t)row * DFF + ca - 4) = w4; } }
                    asm volatile("" ::: "memory"); }
            }
        }
    }
};
}

constexpr int PTR_OFF = RING_BYTES + 512;
__device__ __forceinline__ unsigned long long lds_ptr(LAS unsigned char* lds, int i) {
    const volatile LAS unsigned* p = (const volatile LAS unsigned*)(lds + PTR_OFF) + 2 * i;
    const unsigned lo = __builtin_amdgcn_readfirstlane(p[0]), hi = __builtin_amdgcn_readfirstlane(p[1]);
    return ((unsigned long long)hi << 32) | lo;
}

#define XB_TMO      128
#define XB_XCNT(j)  (256  + 64 * (j))
#define XB_XSUB(j)  (1280 + 64 * (j))
#define XB_XGEN(j)  (2304 + 64 * (j))
#define XB_TOP      3328
#define XB_TOPGEN   3392
#define XCD_BAR_WORDS 3456
#define XB_SPIN_CAP (1u << 18)
__device__ __forceinline__ unsigned xb_ld(unsigned* p)              { return __hip_atomic_load(p, __ATOMIC_RELAXED, __HIP_MEMORY_SCOPE_AGENT); }
__device__ __forceinline__ unsigned xb_add(unsigned* p, unsigned v) { return __hip_atomic_fetch_add(p, v, __ATOMIC_RELAXED, __HIP_MEMORY_SCOPE_AGENT); }
__device__ __forceinline__ unsigned xb_xcc_id() { return (unsigned)__builtin_amdgcn_s_getreg((3 << 11) | 20) & 0xFu; }
#define XB_SPIN(cond, bar) do { unsigned _sp = 0; while (cond) { __builtin_amdgcn_s_sleep(1); \
    if ((++_sp & 255u) == 0u) { if (xb_ld(&(bar)[XB_TMO])) break; if (_sp > XB_SPIN_CAP) { atomicAdd(&(bar)[XB_TMO], 1u); break; } } } } while (0)
struct XcdBarrier { unsigned* bar; unsigned x; volatile LAS unsigned* st; };
__device__ __forceinline__ XcdBarrier xcd_barrier_post(unsigned* bar, volatile LAS unsigned* st) {
    XcdBarrier b; b.bar = bar; b.x = xb_xcc_id(); b.st = st;
    if (threadIdx.x == 0) (void)xb_add(&bar[XB_XCNT(b.x)], 1u);
    return b;
}
__device__ __forceinline__ void xcd_barrier_complete(unsigned* bar, unsigned x, unsigned& nloc, unsigned& nx) {
    const unsigned G = gridDim.x * gridDim.y * gridDim.z;
    unsigned sum, cnt, mine, sp = 0u;
    for (;;) {
        sum = 0u; cnt = 0u; mine = 0u;
#pragma unroll
        for (unsigned j = 0; j < 16; ++j) { const unsigned c = xb_ld(&bar[XB_XCNT(j)]); sum += c; cnt += (c > 0u) ? 1u : 0u; mine = (j == x) ? c : mine; }
        if (sum == G) break;
        __builtin_amdgcn_s_sleep(1);
        if ((++sp & 255u) == 0u) { if (xb_ld(&bar[XB_TMO])) break; if (sp > XB_SPIN_CAP) { atomicAdd(&bar[XB_TMO], 1u); break; } }
    }
    nloc = mine > 0u ? mine : 1u; nx = cnt > 0u ? cnt : 1u;
}
__device__ __forceinline__ void xcd_barrier(LAS unsigned char* lds) {
    asm volatile("s_waitcnt vmcnt(0)" ::: "memory");
    __syncthreads();
    if (threadIdx.x == 0) {
        XcdBarrier b; b.bar = (unsigned*)(lds_ptr(lds, 27) + WS_CTL) + CW_BAR; b.x = xb_xcc_id(); b.st = (volatile LAS unsigned*)(lds + MISC_OFF) + 8;
        unsigned* bar = b.bar; unsigned bx_ = b.x;
        asm volatile("" : "+v"(bar), "+s"(bx_));
        __builtin_amdgcn_s_waitcnt(0);
        unsigned nloc = b.st[0], nx = b.st[1];
        if (nloc == 0u) { xcd_barrier_complete(bar, bx_, nloc, nx); b.st[0] = nloc; b.st[1] = nx; }
        const unsigned old = xb_add(&bar[XB_XSUB(bx_)], 1u);
        const unsigned gen = old / nloc;
        if (old + 1u == (gen + 1u) * nloc) {
            __builtin_amdgcn_fence(__ATOMIC_RELEASE, "agent");
            asm volatile("s_waitcnt vmcnt(0)" ::: "memory");
            const unsigned og = xb_add(&bar[XB_TOP], 1u);
            const unsigned tg = og / nx;
            if (og + 1u == (tg + 1u) * nx) xb_add(&bar[XB_TOPGEN], 1u);
            else XB_SPIN(xb_ld(&bar[XB_TOPGEN]) == tg, bar);
            __builtin_amdgcn_fence(__ATOMIC_ACQUIRE, "agent");
            xb_add(&bar[XB_XGEN(bx_)], 1u);
            asm volatile("s_waitcnt vmcnt(0)" ::: "memory");
        } else {
            XB_SPIN(xb_ld(&bar[XB_XGEN(bx_)]) == gen, bar);
            __builtin_amdgcn_fence(__ATOMIC_ACQUIRE, "agent");
            asm volatile("s_waitcnt vmcnt(0)" ::: "memory");
        }
    }
    __syncthreads();
}

struct Args { const float* in[26]; float* out; unsigned char* ws; int ph_lo, ph_hi; };
enum { I_X = 0, I_C, I_ADAW, I_ADAB, I_NMG, I_WIN, I_BIN, I_CONVW, I_CONVB, I_WA, I_BA, I_WX, I_BX, I_LAM, I_POOLW, I_POOLB, I_POOLS, I_PROJA, I_PROJB, I_WOUT, I_NFG, I_WUP, I_FCW, I_FCB, I_WDOWN, I_FING };

template <bool BIAS>
__device__ __forceinline__ void cvt_item(const float* src, int N, bf16_t* dst, int dpitch, int k0, int n0, int drow0, int dcol, int lane,
                                         const float* sh0 = nullptr, const float* sh1 = nullptr, float* bias0 = nullptr, float* bias1 = nullptr, const float* binit = nullptr, int dstep = 32) {
    const int r = lane >> 3, q = lane & 7;
    f32x4 s0 = (f32x4){0.f, 0.f, 0.f, 0.f}, s1 = s0, t0 = s0, t1 = s0;
    f32x4 vv[2][8];
#pragma unroll
    for (int c = 0; c < 2; ++c)
#pragma unroll
        for (int j = 0; j < 8; ++j) vv[c][j] = __builtin_nontemporal_load((const f32x4*)(src + (size_t)(k0 + 8 * r + j) * N + n0 + 32 * c + 4 * q));
    if constexpr (BIAS) {
        const int kk = k0 + 8 * r; const f32x4 a0 = *(const f32x4*)(sh0 + kk), a1 = *(const f32x4*)(sh0 + kk + 4), b0 = *(const f32x4*)(sh1 + kk), b1 = *(const f32x4*)(sh1 + kk + 4);
#pragma unroll
        for (int j = 0; j < 4; ++j) { s0 += a0[j] * vv[0][j] + a1[j] * vv[0][4 + j]; s1 += b0[j] * vv[0][j] + b1[j] * vv[0][4 + j]; t0 += a0[j] * vv[1][j] + a1[j] * vv[1][4 + j]; t1 += b0[j] * vv[1][j] + b1[j] * vv[1][4 + j]; }
    }
#pragma unroll
    for (int c = 0; c < 2; ++c) {
        const f32x4 (&v)[8] = vv[c];
#pragma unroll
        for (int i = 0; i < 4; ++i) { u32x4 w; w.x = cvt_pk_bf16(v[0][i], v[1][i]); w.y = cvt_pk_bf16(v[2][i], v[3][i]); w.z = cvt_pk_bf16(v[4][i], v[5][i]); w.w = cvt_pk_bf16(v[6][i], v[7][i]);
            *(u32x4*)(dst + (size_t)(drow0 + dstep * c + 4 * q + i) * dpitch + dcol + k0 + 8 * r) = w; }
    }
    if constexpr (BIAS) {
        const int ii = r & 3, cc = r >> 2, col = 32 * cc + 4 * q + ii;
        f32x4 k0 = cc ? t0 : s0, x0 = cc ? s0 : t0, k1 = cc ? t1 : s1, x1 = cc ? s1 : t1;
#pragma unroll
        for (int i = 0; i < 4; ++i) { k0[i] += __shfl_xor(x0[i], 32); k1[i] += __shfl_xor(x1[i], 32); }
        const bool h1 = (r & 2) != 0, h0 = (r & 1) != 0;
        float a0 = h1 ? k0[2] : k0[0], a1 = h1 ? k0[3] : k0[1], b0 = h1 ? k1[2] : k1[0], b1 = h1 ? k1[3] : k1[1];
        const float xa0 = h1 ? k0[0] : k0[2], xa1 = h1 ? k0[1] : k0[3], xb0 = h1 ? k1[0] : k1[2], xb1 = h1 ? k1[1] : k1[3];
        a0 += __shfl_xor(xa0, 16); a1 += __shfl_xor(xa1, 16); b0 += __shfl_xor(xb0, 16); b1 += __shfl_xor(xb1, 16);
        float v0 = h0 ? a1 : a0, v1 = h0 ? b1 : b0;
        v0 += __shfl_xor(h0 ? a0 : a1, 8); v1 += __shfl_xor(h0 ? b0 : b1, 8);
        if (binit) { const float bi = binit[n0 + col]; v0 += bi; v1 += bi; }
        const int brow = drow0 + dstep * cc + 4 * q + ii;
        bias0[brow] = v0; bias1[brow] = v1;
    }
}
constexpr int IT_WIN = (DM / 64) * (DIN / 64), IT_LRU = 16 * 16, IT_POOL = 4 * 16, IT_PA = 32 * 32, IT_PB = 16 * 32, IT_WO = 32 * 32, IT_WUP = 32 * (DUP / 64), IT_WD = (DFF / 64) * 32;
constexpr int IT_LAYER = IT_WIN + IT_LRU + IT_POOL + IT_PA + IT_PB + IT_WO + IT_WUP + IT_WD;
__device__ __forceinline__ void cvt_one(const Args& a, int it, int lane) {
    const float* mod = (const float*)(a.ws + WS_MOD);
    {
        const int l = it / IT_LAYER; int r = it % IT_LAYER;
        bf16_t* wl = (bf16_t*)(a.ws + WS_W + (size_t)l * W_LAYER);
        const float* sh = mod + (size_t)l * NB * NADA;
        if (r < IT_WIN) { const int kb = r / (DIN / 64), nb = r % (DIN / 64), n0 = 64 * nb; int drow = n0;
            int dstep = 32;
            if (n0 >= 5120) { const int gsel = n0 - 5120, isb = gsel / 2048, ch = gsel % 2048; drow = 5120 + 256 * (ch / 128) + 64 * ((ch % 128) / 32) + 32 * isb; dstep = 64; }
            float* bo = (float*)(a.ws + WS_PB1) + ((size_t)(l * NB) * 32 + kb) * DIN;
            cvt_item<true>(a.in[I_WIN] + (size_t)l * DM * DIN, DIN, wl + W_BT1 / 2, DM, 64 * kb, n0, drow, 0, lane, sh, sh + NADA, bo, bo + (size_t)32 * DIN, kb == 0 ? a.in[I_BIN] + (size_t)l * DIN : nullptr, dstep); return; } r -= IT_WIN;
        if (r < IT_LRU) { const int mat = r / 16, idx = r % 16, isx = mat / 8, h = mat % 8, kb = idx / 4, nb = idx % 4, n0 = 64 * nb;
            const float* src = a.in[isx ? I_WX : I_WA] + ((size_t)l * 8 + h) * 256 * 256;
            cvt_item<false>(src, 256, wl + W_BTG / 2, 256, 64 * kb, n0, 512 * h + 256 * (n0 / 128) + 64 * ((n0 % 128) / 32) + 32 * isx, 0, lane, nullptr, nullptr, nullptr, nullptr, nullptr, 64); return; } r -= IT_LRU;
        if (r < IT_POOL) { const int gI = r / 16, idx = r % 16, kb = idx / 4, nb = idx % 4;
            cvt_item<false>(a.in[I_POOLW] + ((size_t)l * 4 + gI) * 256 * 256, 256, wl + W_BTP / 2, 256, 64 * kb, 64 * nb, 256 * gI + 64 * nb, 0, lane); return; } r -= IT_POOL;
        if (r < IT_PA) { const int kb = r / 32, nb = r % 32; cvt_item<false>(a.in[I_PROJA] + (size_t)l * DRNN * DM, DM, wl + W_BT3 / 2, 3072, 64 * kb, 64 * nb, 64 * nb, 0, lane); return; } r -= IT_PA;
        if (r < IT_PB) { const int kb = r / 32, nb = r % 32; cvt_item<false>(a.in[I_PROJB] + (size_t)l * DPOOL * DM, DM, wl + W_BT3 / 2, 3072, 64 * kb, 64 * nb, 64 * nb, 2048, lane); return; } r -= IT_PB;
        if (r < IT_WO) { const int kb = r / 32, nb = r % 32; cvt_item<false>(a.in[I_WOUT] + (size_t)l * DM * DM, DM, wl + W_BT4 / 2, DM, 64 * kb, 64 * nb, 64 * nb, 0, lane); return; } r -= IT_WO;
        if (r < IT_WUP) { const int kb = r / (DUP / 64), nb = r % (DUP / 64), n0 = 64 * nb, isl = n0 / DFF, ch = n0 % DFF;
            float* bo = (float*)(a.ws + WS_PB2) + ((size_t)(l * NB) * 32 + kb) * DUP;
            cvt_item<true>(a.in[I_WUP] + (size_t)l * DM * DUP, DUP, wl + W_BT5 / 2, DM, 64 * kb, n0, 256 * (ch / 128) + 128 * isl + (ch % 128), 0, lane, sh + 3 * DM, sh + NADA + 3 * DM, bo, bo + (size_t)32 * DUP, nullptr); return; } r -= IT_WUP;
        { const int kb = r / 32, nb = r % 32; cvt_item<false>(a.in[I_WDOWN] + (size_t)l * DFF * DM, DM, wl + W_BT6 / 2, DFF, 64 * kb, 64 * nb, 64 * nb, 0, lane); }
    }
}
__device__ __forceinline__ void p0_convert(const Args& a, int lo, int hi, int widx, int nw, int lane, unsigned* cnt = nullptr, int shard = 0) {
    if (cnt == nullptr) { for (int it = lo + widx; it < hi; it += nw) cvt_one(a, it, lane); return; }
    const int per = (hi - lo + 7) / 8, slo = lo + shard * per, shi = (slo + per < hi) ? slo + per : hi;
    for (;;) {
        unsigned base = 0; if (lane == 0) base = atomicAdd(cnt + 64 * shard, 2u);
        const int it0 = slo + (int)__builtin_amdgcn_readfirstlane(base);
        if (it0 >= shi) break;
        cvt_one(a, it0, lane); if (it0 + 1 < shi) cvt_one(a, it0 + 1, lane);
    }
}
constexpr int CVT_A_LO = 0, CVT_A_HI = IT_WIN;
__host__ __device__ constexpr int cvt_b_lo(int l) { return l * IT_LAYER + IT_WIN; }
__host__ __device__ constexpr int cvt_b_hi(int l) { return (l + 1) * IT_LAYER - IT_WD; }
__host__ __device__ constexpr int cvt_c_lo(int l) { return (l + 1) * IT_LAYER - IT_WD; }
__host__ __device__ constexpr int cvt_c_hi(int l) { return l + 1 < NL ? (l + 1) * IT_LAYER + IT_WIN : (l + 1) * IT_LAYER; }
__device__ __forceinline__ void p0_ada(const Args& a, LAS unsigned char* lds, int G, int tid, int bx) {
    const int wave = tid >> 6, lane = tid & 63;
    LAS float* cact = (LAS float*)lds;
    LAS float* red = (LAS float*)(lds + 16384);
    for (int i = tid; i < NB * DM; i += 512) { const float v = a.in[I_C][i]; cact[i] = v * sigmoid_f(v); }
    __syncthreads();
    float* mod = (float*)(a.ws + WS_MOD);
    for (int un = bx; un < NL * (NADA / 32); un += G) {
        const int l = un / (NADA / 32), nb = un % (NADA / 32);
        const float* wsrc = a.in[I_ADAW] + (size_t)l * DM * NADA + nb * 32 + 4 * (lane & 7);
        f32x4 s0 = (f32x4){0.f, 0.f, 0.f, 0.f}, s1 = s0;
#pragma unroll 8
        for (int rg = wave; rg < 256; rg += 8) { const int k = rg * 8 + (lane >> 3); const f32x4 wv = __builtin_nontemporal_load((const f32x4*)(wsrc + (size_t)k * NADA)); s0 += cact[k] * wv; s1 += cact[DM + k] * wv; }
#pragma unroll
        for (int i = 0; i < 4; ++i) {
#pragma unroll
            for (int o = 8; o < 64; o <<= 1) { s0[i] += __shfl_xor(s0[i], o); s1[i] += __shfl_xor(s1[i], o); } }
        if (lane < 8) {
#pragma unroll
            for (int i = 0; i < 4; ++i) { red[(wave * 2 + 0) * 32 + 4 * lane + i] = s0[i]; red[(wave * 2 + 1) * 32 + 4 * lane + i] = s1[i]; } }
        __syncthreads();
        if (tid < 64) { const int b = tid >> 5, c = tid & 31; float s = 0.f;
#pragma unroll
            for (int w = 0; w < 8; ++w) s += red[(w * 2 + b) * 32 + c];
            mod[((size_t)l * NB + b) * NADA + nb * 32 + c] = s + a.in[I_ADAB][(size_t)l * NADA + nb * 32 + c]; }
        __syncthreads();
    }
}

__device__ __forceinline__ void p0b(const Args& a, int gw, int ngw, int lane, int gtid, int ngt) {
    const float* mod = (const float*)(a.ws + WS_MOD);
    for (int i = gtid; i < NL * NB * DM; i += ngt) { const int l = i / (NB * DM), b = (i / DM) % NB, c = i % DM; const float* mm = mod + ((size_t)l * NB + b) * NADA;
        ((float*)(a.ws + WS_GM1))[i] = a.in[I_NMG][l * DM + c] * (1.f + mm[DM + c]);
        ((float*)(a.ws + WS_GT1))[i] = mm[2 * DM + c];
        ((float*)(a.ws + WS_GM2))[i] = a.in[I_NFG][l * DM + c] * (1.f + mm[4 * DM + c]);
        ((float*)(a.ws + WS_GT2))[i] = mm[5 * DM + c]; }
    for (int i = gtid; i < NL * DRNN; i += ngt) { const float lam = a.in[I_LAM][i]; ((float*)(a.ws + WS_LRUK))[i] = -8.0f * log1pf(expf(-lam)); }
    p0_convert(a, CVT_A_LO, CVT_A_HI, gw, ngw, lane);
    float* ss = (float*)(a.ws + WS_SS); bf16_t* xg = (bf16_t*)(a.ws + WS_XG);
    for (int row = gw; row < M; row += ngw) { const int b = row / SEQ; const float* xr = a.in[I_X] + (size_t)row * DM; const float* mm = mod + (size_t)b * NADA + DM; float s = 0.f;
#pragma unroll
        for (int j = 0; j < 8; ++j) { const int c = (j * 64 + lane) * 4; const f32x4 xv = __builtin_nontemporal_load((const f32x4*)(xr + c)), gv = *(const f32x4*)(a.in[I_NMG] + c), sc = *(const f32x4*)(mm + c);
            s += (xv[0] * xv[0] + xv[1] * xv[1]) + (xv[2] * xv[2] + xv[3] * xv[3]); const f32x4 y = xv * (gv * (1.f + sc));
            u32x2 w; w.x = cvt_pk_bf16(y[0], y[1]); w.y = cvt_pk_bf16(y[2], y[3]); *(u32x2*)(xg + (size_t)row * DM + c) = w; }
        s = wave_sum(s);
        if (lane < 8) ss[(size_t)lane * M + row] = lane == 0 ? s : 0.f; }
}

__device__ __forceinline__ void build_xr_tile(const Args& a, int l, int pm, int head, int tid) {
    const int strip = tid >> 5, c = head * 256 + (tid & 31) * 8, row0 = pm * 256 + strip * 16, t0 = row0 % SEQ;
    const float* cw = a.in[I_CONVW] + (size_t)l * 4 * DRNN + c; const float* cb = a.in[I_CONVB] + (size_t)l * DRNN + c;
    f32x4 w0[4], w1[4];
#pragma unroll
    for (int k = 0; k < 4; ++k) { w0[k] = *(const f32x4*)(cw + (size_t)k * DRNN); w1[k] = *(const f32x4*)(cw + (size_t)k * DRNN + 4); }
    const f32x4 b0 = *(const f32x4*)cb, b1 = *(const f32x4*)(cb + 4);
    const bf16_t* src = (const bf16_t*)(a.ws + WS_XRNN) + (size_t)row0 * DRNN + c; bf16_t* dst = (bf16_t*)(a.ws + WS_XR) + (size_t)row0 * DRNN + c;
    f32x4 h0[3], h1[3];
#pragma unroll
    for (int d = 0; d < 3; ++d) { h0[d] = (f32x4){0.f, 0.f, 0.f, 0.f}; h1[d] = h0[d]; if (t0 >= 3 - d) { const u32x4 w = *(const u32x4*)(src - (size_t)(3 - d) * DRNN); pg8::unpack8(w, h0[d], h1[d]); } }
#pragma unroll
    for (int j = 0; j < 16; ++j) { const u32x4 w = *(const u32x4*)(src + (size_t)j * DRNN); f32x4 x0, x1; pg8::unpack8(w, x0, x1);
        const f32x4 o0 = b0 + w0[0] * h0[0] + w0[1] * h0[1] + w0[2] * h0[2] + w0[3] * x0, o1 = b1 + w1[0] * h1[0] + w1[1] * h1[1] + w1[2] * h1[2] + w1[3] * x1;
        *(u32x4*)(dst + (size_t)j * DRNN) = pg8::pack8(o0, o1);
        h0[0] = h0[1]; h0[1] = h0[2]; h0[2] = x0; h1[0] = h1[1]; h1[1] = h1[2]; h1[2] = x1; }
}
__device__ __forceinline__ void build_pp_tile(const Args& a, int pm, int g, int tid) {
    const int strip = tid >> 5, c = g * 256 + (tid & 31) * 8, row0 = pm * 256 + strip * 16, t0 = row0 % SEQ, win = 2 << g;
    const bf16_t* src = (const bf16_t*)(a.ws + WS_XPOOL) + (size_t)row0 * DPOOL + c; bf16_t* dst = (bf16_t*)(a.ws + WS_PP) + (size_t)row0 * DPOOL + c;
    f32x4 s0 = (f32x4){0.f, 0.f, 0.f, 0.f}, s1 = s0;
    for (int d = 1; d < win; ++d) if (t0 >= d) { const u32x4 w = *(const u32x4*)(src - (size_t)d * DPOOL); f32x4 y0, y1; pg8::unpack8(w, y0, y1); s0 += y0; s1 += y1; }
#pragma unroll 4
    for (int j = 0; j < 16; ++j) { const int t = t0 + j; const u32x4 w = *(const u32x4*)(src + (size_t)j * DPOOL); f32x4 x0, x1; pg8::unpack8(w, x0, x1); s0 += x0; s1 += x1;
        const float inv = 1.0f / (float)((t + 1 < win) ? t + 1 : win);
        *(u32x4*)(dst + (size_t)j * DPOOL) = pg8::pack8(s0 * inv - x0, s1 * inv - x1);
        if (t - (win - 1) >= 0) { const u32x4 wo = *(const u32x4*)(src + (size_t)(j - (win - 1)) * DPOOL); f32x4 y0, y1; pg8::unpack8(wo, y0, y1); s0 -= y0; s1 -= y1; } }
}

__device__ __forceinline__ void p5_fixup(const Args& a, int l, int gtid, int ngt) {
    const float* uh = (const float*)(a.ws + WS_UH); bf16_t* act = (bf16_t*)(a.ws + WS_ACT);
    const float* cw = a.in[I_FCW] + (size_t)l * 3 * DUP; const float* cb = a.in[I_FCB] + (size_t)l * DUP;
    for (int it = gtid; it < 128 * 2 * DFF; it += ngt) { const int ch = it % DFF, r = (it / DFF) & 1, sb = it / (2 * DFF), row = 64 * sb + r;
        const int j = ch / 128, w = ch % 128; const bool edge = (sb % 64) == 0; float cv[2];
#pragma unroll
        for (int bj = 0; bj < 2; ++bj) { const int tc = 256 * j + 128 * bj + w, nc = bj * DFF + ch;
            const float u0 = uh[((size_t)sb * 4 + r) * DUP + tc];
            float u1, u2;
            if (r == 1) { u1 = uh[((size_t)sb * 4 + 0) * DUP + tc]; u2 = edge ? 0.f : uh[((size_t)(sb - 1) * 4 + 3) * DUP + tc]; }
            else { u1 = edge ? 0.f : uh[((size_t)(sb - 1) * 4 + 3) * DUP + tc]; u2 = edge ? 0.f : uh[((size_t)(sb - 1) * 4 + 2) * DUP + tc]; }
            cv[bj] = cb[nc] + cw[2 * DUP + nc] * u0 + cw[DUP + nc] * u1 + cw[nc] * u2; }
        const float o = cv[0] * sigmoid_f(cv[0]) * cv[1];
        act[(size_t)row * DFF + ch] = (bf16_t)(cvt_pk_bf16(o, 0.f) & 0xffffu); }
}

__device__ __forceinline__ void p_final(const Args& a, int gw, int ngw, int lane) {
    const float* X = (const float*)(a.ws + WS_X); const float* ss = (const float*)(a.ws + WS_SS);
    for (int row = gw; row < M; row += ngw) { const float rs = pg8::row_rstd(ss, row);
#pragma unroll
        for (int j = 0; j < 8; ++j) { const int c = (j * 64 + lane) * 4; *(f32x4*)(a.out + (size_t)row * DM + c) = *(const f32x4*)(X + (size_t)row * DM + c) * rs * *(const f32x4*)(a.in[I_FING] + c); } }
}

constexpr int PH_P0A = 0, PH_P0B = 1, PH_LAYER0 = 2, PH_PER_LAYER = 7, PH_FINAL = -1000, N_PHASES = PH_LAYER0 + NL * PH_PER_LAYER;
__host__ __device__ constexpr int phase_kind(int ph) {
    if (ph == PH_P0A) return 0; if (ph == PH_P0B) return 1; if (ph == PH_FINAL) return 11;
    const int sub = (ph - PH_LAYER0) % PH_PER_LAYER;
    return sub == 0 ? 2 : sub == 1 ? 4 : 4 + sub;
}
template <int KIND, bool DUMMY = false>
__device__ __forceinline__ void run_kind(int ph, LAS unsigned char* lds) {
    int tid = threadIdx.x, bx = blockIdx.x, G = gridDim.x; asm volatile("" : "+v"(tid), "+s"(bx), "+s"(G));
    const int lane = tid & 63, wave = __builtin_amdgcn_readfirstlane(tid >> 6);
    const int vcu = (G % 8 == 0) ? (bx % 8) * (G / 8) + bx / 8 : bx;
    const int gw = vcu * NWAVES + wave, ngw = G * NWAVES, gtid = bx * 512 + tid, ngt = G * 512;
    Args a;
#pragma unroll
    for (int i = 0; i < 26; ++i) a.in[i] = (const float*)lds_ptr(lds, i);
    a.out = (float*)lds_ptr(lds, 26); a.ws = (unsigned char*)lds_ptr(lds, 27); a.ph_lo = ph; a.ph_hi = ph + 1;
    asm volatile("" : "+s"(ph));
    const int l = (ph - PH_LAYER0) / PH_PER_LAYER;
    const bf16_t* wl = (const bf16_t*)(a.ws + WS_W + (size_t)l * W_LAYER);
    const float* ss = (const float*)(a.ws + WS_SS);
    pg8::StaticOrder S;
    if constexpr (KIND == 0) { p0_ada(a, lds, G, tid, bx); }
    else if constexpr (KIND == 1) { p0b(a, gw, ngw, lane, gtid, ngt); }
    else if constexpr (KIND == 11) { p_final(a, gw, ngw, lane); }
    else if constexpr (KIND == 2) {
        const int GGm = (G == 256 && !DUMMY) ? P1_GEMM_WGS : G;
        pg8::Gemm g{(const bf16_t*)(a.ws + WS_XG), wl + W_BT1 / 2, DM, DM, DM / 64, M / 256, DIN / 256, 31, 0}; S.init(g.nM, g.nN, GGm, bx);
        if (bx < GGm) {
        pg8::fill_bias_tab(lds, S, (const float*)(a.ws + WS_PB1) + (size_t)(l * NB) * 32 * DIN, DIN, tid);
        pg8::fill_rstd_tab(lds, S, ss, tid);
        pg8::EpiZ E{(const LAS float*)(lds + pg8::TAB_OFF), (const LAS float*)(lds + pg8::BTAB_OFF), (bf16_t*)(a.ws + WS_XRNN), (bf16_t*)(a.ws + WS_GG), (bf16_t*)(a.ws + WS_XPOOL), (bf16_t*)(a.ws + WS_RATIO), -1};
        pg8::gemm_phase<pg8::EpiZ, true>(lds, g, S, E);
        }
        if (!DUMMY) p0_convert(a, cvt_b_lo(l), cvt_b_hi(l), gw, ngw, lane, (unsigned*)(a.ws + WS_CTL) + CW_CVT + 512 * (2 * l), bx & 7);
    } else if constexpr (KIND == 4) {
        { pg8::Gemm g{(const bf16_t*)(a.ws + WS_XR), wl + W_BTG / 2, DRNN, 256, 4, M / 256, 16, 1, 256}; pg8::GateOrder GO{bx};
          { pg8::Unit u; for (int i = 0; i < 2 && GO.next(i, u); ++i) build_xr_tile(a, l, u.pm, u.pn >> 1, tid); }
          asm volatile("s_waitcnt vmcnt(0)" ::: "memory"); __syncthreads();
          pg8::EpiGates E{a.in[I_BA] + (size_t)l * DRNN, a.in[I_BX] + (size_t)l * DRNN, (const float*)(a.ws + WS_LRUK) + (size_t)l * DRNN, (const bf16_t*)(a.ws + WS_XR), (const bf16_t*)(a.ws + WS_GG), (bf16_t*)(a.ws + WS_YAB),
                          (unsigned long long*)(a.ws + WS_AGG) + (size_t)l * NB * 16 * DRNN, lds, -1};
          pg8::gemm_phase<pg8::EpiGates, true, pg8::GateOrder>(lds, g, GO, E); }
    } else if constexpr (KIND == 12) {
        { pg8::Gemm g{(const bf16_t*)(a.ws + WS_PP), wl + W_BTP / 2, DPOOL, 256, 4, M / 256, 4, 0, 256}; S.init(g.nM, g.nN, G, bx);
          { pg8::Unit u; for (int i = 0; i < 8 && S.next(i, u); ++i) build_pp_tile(a, u.pm, u.pn, tid); }
          asm volatile("s_waitcnt vmcnt(0)" ::: "memory"); __syncthreads();
          pg8::EpiPool E{a.in[I_POOLB] + (size_t)l * DPOOL, a.in[I_POOLS] + (size_t)l * DPOOL, (bf16_t*)(a.ws + WS_YAB), -1};
          pg8::gemm_phase<pg8::EpiPool, true>(lds, g, S, E); }
    } else if constexpr (KIND == 6) {
        pg8::Gemm g{(const bf16_t*)(a.ws + WS_YAB), wl + W_BT3 / 2, 3072, 3072, 48, M / 256, DM / 256, 31, 0}; S.init(g.nM, g.nN, G, bx);
        pg8::EpiMerge E{(const bf16_t*)(a.ws + WS_RATIO), (bf16_t*)(a.ws + WS_MERGED), 32};
        pg8::gemm_phase<pg8::EpiMerge, false>(lds, g, S, E);
    } else if constexpr (KIND == 7) {
        pg8::Gemm g{(const bf16_t*)(a.ws + WS_MERGED), wl + W_BT4 / 2, DM, DM, DM / 64, M / 256, DM / 256, 31, 0}; S.init(g.nM, g.nN, G, bx);
        const float* gt1 = (const float*)(a.ws + WS_GT1) + (size_t)l * NB * DM; const float* gm2 = (const float*)(a.ws + WS_GM2) + (size_t)l * NB * DM;
        if (l == 0) { pg8::EpiResid<true> E{a.in[I_X], nullptr, nullptr, (bf16_t*)(a.ws + WS_XG), gt1, gm2, (float*)(a.ws + WS_SS), -1}; pg8::gemm_phase<pg8::EpiResid<true>, false>(lds, g, S, E); }
        else { pg8::EpiResid<false> E{nullptr, (const bf16_t*)(a.ws + WS_XG), (const float*)(a.ws + WS_GM1) + (size_t)l * NB * DM, (bf16_t*)(a.ws + WS_XG), gt1, gm2, (float*)(a.ws + WS_SS), -1}; pg8::gemm_phase<pg8::EpiResid<false>, false>(lds, g, S, E); }
    } else if constexpr (KIND == 8) {
        const int GGm = (G == 256 && !DUMMY) ? P5_GEMM_WGS : G;
        pg8::Gemm g{(const bf16_t*)(a.ws + WS_XG), wl + W_BT5 / 2, DM, DM, DM / 64, M / 256, DUP / 256, 31, 0}; S.init(g.nM, g.nN, GGm, bx);
        if (bx < GGm) {
        pg8::fill_bias_tab(lds, S, (const float*)(a.ws + WS_PB2) + (size_t)(l * NB) * 32 * DUP, DUP, tid);
        pg8::fill_rstd_tab(lds, S, ss, tid);
        pg8::EpiUp E{(const LAS float*)(lds + pg8::TAB_OFF), (const LAS float*)(lds + pg8::BTAB_OFF), a.in[I_FCW] + (size_t)l * 3 * DUP, a.in[I_FCB] + (size_t)l * DUP, (bf16_t*)(a.ws + WS_ACT), (float*)(a.ws + WS_UH), -1};
        pg8::gemm_phase<pg8::EpiUp, true>(lds, g, S, E);
        }
        if (!DUMMY) p0_convert(a, cvt_c_lo(l), cvt_c_hi(l), gw, ngw, lane, (unsigned*)(a.ws + WS_CTL) + CW_CVT + 512 * (2 * l + 1), bx & 7);
    } else if constexpr (KIND == 9) { p5_fixup(a, l, gtid, ngt);
    } else {
        pg8::Gemm g{(const bf16_t*)(a.ws + WS_ACT), wl + W_BT6 / 2, DFF, DFF, DFF / 64, M / 256, DM / 256, 31, 0}; S.init(g.nM, g.nN, G, bx);
        if (l == NL - 1 && !DUMMY) {
            pg8::EpiFinal E{(const bf16_t*)(a.ws + WS_XG), (const float*)(a.ws + WS_GM2) + (size_t)l * NB * DM, a.out, (const float*)(a.ws + WS_GT2) + (size_t)l * NB * DM, a.in[I_FING], (unsigned*)(a.ws + WS_FSS), -1};
            pg8::gemm_phase<pg8::EpiFinal, false>(lds, g, S, E);
        } else {
        pg8::EpiResid<false> E{nullptr, (const bf16_t*)(a.ws + WS_XG), (const float*)(a.ws + WS_GM2) + (size_t)l * NB * DM, (bf16_t*)(a.ws + (DUMMY ? WS_RATIO : WS_XG)), (const float*)(a.ws + WS_GT2) + (size_t)l * NB * DM,
                        (const float*)(a.ws + WS_GM1) + (size_t)(l + 1 < NL ? l + 1 : l) * NB * DM, (float*)(a.ws + (DUMMY ? WS_AGG : WS_SS)), -1};
        pg8::gemm_phase<pg8::EpiResid<false>, false>(lds, g, S, E);
        }
    }
}
#define MK_PROLOGUE \
    extern __shared__ __attribute__((aligned(16))) unsigned char lds_raw[]; \
    LAS unsigned char* lds = (LAS unsigned char*)lds_raw; \
    const int tid = threadIdx.x; \
    volatile LAS unsigned* MISC = (volatile LAS unsigned*)(lds + MISC_OFF); \
    for (int u = tid; u < (LDS_BYTES - RING_BYTES) / 4; u += 512) ((LAS unsigned*)(lds + RING_BYTES))[u] = 0u; \
    __syncthreads(); \
    if (tid == 0) { LAS unsigned long long* pt = (LAS unsigned long long*)(lds + PTR_OFF); \
        _Pragma("unroll") for (int i = 0; i < 26; ++i) pt[i] = (unsigned long long)a.in[i]; \
        pt[26] = (unsigned long long)a.out; pt[27] = (unsigned long long)a.ws; } \
    __syncthreads();

#if MK_ONE_LAUNCH
template <int PH> __device__ __forceinline__ void run_from(LAS unsigned char* lds) {
    if constexpr (PH < N_PHASES) {
        if constexpr (PH == PROBE_PH) { run_kind<phase_kind(PH), true>(PH, lds); if constexpr (phase_kind(PH) == 4) run_kind<12, true>(PH, lds); xcd_barrier(lds); }
        run_kind<phase_kind(PH)>(PH, lds);
        if constexpr (phase_kind(PH) == 4) run_kind<12>(PH, lds);
        if constexpr (PH + 1 < N_PHASES) xcd_barrier(lds);
        run_from<PH + 1>(lds);
    }
}
__global__ void __launch_bounds__(NWAVES * 64, 2) mk_fwd(Args a) {
    MK_PROLOGUE
    (void)xcd_barrier_post((unsigned*)(a.ws + WS_CTL) + CW_BAR, MISC + 8);
    run_from<0>(lds);
}
#else
template <int KIND>
__global__ void __launch_bounds__(NWAVES * 64, 2) mk_phase(Args a) {
    MK_PROLOGUE
    (void)MISC;
    run_kind<KIND>(a.ph_lo, lds);
}
#endif

#if !MK_ONE_LAUNCH
template <int KIND> static void launch_kind(int grid, hipStream_t stream, const Args& a) {
    static bool attr = false;
    if (!attr) { (void)hipFuncSetAttribute((const void*)mk_phase<KIND>, hipFuncAttributeMaxDynamicSharedMemorySize, LDS_BYTES); attr = true; }
    hipLaunchKernelGGL(mk_phase<KIND>, dim3(grid), dim3(NWAVES * 64), LDS_BYTES, stream, a);
}
#endif
extern "C" void kernel_launch(void* const* d_in, const int* in_sizes, int n_in, void* d_out, int out_size, void* d_ws, size_t ws_size, hipStream_t stream) {
    static int grid = 0;
    if (grid == 0) {
        if (n_in != 26 || out_size != M * DM || ws_size < WS_END) { fprintf(stderr, "kernel_launch: unexpected problem (n_in %d out %d ws %zu need %zu)\n", n_in, out_size, ws_size, (size_t)WS_END); grid = -1; return; }
        int dev = 0, cus = 0;
        if (hipGetDevice(&dev) != hipSuccess || hipDeviceGetAttribute(&cus, hipDeviceAttributeMultiprocessorCount, dev) != hipSuccess) { grid = -1; return; }
#if MK_ONE_LAUNCH
        if (hipFuncSetAttribute((const void*)mk_fwd, hipFuncAttributeMaxDynamicSharedMemorySize, LDS_BYTES) != hipSuccess) { fprintf(stderr, "kernel_launch: hipFuncSetAttribute failed\n"); grid = -1; return; }
#endif
        (void)hipGetLastError();
        grid = cus;
        if (grid != 256) fprintf(stderr, "kernel_launch: %d CUs; the residual GEMM phases need exactly 256 workgroups\n", grid);
    }
    if (grid < 0) return;
    (void)hipMemsetAsync((char*)d_ws + WS_CTL, 0, CTL_ZERO_BYTES, stream);
    Args a{};
    for (int i = 0; i < 26; ++i) a.in[i] = (const float*)d_in[i];
    a.out = (float*)d_out; a.ws = (unsigned char*)d_ws;
#if MK_ONE_LAUNCH
    a.ph_lo = 0; a.ph_hi = N_PHASES;
    hipLaunchKernelGGL(mk_fwd, dim3(grid), dim3(NWAVES * 64), LDS_BYTES, stream, a);
#else
    for (int ph = 0; ph < N_PHASES; ++ph) { a.ph_lo = ph; a.ph_hi = ph + 1;
        switch (phase_kind(ph)) {
            case 0: launch_kind<0>(grid, stream, a); break;  case 1: launch_kind<1>(grid, stream, a); break;  case 2: launch_kind<2>(grid, stream, a); break;
            case 4: launch_kind<4>(grid, stream, a); launch_kind<12>(grid, stream, a); break;
            case 6: launch_kind<6>(grid, stream, a); break;  case 7: launch_kind<7>(grid, stream, a); break;  case 8: launch_kind<8>(grid, stream, a); break;
            case 9: launch_kind<9>(grid, stream, a); break;  case 10: launch_kind<10>(grid, stream, a); break; default: launch_kind<11>(grid, stream, a); break;
        } }
#endif
}
```

```cpp
#include <hip/hip_runtime.h>
#include <cstdio>
#include <cstdint>

#ifndef PROBE_PH
#define PROBE_PH -1
#endif
#ifndef P1_GEMM_WGS
#define P1_GEMM_WGS 232
#endif
#ifndef P5_GEMM_WGS
#define P5_GEMM_WGS 240
#endif
#ifndef MK_ONE_LAUNCH
#define MK_ONE_LAUNCH 1
#endif

#define GAS __attribute__((address_space(1)))
#define LAS __attribute__((address_space(3)))
typedef unsigned short bf16_t;
typedef short bf16x8 __attribute__((ext_vector_type(8)));
typedef float f32x4 __attribute__((ext_vector_type(4)));
typedef float f32x2 __attribute__((ext_vector_type(2)));
typedef unsigned u32x4 __attribute__((ext_vector_type(4)));
typedef unsigned u32x2 __attribute__((ext_vector_type(2)));

constexpr int NB = 2, SEQ = 4096, DM = 2048, M = NB * SEQ, DRNN = 2048, DPOOL = 1024, DIN = 9216, DFF = 5632, DUP = 11264, NADA = 12288, NL = 2;
constexpr float EPS = 1e-6f;
constexpr int NWAVES = 8;
constexpr int LDS_BYTES = 147456;
constexpr int RING_BYTES = 131072;
constexpr int MISC_OFF = RING_BYTES + 320;

constexpr size_t MiB = 1u << 20;
constexpr size_t WS_CTL = 0, CTL_ZERO_BYTES = 4 * MiB;
constexpr size_t WS_MOD = 1 * MiB;
constexpr size_t WS_GM1 = WS_MOD + (size_t)NL * NB * NADA * 4;
constexpr size_t WS_GT1 = WS_GM1 + (size_t)NL * NB * DM * 4;
constexpr size_t WS_GM2 = WS_GT1 + (size_t)NL * NB * DM * 4;
constexpr size_t WS_GT2 = WS_GM2 + (size_t)NL * NB * DM * 4;
constexpr size_t WS_LRUK = WS_GT2 + (size_t)NL * NB * DM * 4;
constexpr size_t WS_BIAS1 = WS_LRUK + (size_t)NL * DRNN * 4;
constexpr size_t WS_BIAS2 = WS_BIAS1 + (size_t)NL * NB * DIN * 4;
constexpr size_t WS_SS = WS_BIAS2 + (size_t)NL * NB * DUP * 4;
static_assert(WS_SS + 8 * (size_t)M * 4 <= 2 * MiB, "small region");
constexpr size_t WS_AGG = 2 * MiB;
constexpr size_t WS_FSS = 3 * MiB;
constexpr size_t WS_W = 4 * MiB;
constexpr size_t W_BT1 = 0, W_BTG = 36 * MiB, W_BTP = 38 * MiB, W_BT3 = 39 * MiB, W_BT4 = 51 * MiB, W_BT5 = 59 * MiB, W_BT6 = 103 * MiB, W_LAYER = 125 * MiB;
static_assert((size_t)DIN * DM * 2 == 36 * MiB && (size_t)DUP * DM * 2 == 44 * MiB && (size_t)DM * DFF * 2 == 22 * MiB, "weight sizes");
constexpr size_t WS_X = WS_W + 2 * W_LAYER;
constexpr size_t WS_PB1 = WS_X;
constexpr size_t WS_PB2 = WS_X + 16 * MiB;
static_assert((size_t)NL * NB * 32 * DIN * 4 <= 16 * MiB && (size_t)NL * NB * 32 * DUP * 4 <= 16 * MiB, "partial bias rows");
constexpr size_t WS_XG = WS_X + 64 * MiB;
constexpr size_t WS_XRNN = WS_XG + 32 * MiB;
constexpr size_t WS_GG = WS_XRNN + 32 * MiB;
constexpr size_t WS_XPOOL = WS_GG + 32 * MiB;
constexpr size_t WS_RATIO = WS_XPOOL + 16 * MiB;
constexpr size_t WS_GB = WS_RATIO + 32 * MiB;
constexpr size_t WS_XR = WS_GB + 32 * MiB;
constexpr size_t WS_MERGED = WS_XR;
constexpr size_t WS_PP = WS_XR + 32 * MiB;
constexpr size_t WS_YAB = WS_PP + 16 * MiB;
constexpr size_t WS_AA = WS_YAB + 48 * MiB;
constexpr size_t WS_BB = WS_AA + 64 * MiB;
constexpr size_t WS_ACT = WS_AA;
constexpr size_t WS_UH = WS_ACT + 88 * MiB;
constexpr size_t WS_END = WS_BB + 64 * MiB;
static_assert(WS_UH + (size_t)128 * 4 * DUP * 4 <= WS_END, "ws map");
constexpr int CW_BAR = 4096;
constexpr int CW_CVT = 8192;

__device__ __forceinline__ unsigned cvt_pk_bf16(float lo, float hi) { unsigned r; asm("v_cvt_pk_bf16_f32 %0, %1, %2" : "=v"(r) : "v"(lo), "v"(hi)); return r; }
__device__ __forceinline__ float bf_lo(unsigned w) { return __uint_as_float(w << 16); }
__device__ __forceinline__ float bf_hi(unsigned w) { return __uint_as_float(w & 0xffff0000u); }
__device__ __forceinline__ float bf1(bf16_t h) { return __uint_as_float((unsigned)h << 16); }
__device__ __forceinline__ float fexp2(float x) { return __builtin_amdgcn_exp2f(x); }
__device__ __forceinline__ float frcp(float x) { return __builtin_amdgcn_rcpf(x); }
__device__ __forceinline__ float sigmoid_f(float x) { return frcp(1.f + fexp2(-1.4426950409f * x)); }
__device__ __forceinline__ float gelu_tanh_f(float x) { const float t = x + 0.044715f * x * x * x; return x * frcp(1.f + fexp2(-2.3022082f * t)); }
__device__ __forceinline__ float wave_sum(float v) {
#pragma unroll
    for (int o = 1; o < 64; o <<= 1) v += __shfl_xor(v, o);
    return v;
}
template <int CTRL> __device__ __forceinline__ float dpp0(float x) { return __builtin_bit_cast(float, __builtin_amdgcn_update_dpp(0, __builtin_bit_cast(int, x), CTRL, 0xf, 0xf, true)); }

namespace pg8 {
constexpr int BM = 256, BK = 64, HALF = 128, HTB = HALF * BK * 2, STAGE_BYTES = 8 * HTB, NXCD = 8, WGM = 4;
__host__ __device__ __forceinline__ int lds_byte(int r, int c) { const int st = (r >> 4) * 2 + (c >> 5), rr = r & 15, cc = c & 31, ob = rr * 64 + cc * 2; return st * 1024 + (ob ^ (((ob >> 9) & 1) << 5)); }
__host__ __device__ __forceinline__ void stage_rc(int b, int& R, int& C) { const int st = b / 1024, sb = b % 1024, swz = sb ^ (((sb >> 9) & 1) << 5); R = (st >> 1) * 16 + swz / 64; C = (st & 1) * 32 + (swz % 64) / 2; }
__host__ __device__ __forceinline__ int perm32(int rho) { const int n = rho >> 4, i = rho & 15; return 8 * (i >> 2) + 4 * n + (i & 3); }

struct Unit { int pm, pn; };
struct Gemm { const bf16_t* A; const bf16_t* Bt; int lda, ldb, nt, nM, nN, a_sh, a_mul; };

struct StaticOrder {
    int nM, nN, nwg, G, c;
    __device__ void init(int nM_, int nN_, int G_, int c_) { nM = nM_; nN = nN_; nwg = nM * nN; G = G_; c = c_; }
    __device__ bool next(int i, Unit& u) const {
        const long L = (long)i * G + c; if (L >= nwg) return false;
        int wgid = (int)L; { const int q = nwg / NXCD, r = nwg % NXCD, xcd = wgid % NXCD, off = wgid / NXCD; wgid = (xcd < r ? xcd * (q + 1) : r * (q + 1) + (xcd - r) * q) + off; }
        const int nig = WGM * nN, gid = wgid / nig, fm = gid * WGM, gsz = (nM - fm) < WGM ? (nM - fm) : WGM;
        u.pm = fm + ((wgid % nig) % gsz); u.pn = (wgid % nig) / gsz; return true;
    }
};

template <class Epi, bool ALIGN_EPI, class Sched = StaticOrder>
__device__ __forceinline__ void gemm_phase(LAS unsigned char* lds, const Gemm g, const Sched& S, const Epi& E) {
    int tid = threadIdx.x; asm volatile("" : "+v"(tid)); tid &= 511;
    const int wid = __builtin_amdgcn_readfirstlane(tid >> 6), lane = tid & 63, wr = wid >> 2, wc = wid & 3, fr = lane & 15, fq = lane >> 4;
    const int nt = g.nt;
    unsigned voffA[2], voffB[2];
#pragma unroll
    for (int i = 0; i < 2; ++i) { int R, C; stage_rc(tid * 16 + i * 8192, R, C); const int Rb = Epi::PERM == 2 ? ((R >> 5) * 64 + perm32(R & 31)) : Epi::PERM == 1 ? ((R & ~31) + perm32(R & 31)) : R;
        voffA[i] = (unsigned)(R * g.lda + C) * 2u; voffB[i] = (unsigned)(Rb * g.ldb + C) * 2u; }
    const size_t kstep = (size_t)(BK * 2);
    const size_t hstepA = (size_t)HALF * g.lda * 2, hstepB = (size_t)(Epi::PERM == 2 ? 32 : HALF) * g.ldb * 2;
    const size_t tstepA = 2 * hstepA, tstepB = (size_t)BM * g.ldb * 2;
    const unsigned ldsw = (unsigned)wid * 1024u;
    const int aoff = lds_byte(wr * 64 + fr, fq * 8), boff = lds_byte(wc * 32 + fr, fq * 8);
#define PG8_SA(b, h) (((b) * 2 + (h)) * HTB)
#define PG8_SB(b, h) ((4 + (b) * 2 + (h)) * HTB)
#define PG8_STAGE(bufoff, gbase, voff) do { _Pragma("unroll") for (int _i = 0; _i < 2; ++_i) \
        __builtin_amdgcn_global_load_lds((const unsigned*)((const char*)(gbase) + (voff)[_i]), (LAS unsigned*)(lds + (bufoff) + ldsw + _i * 8192), 16, 0, 0); } while (0)
#define PG8_LDA(dst, b, h) do { _Pragma("unroll") for (int m = 0; m < 4; ++m) _Pragma("unroll") for (int k = 0; k < 2; ++k) dst[m][k] = *(const LAS bf16x8*)(lds + PG8_SA(b, h) + aoff + m * 2048 + k * 1024); } while (0)
#define PG8_LDB(dst, b, h) do { _Pragma("unroll") for (int n = 0; n < 2; ++n) _Pragma("unroll") for (int k = 0; k < 2; ++k) dst[n][k] = *(const LAS bf16x8*)(lds + PG8_SB(b, h) + boff + n * 2048 + k * 1024); } while (0)
#define PG8_MMA(ai, bj, At, Bt) do { __builtin_amdgcn_s_setprio(1); _Pragma("unroll") for (int m = 0; m < 4; ++m) _Pragma("unroll") for (int n = 0; n < 2; ++n) _Pragma("unroll") for (int k = 0; k < 2; ++k) \
        acc[ai][bj][m][n] = __builtin_amdgcn_mfma_f32_16x16x32_bf16(Bt[n][k], At[m][k], acc[ai][bj][m][n], 0, 0, 0); __builtin_amdgcn_s_setprio(0); } while (0)
#define PG8_WAIT_V(n) asm volatile("s_waitcnt vmcnt(" #n ")" ::: "memory")
#define PG8_WAIT_L(n) asm volatile("s_waitcnt lgkmcnt(" #n ")" ::: "memory")
#define PG8_BAR __builtin_amdgcn_s_barrier()
#define PG8_SCHED __builtin_amdgcn_sched_barrier(0)
#define PG8_ABASE(u) ((const char*)g.A + (size_t)(u).pm * tstepA + (size_t)(((u).pn >> g.a_sh) * g.a_mul) * 2)
#define PG8_BBASE(u) ((const char*)g.Bt + (size_t)(u).pn * tstepB)
    Unit cur, nxt; int ui = 0;
    if (!S.next(0, cur)) return;
    f32x4 acc[2][2][4][2];
#pragma unroll
    for (int a = 0; a < 2; ++a)
#pragma unroll
        for (int b = 0; b < 2; ++b)
#pragma unroll
            for (int m = 0; m < 4; ++m)
#pragma unroll
                for (int n = 0; n < 2; ++n) acc[a][b][m][n] = (f32x4){0.f, 0.f, 0.f, 0.f};
    bf16x8 At[4][2], B0[2][2], B1[2][2];
    const char* cA = PG8_ABASE(cur); const char* cB = PG8_BBASE(cur);
    PG8_STAGE(PG8_SB(0, 0), cB, voffB); PG8_STAGE(PG8_SB(0, 1), cB + hstepB, voffB); PG8_STAGE(PG8_SA(0, 0), cA, voffA); PG8_STAGE(PG8_SA(0, 1), cA + hstepA, voffA);
    if (wr == 1) PG8_BAR;
    PG8_WAIT_V(2); PG8_BAR;
    PG8_STAGE(PG8_SB(1, 0), cB + kstep, voffB); PG8_STAGE(PG8_SA(1, 0), cA + kstep, voffA); PG8_STAGE(PG8_SB(1, 1), cB + hstepB + kstep, voffB);
    PG8_WAIT_V(6); PG8_BAR;
    for (;;) {
        const bool has_next = S.next(ui + 1, nxt);
        const char* nA = has_next ? PG8_ABASE(nxt) : cA; const char* nB = has_next ? PG8_BBASE(nxt) : cB;
#pragma unroll 1
        for (int t = 0; t < nt; t += 2) {
            const bool last = (t == nt - 2);
            if constexpr (Epi::MIDK) { if (t == E.midk_t) E.mid(acc, cur, wr, wc, fr, fq); }
            const char* a1 = cA + (size_t)(t + 1) * kstep;
            const char* a2 = last ? nA : cA + (size_t)(t + 2) * kstep; const char* b2 = last ? nB : cB + (size_t)(t + 2) * kstep;
            const char* a3 = a2 + kstep; const char* b3 = b2 + kstep;
            PG8_LDB(B0, 0, 0); PG8_LDB(B1, 0, 1); PG8_SCHED; PG8_LDA(At, 0, 0); PG8_STAGE(PG8_SA(1, 1), a1 + hstepA, voffA);
            PG8_WAIT_V(8); PG8_WAIT_L(0); PG8_BAR; PG8_MMA(0, 0, At, B0); PG8_MMA(0, 1, At, B1); PG8_BAR; PG8_SCHED;
            PG8_LDA(At, 0, 1); PG8_STAGE(PG8_SB(0, 0), b2, voffB); PG8_STAGE(PG8_SB(0, 1), b2 + hstepB, voffB); PG8_STAGE(PG8_SA(0, 0), a2, voffA);
            PG8_WAIT_V(8); PG8_WAIT_L(0); PG8_BAR; PG8_MMA(1, 0, At, B0); PG8_MMA(1, 1, At, B1); PG8_BAR; PG8_SCHED;
            PG8_LDB(B0, 1, 0); PG8_LDB(B1, 1, 1); PG8_SCHED; PG8_LDA(At, 1, 0); PG8_STAGE(PG8_SA(0, 1), a2 + hstepA, voffA);
            PG8_WAIT_V(8); PG8_WAIT_L(0); PG8_BAR; PG8_MMA(0, 0, At, B0); PG8_MMA(0, 1, At, B1); PG8_BAR; PG8_SCHED;
            PG8_LDA(At, 1, 1); PG8_STAGE(PG8_SB(1, 0), b3, voffB); PG8_STAGE(PG8_SB(1, 1), b3 + hstepB, voffB); PG8_STAGE(PG8_SA(1, 0), a3, voffA);
            PG8_WAIT_V(8); PG8_WAIT_L(0); PG8_BAR; PG8_MMA(1, 0, At, B0); PG8_MMA(1, 1, At, B1); PG8_BAR; PG8_SCHED;
        }
        if constexpr (ALIGN_EPI) { if (wr == 0) PG8_BAR; }
        if constexpr (!Epi::AFTER_DRAIN) { E(acc, cur, ui, wr, wc, fr, fq); }
        if (!has_next) break;
#pragma unroll
        for (int a = 0; a < 2; ++a)
#pragma unroll
            for (int b = 0; b < 2; ++b)
#pragma unroll
                for (int m = 0; m < 4; ++m)
#pragma unroll
                    for (int n = 0; n < 2; ++n) acc[a][b][m][n] = (f32x4){0.f, 0.f, 0.f, 0.f};
        cur = nxt; cA = nA; cB = nB; ++ui;
        if constexpr (ALIGN_EPI) { if (wr == 1) PG8_BAR; }
    }
    PG8_WAIT_V(0);
    if constexpr (!ALIGN_EPI) { if (wr == 0) PG8_BAR; }
    PG8_BAR;
    if constexpr (Epi::AFTER_DRAIN) { E.fused(acc, cur, wr, wc, fr, fq, lds, wid, lane); }
#undef PG8_SA
#undef PG8_SB
#undef PG8_STAGE
#undef PG8_LDA
#undef PG8_LDB
#undef PG8_MMA
#undef PG8_WAIT_V
#undef PG8_WAIT_L
#undef PG8_BAR
#undef PG8_SCHED
#undef PG8_ABASE
#undef PG8_BBASE
}

typedef f32x4 Acc[2][2][4][2];
__device__ __forceinline__ float ror8_1(float x) { float r; asm volatile("s_nop 1\n\tv_mov_b32_dpp %0, %1 row_ror:8 row_mask:0xf bank_mask:0xf" : "=v"(r) : "v"(x)); return r; }
__device__ __forceinline__ f32x4 ror8(const f32x4 v) { f32x4 r; r[0] = ror8_1(v[0]); r[1] = ror8_1(v[1]); r[2] = ror8_1(v[2]); r[3] = ror8_1(v[3]); return r; }
__device__ __forceinline__ f32x4 sel4(bool c, const f32x4 a, const f32x4 b) { f32x4 r;
#pragma unroll
    for (int i = 0; i < 4; ++i) r[i] = c ? a[i] : b[i]; return r; }
__device__ __forceinline__ void ld_lines(const float* p, int ldf, bool lo, int fr7, f32x4& n0, f32x4& n1, int hoff = 16) {
    const float* q = p + (size_t)fr7 * ldf + (lo ? 0 : hoff); const f32x4 A = __builtin_nontemporal_load((const f32x4*)q), B = __builtin_nontemporal_load((const f32x4*)(q + (size_t)8 * ldf));
    n0 = sel4(lo, A, ror8(B)); n1 = sel4(lo, ror8(A), B); }
__device__ __forceinline__ void st_lines(float* p, int ldf, bool lo, int fr7, const f32x4 n0, const f32x4 n1, int hoff = 16) {
    float* q = p + (size_t)fr7 * ldf + (lo ? 0 : hoff); *(f32x4*)q = sel4(lo, n0, ror8(n1)); *(f32x4*)(q + (size_t)8 * ldf) = sel4(lo, ror8(n0), n1); }
__device__ __forceinline__ u32x4 asu(const f32x4 v) { return __builtin_bit_cast(u32x4, v); }
__device__ __forceinline__ f32x4 asf(const u32x4 v) { return __builtin_bit_cast(f32x4, v); }
__device__ __forceinline__ void st_lines16(bf16_t* p, int ld, bool lo, int fr7, const u32x4 h0, const u32x4 h1) {
    bf16_t* q = p + (size_t)fr7 * ld + (lo ? 0 : 32); *(u32x4*)q = asu(sel4(lo, asf(h0), ror8(asf(h1)))); *(u32x4*)(q + (size_t)8 * ld) = asu(sel4(lo, ror8(asf(h0)), asf(h1))); }
__device__ __forceinline__ void ld_lines16(const bf16_t* p, int ld, bool lo, int fr7, u32x4& h0, u32x4& h1) {
    const bf16_t* q = p + (size_t)fr7 * ld + (lo ? 0 : 32); const f32x4 A = asf(*(const u32x4*)q), B = asf(*(const u32x4*)(q + (size_t)8 * ld));
    h0 = asu(sel4(lo, A, ror8(B))); h1 = asu(sel4(lo, ror8(A), B)); }

constexpr int TAB_OFF = RING_BYTES + 1024;

__device__ __forceinline__ float row_rstd(const float* ss, int row) {
    float s = 0.f;
#pragma unroll
    for (int j = 0; j < 8; ++j) s += ss[(size_t)j * M + row];
    return __builtin_amdgcn_rsqf(s * (1.0f / DM) + EPS);
}
__device__ __forceinline__ u32x4 pack8(const f32x4 a, const f32x4 b) { u32x4 w; w.x = cvt_pk_bf16(a[0], a[1]); w.y = cvt_pk_bf16(a[2], a[3]); w.z = cvt_pk_bf16(b[0], b[1]); w.w = cvt_pk_bf16(b[2], b[3]); return w; }
__device__ __forceinline__ void unpack8(const u32x4 w, f32x4& a, f32x4& b) { a = (f32x4){bf_lo(w.x), bf_hi(w.x), bf_lo(w.y), bf_hi(w.y)}; b = (f32x4){bf_lo(w.z), bf_hi(w.z), bf_lo(w.w), bf_hi(w.w)}; }

__device__ __forceinline__ void fill_rstd_tab(LAS unsigned char* lds, const StaticOrder& S, const float* ss, int tid) {
    LAS float* tab = (LAS float*)(lds + TAB_OFF); Unit u;
    for (int i = 0; i < 8 && S.next(i, u); ++i) if (tid < 256) tab[i * 256 + tid] = row_rstd(ss, u.pm * BM + tid);
    __syncthreads();
}
constexpr int BTAB_OFF = RING_BYTES + 9216;
__device__ __forceinline__ void fill_tabs(LAS unsigned char* lds, const StaticOrder& S, const float* ss, const float* pb, int ncols, int tid) {
    LAS float* tab = (LAS float*)(lds + TAB_OFF); LAS float* bt = (LAS float*)(lds + BTAB_OFF); LAS float* bh = (LAS float*)lds;
    const int c = tid & 255, h = tid >> 8;
    Unit u0; S.next(0, u0);
    float sb[6], sr[3];
#pragma unroll
    for (int i = 0; i < 6; ++i) { Unit u; if (!S.next(i, u)) u = u0; const float* p = pb + (size_t)((u.pm >> 4) * 32 + 16 * h) * ncols + u.pn * BM + c; float s = 0.f;
#pragma unroll
        for (int kb = 0; kb < 16; ++kb) s += p[(size_t)kb * ncols];
        sb[i] = s; }
#pragma unroll
    for (int j = 0; j < 3; ++j) { Unit u; if (!S.next(2 * j + h, u)) u = u0; sr[j] = row_rstd(ss, u.pm * BM + c); }
#pragma unroll
    for (int j = 0; j < 3; ++j) tab[(2 * j + h) * 256 + c] = sr[j];
    if (h) {
#pragma unroll
        for (int i = 0; i < 6; ++i) bh[i * 256 + c] = sb[i]; }
    __syncthreads();
    if (!h) {
#pragma unroll
        for (int i = 0; i < 6; ++i) bt[i * 256 + c] = sb[i] + bh[i * 256 + c]; }
    __syncthreads();
}
struct EpiZ {
    static constexpr int PERM = 2; static constexpr bool AFTER_DRAIN = false, MIDK = false;
    const LAS float* tab; const LAS float* btab; bf16_t* xrnn; bf16_t* gg; bf16_t* xpool; bf16_t* rg; int midk_t;
    __device__ __forceinline__ void mid(Acc&, const Unit&, int, int, int, int) const {}
    __device__ __forceinline__ void operator()(const Acc& acc, const Unit& u, int ui, int wr, int wc, int fr, int fq) const {
        { int t_ = threadIdx.x; asm volatile("" : "+v"(t_)); fr = t_ & 15; fq = (t_ >> 4) & 3; }
        const int row0 = u.pm * BM + wr * 64, b = u.pm >> 4, lc0 = wc * 64 + 8 * fq; const bool lo = fr < 8; const int fr7 = fr & 7;
        const LAS float* rtab = tab + ui * 256 + wr * 64 + fr;
        const LAS float* bp = btab + ui * 256 + lc0;
        f32x4 bv[2][2];
#pragma unroll
        for (int bj = 0; bj < 2; ++bj)
#pragma unroll
            for (int n = 0; n < 2; ++n) bv[bj][n] = *(const LAS f32x4*)(bp + 32 * bj + 4 * n);
        bf16_t* d0; int ld, mode = 0;
        if (u.pn < 8) { d0 = xrnn + u.pn * BM + lc0; ld = DRNN; }
        else if (u.pn < 16) { d0 = gg + (u.pn - 8) * BM + lc0; ld = DRNN; mode = 1; }
        else if (u.pn < 20) { d0 = xpool + (u.pn - 16) * BM + lc0; ld = DPOOL; }
        else { d0 = rg + (u.pn - 20) * BM + lc0; ld = 2 * DM; mode = 2; }
#pragma unroll
        for (int ai = 0; ai < 2; ++ai)
#pragma unroll
            for (int m = 0; m < 4; ++m) { const int rowg = row0 + ai * HALF + m * 16; const float rs = rtab[ai * HALF + m * 16];
                f32x4 z[2][2];
#pragma unroll
                for (int bj = 0; bj < 2; ++bj)
#pragma unroll
                    for (int n = 0; n < 2; ++n) z[bj][n] = acc[ai][bj][m][n] * rs + bv[bj][n];
                if (mode == 1) {
#pragma unroll
                    for (int bj = 0; bj < 2; ++bj)
#pragma unroll
                        for (int n = 0; n < 2; ++n)
#pragma unroll
                            for (int i = 0; i < 4; ++i) z[bj][n][i] = gelu_tanh_f(z[bj][n][i]);
                } else if (mode == 2) {
#pragma unroll
                    for (int n = 0; n < 2; ++n)
#pragma unroll
                        for (int i = 0; i < 4; ++i) { const float eu = fexp2(-1.4426950409f * z[0][n][i]), ev = fminf(fexp2(-1.4426950409f * z[1][n][i]), 1e30f);
                            z[1][n][i] = frcp(1.f + ev); z[0][n][i] = (1.f + ev) * frcp(1.f + eu); }
                }
                st_lines16(d0 + (size_t)rowg * ld, ld, lo, fr7, pack8(z[0][0], z[0][1]), pack8(z[1][0], z[1][1])); }
    }
};

struct GateOrder {
    int c;
    __device__ bool next(int i, Unit& u) const { if (i >= 2 || c >= 256) return false; const int pmi = c >> 4; u.pn = c & 15; u.pm = ((pmi < 8) ? pmi : pmi + 8) + 8 * i; return true; }
};
constexpr int SCAN_OFF = RING_BYTES + 9216;
template <int CTRL> __device__ __forceinline__ float dpp_old(float oldv, float x) { return __builtin_bit_cast(float, __builtin_amdgcn_update_dpp(__builtin_bit_cast(int, oldv), __builtin_bit_cast(int, x), CTRL, 0xf, 0xf, false)); }
__device__ __forceinline__ float bcast15(float x) { return __builtin_bit_cast(float, __builtin_amdgcn_ds_swizzle(__builtin_bit_cast(int, x), 0x1F0)); }
struct EpiGates {
    static constexpr int PERM = 2; static constexpr bool AFTER_DRAIN = false, MIDK = false;
    const float* ba; const float* bx; const float* lruk; const bf16_t* xr; const bf16_t* gg; bf16_t* yab; unsigned long long* aggu; LAS unsigned char* lds; int midk_t;
    __device__ __forceinline__ void mid(Acc&, const Unit&, int, int, int, int) const {}
    __device__ __forceinline__ void operator()(const Acc& acc, const Unit& u, int ui, int wr, int wc, int fr, int fq) const {
        int tid; { int t_ = threadIdx.x; asm volatile("" : "+v"(t_)); tid = t_ & 511; fr = t_ & 15; fq = (t_ >> 4) & 3; }
        const int b = u.pm >> 4, pmb = u.pm & 15;
        const int row0 = u.pm * BM + wr * 64 + fr, chl0 = wc * 32 + 8 * fq, ch0 = u.pn * HALF + chl0;
        LAS float* CH = (LAS float*)(lds + SCAN_OFF); LAS float* CARRY = CH + 1024;
        f32x4 Pf[2][4][2], Hf[2][4][2];
        f32x4 vba[2], vbx[2], vk[2];
#pragma unroll
        for (int n = 0; n < 2; ++n) { vba[n] = *(const f32x4*)(ba + ch0 + 4 * n); vbx[n] = *(const f32x4*)(bx + ch0 + 4 * n); vk[n] = *(const f32x4*)(lruk + ch0 + 4 * n); }
#pragma unroll
        for (int ai = 0; ai < 2; ++ai) {
            f32x4 Pc[2] = {(f32x4){1.f, 1.f, 1.f, 1.f}, (f32x4){1.f, 1.f, 1.f, 1.f}}, Hc[2] = {(f32x4){0.f, 0.f, 0.f, 0.f}, (f32x4){0.f, 0.f, 0.f, 0.f}};
            const bf16_t* px = xr + (size_t)(row0 + ai * HALF) * DRNN + ch0; asm volatile("" : "+v"(px));
#pragma unroll
            for (int m = 0; m < 4; ++m) { const u32x4 xw = *(const u32x4*)px; px += 16 * DRNN; f32x4 xv[2]; unpack8(xw, xv[0], xv[1]);
#pragma unroll
                for (int n = 0; n < 2; ++n) {
#pragma unroll
                    for (int i = 0; i < 4; ++i) { const float r = sigmoid_f(acc[ai][0][m][n][i] + vba[n][i]), g = sigmoid_f(acc[ai][1][m][n][i] + vbx[n][i]);
                        float P = fexp2(1.4426950409f * vk[n][i] * r), H = __builtin_amdgcn_sqrtf(fmaxf(1.f - P * P, 0.f)) * (g * xv[n][i]);
                        { const float Pp = dpp_old<0x111>(1.f, P), Hp = dpp_old<0x111>(0.f, H); H = P * Hp + H; P = P * Pp; }
                        { const float Pp = dpp_old<0x112>(1.f, P), Hp = dpp_old<0x112>(0.f, H); H = P * Hp + H; P = P * Pp; }
                        { const float Pp = dpp_old<0x114>(1.f, P), Hp = dpp_old<0x114>(0.f, H); H = P * Hp + H; P = P * Pp; }
                        { const float Pp = dpp_old<0x118>(1.f, P), Hp = dpp_old<0x118>(0.f, H); H = P * Hp + H; P = P * Pp; }
                        const float Pt = bcast15(P), Ht = bcast15(H);
                        Hf[ai][m][n][i] = P * Hc[n][i] + H; Pf[ai][m][n][i] = P * Pc[n][i];
                        Hc[n][i] = Pt * Hc[n][i] + Ht; Pc[n][i] = Pt * Pc[n][i]; }
                    asm volatile("" : "+v"(Hf[ai][m][n]), "+v"(Pf[ai][m][n]), "+v"(Hc[n]), "+v"(Pc[n]) :: "memory"); } }
            if (fr == 0) {
#pragma unroll
                for (int n = 0; n < 2; ++n) { *(LAS f32x4*)(CH + ((2 * ai + wr) * 2 + 0) * 128 + chl0 + 4 * n) = Pc[n]; *(LAS f32x4*)(CH + ((2 * ai + wr) * 2 + 1) * 128 + chl0 + 4 * n) = Hc[n]; } }
        }
        asm volatile("s_waitcnt lgkmcnt(0)" ::: "memory"); __builtin_amdgcn_s_barrier(); asm volatile("" ::: "memory");
        {
            const int tc = tid & 127, jg = tid >> 7;
            unsigned long long* gbase = aggu + (size_t)(b * 16) * DRNN + u.pn * HALF + tc;
            if (jg == 0) { float P = 1.f, H = 0.f;
#pragma unroll
                for (int c = 0; c < 4; ++c) { const float p = CH[(c * 2 + 0) * 128 + tc], h = CH[(c * 2 + 1) * 128 + tc]; H = p * H + h; P = p * P; }
                __hip_atomic_store(gbase + (size_t)pmb * DRNN, ((unsigned long long)__float_as_uint(H) << 32) | (unsigned long long)__float_as_uint(-P), __ATOMIC_RELAXED, __HIP_MEMORY_SCOPE_AGENT); }
            float Pq = 1.f, Hq = 0.f;
            if (4 * jg < pmb) {
                unsigned long long gq[4]; unsigned spins = 0;
                for (;;) { bool ok = true;
#pragma unroll
                    for (int j = 0; j < 4; ++j) { gq[j] = 0x80000000ull; if (4 * jg + j < pmb) { gq[j] = __hip_atomic_load(gbase + (size_t)(4 * jg + j) * DRNN, __ATOMIC_RELAXED, __HIP_MEMORY_SCOPE_AGENT); ok = ok && ((gq[j] >> 31) & 1ull); } }
                    if (__all(ok) || ++spins > (1u << 20)) break;
                    __builtin_amdgcn_s_sleep(4); }
#pragma unroll
                for (int j = 0; j < 4; ++j) if (4 * jg + j < pmb) { const float p = -__uint_as_float((unsigned)gq[j]), h = __uint_as_float((unsigned)(gq[j] >> 32)); Hq = p * Hq + h; Pq = p * Pq; }
            }
            LAS float* PART = (LAS float*)(lds + TAB_OFF);
            PART[(jg * 2 + 0) * 128 + tc] = Pq; PART[(jg * 2 + 1) * 128 + tc] = Hq;
        }
        asm volatile("s_waitcnt lgkmcnt(0)" ::: "memory"); __builtin_amdgcn_s_barrier(); asm volatile("" ::: "memory");
        if (tid < 128) { const LAS float* PART = (const LAS float*)(lds + TAB_OFF); float hin = 0.f;
#pragma unroll
            for (int jg = 0; jg < 4; ++jg) hin = PART[(jg * 2 + 0) * 128 + tid] * hin + PART[(jg * 2 + 1) * 128 + tid];
            CARRY[tid] = hin; }
        asm volatile("s_waitcnt lgkmcnt(0)" ::: "memory"); __builtin_amdgcn_s_barrier(); asm volatile("" ::: "memory");
#pragma unroll
        for (int ai = 0; ai < 2; ++ai) {
            f32x4 hp[2];
#pragma unroll
            for (int n = 0; n < 2; ++n) { hp[n] = *(const LAS f32x4*)(CARRY + chl0 + 4 * n);
#pragma unroll
                for (int c = 0; c < 3; ++c) if (c < 2 * ai + wr) hp[n] = *(const LAS f32x4*)(CH + (c * 2 + 0) * 128 + chl0 + 4 * n) * hp[n] + *(const LAS f32x4*)(CH + (c * 2 + 1) * 128 + chl0 + 4 * n); }
            const bf16_t* pg = gg + (size_t)(row0 + ai * HALF) * DRNN + ch0; bf16_t* py = yab + (size_t)(row0 + ai * HALF) * 3072 + ch0; asm volatile("" : "+v"(pg), "+v"(py));
#pragma unroll
            for (int m = 0; m < 4; ++m) { const u32x4 gw = __builtin_nontemporal_load((const u32x4*)pg); pg += 16 * DRNN; f32x4 g0, g1; unpack8(gw, g0, g1);
                *(u32x4*)py = pack8((Hf[ai][m][0] + Pf[ai][m][0] * hp[0]) * g0, (Hf[ai][m][1] + Pf[ai][m][1] * hp[1]) * g1); py += 16 * 3072; asm volatile("" ::: "memory"); }
        }
    }
};

struct EpiPool {
    static constexpr int PERM = 2; static constexpr bool AFTER_DRAIN = false, MIDK = false;
    const float* pb; const float* ps; bf16_t* yab; int midk_t;
    __device__ __forceinline__ void mid(Acc&, const Unit&, int, int, int, int) const {}
    __device__ __forceinline__ void operator()(const Acc& acc, const Unit& u, int ui, int wr, int wc, int fr, int fq) const {
        { int t_ = threadIdx.x; asm volatile("" : "+v"(t_)); fr = t_ & 15; fq = (t_ >> 4) & 3; }
        const int c0 = u.pn * BM + wc * 64 + 8 * fq; const bool lo = fr < 8; const int fr7 = fr & 7;
        f32x4 bv[2][2], sv[2][2];
#pragma unroll
        for (int bj = 0; bj < 2; ++bj)
#pragma unroll
            for (int n = 0; n < 2; ++n) { bv[bj][n] = *(const f32x4*)(pb + c0 + 32 * bj + 4 * n); sv[bj][n] = *(const f32x4*)(ps + c0 + 32 * bj + 4 * n); }
#pragma unroll
        for (int ai = 0; ai < 2; ++ai)
#pragma unroll
            for (int m = 0; m < 4; ++m) { bf16_t* p = yab + (size_t)(u.pm * BM + ai * HALF + wr * 64 + m * 16) * 3072 + 2048 + c0;
                st_lines16(p, 3072, lo, fr7, pack8((acc[ai][0][m][0] + bv[0][0]) * sv[0][0], (acc[ai][0][m][1] + bv[0][1]) * sv[0][1]), pack8((acc[ai][1][m][0] + bv[1][0]) * sv[1][0], (acc[ai][1][m][1] + bv[1][1]) * sv[1][1]));
                asm volatile("" ::: "memory"); }
    }
};

struct EpiMerge {
    static constexpr int PERM = 2; static constexpr bool AFTER_DRAIN = false, MIDK = true;
    const bf16_t* rg; bf16_t* merged; int midk_t;
    __device__ __forceinline__ void mid(Acc& acc, const Unit& u, int wr, int wc, int fr, int fq) const {
        { int t_ = threadIdx.x; asm volatile("" : "+v"(t_)); fr = t_ & 15; fq = (t_ >> 4) & 3; }
        const int rc0 = 256 * (2 * u.pn + (wc >> 1)) + 128 * (wc & 1) + 8 * fq;
#pragma unroll
        for (int ai = 0; ai < 2; ++ai)
#pragma unroll
            for (int m = 0; m < 4; ++m) {
                const bf16_t* pr = rg + (size_t)(u.pm * BM + ai * HALF + wr * 64 + m * 16 + fr) * (2 * DM) + rc0; const u32x4 h0 = __builtin_nontemporal_load((const u32x4*)pr), h1 = __builtin_nontemporal_load((const u32x4*)(pr + 64));
                f32x4 a, b; unpack8(h0, a, b); acc[ai][0][m][0] *= a; acc[ai][0][m][1] *= b; unpack8(h1, a, b); acc[ai][1][m][0] *= a; acc[ai][1][m][1] *= b;
                asm volatile("" ::: "memory"); }
    }
    __device__ __forceinline__ void operator()(const Acc& acc, const Unit& u, int ui, int wr, int wc, int fr, int fq) const {
        { int t_ = threadIdx.x; asm volatile("" : "+v"(t_)); fr = t_ & 15; fq = (t_ >> 4) & 3; }
        const int c0 = u.pn * BM + wc * 64 + 8 * fq; const bool lo = fr < 8; const int fr7 = fr & 7;
        const int rc0 = 256 * (2 * u.pn + (wc >> 1)) + 128 * (wc & 1) + 8 * fq + 32;
#pragma unroll
        for (int ai = 0; ai < 2; ++ai)
#pragma unroll
            for (int m = 0; m < 4; ++m) { const size_t goff = (size_t)(u.pm * BM + ai * HALF + wr * 64 + m * 16) * DM + c0;
                const bf16_t* pr = rg + (size_t)(u.pm * BM + ai * HALF + wr * 64 + m * 16 + fr) * (2 * DM) + rc0; const u32x4 h0 = __builtin_nontemporal_load((const u32x4*)pr), h1 = __builtin_nontemporal_load((const u32x4*)(pr + 64)); f32x4 a0, b0, a1, b1; unpack8(h0, a0, b0); unpack8(h1, a1, b1);
                st_lines16(merged + goff, DM, lo, fr7, pack8(acc[ai][0][m][0] * a0, acc[ai][0][m][1] * b0), pack8(acc[ai][1][m][0] * a1, acc[ai][1][m][1] * b1));
                asm volatile("" ::: "memory"); }
    }
};

template <bool F32SRC>
struct EpiResid {
    static constexpr int PERM = 2; static constexpr bool AFTER_DRAIN = true, MIDK = false;
    const float* xsrc_f;
    const bf16_t* xsrc_b; const float* gsrc;
    bf16_t* xg; const float* gt; const float* gm; float* ss; int midk_t;
    __device__ __forceinline__ void mid(Acc&, const Unit&, int, int, int, int) const {}
    __device__ __forceinline__ void operator()(const Acc&, const Unit&, int, int, int, int, int) const {}
    __device__ __forceinline__ void fused(const Acc& acc, const Unit& u, int wr, int wc, int fr, int fq, LAS unsigned char* lds, int wid, int lane) const {
        { int t_ = threadIdx.x; asm volatile("" : "+v"(t_)); fr = t_ & 15; fq = (t_ >> 4) & 3; }
        const int b = u.pm >> 4, col0 = u.pn * BM + wc * 64 + 8 * fq;
        LAS float* P = (LAS float*)lds;
        const bool lo = fr < 8; const int fr7 = fr & 7;
        f32x4 gv[2][2], gmv[2][2], rgv[2][2];
#pragma unroll
        for (int bj = 0; bj < 2; ++bj)
#pragma unroll
            for (int n = 0; n < 2; ++n) { const size_t ci = (size_t)b * DM + col0 + 32 * bj + 4 * n; gv[bj][n] = *(const f32x4*)(gt + ci); gmv[bj][n] = *(const f32x4*)(gm + ci);
                if constexpr (!F32SRC) { const f32x4 gs = *(const f32x4*)(gsrc + ci); rgv[bj][n] = (f32x4){1.0f / gs[0], 1.0f / gs[1], 1.0f / gs[2], 1.0f / gs[3]}; } else rgv[bj][n] = (f32x4){1.f, 1.f, 1.f, 1.f}; }
#pragma unroll
        for (int ai = 0; ai < 2; ++ai)
#pragma unroll
            for (int m = 0; m < 4; ++m) { const size_t goff = (size_t)(u.pm * BM + ai * HALF + wr * 64 + m * 16) * DM + col0;
                float q = 0.f; u32x4 pk[2]; f32x4 x[2][2];
                if constexpr (F32SRC) {
#pragma unroll
                    for (int bj = 0; bj < 2; ++bj) ld_lines(xsrc_f + goff + 32 * bj, DM, lo, fr7, x[bj][0], x[bj][1], 4);
                } else { u32x4 h0, h1; ld_lines16(xsrc_b + goff, DM, lo, fr7, h0, h1); unpack8(h0, x[0][0], x[0][1]); unpack8(h1, x[1][0], x[1][1]);
#pragma unroll
                    for (int bj = 0; bj < 2; ++bj) { x[bj][0] *= rgv[bj][0]; x[bj][1] *= rgv[bj][1]; } }
#pragma unroll
                for (int bj = 0; bj < 2; ++bj) { const f32x4 y0 = x[bj][0] + gv[bj][0] * acc[ai][bj][m][0], y1 = x[bj][1] + gv[bj][1] * acc[ai][bj][m][1];
                    q += ((y0[0] * y0[0] + y0[1] * y0[1]) + (y0[2] * y0[2] + y0[3] * y0[3])) + ((y1[0] * y1[0] + y1[1] * y1[1]) + (y1[2] * y1[2] + y1[3] * y1[3]));
                    pk[bj] = pack8(y0 * gmv[bj][0], y1 * gmv[bj][1]); }
                st_lines16(xg + goff, DM, lo, fr7, pk[0], pk[1]);
                q += __shfl_xor(q, 16); q += __shfl_xor(q, 32); if (fq == 0) P[(ai * HALF + wr * 64 + m * 16 + fr) * 4 + wc] = q;
                asm volatile("" ::: "memory"); }
        asm volatile("s_waitcnt lgkmcnt(0)" ::: "memory"); __builtin_amdgcn_s_barrier(); asm volatile("" ::: "memory");
        const int t = wid * 64 + lane;
        if (t < 256) { const float s = (P[t * 4 + 0] + P[t * 4 + 1]) + (P[t * 4 + 2] + P[t * 4 + 3]); ss[(size_t)u.pn * M + u.pm * BM + t] = s; }
    }
};

struct EpiFinal {
    static constexpr int PERM = 2; static constexpr bool AFTER_DRAIN = true, MIDK = false;
    const bf16_t* xsrc_b; const float* gsrc; float* out; const float* gt; const float* fg; unsigned* fss; int midk_t;
    __device__ __forceinline__ void mid(Acc&, const Unit&, int, int, int, int) const {}
    __device__ __forceinline__ void operator()(const Acc&, const Unit&, int, int, int, int, int) const {}
    __device__ __forceinline__ void fused(const Acc& acc, const Unit& u, int wr, int wc, int fr, int fq, LAS unsigned char* lds, int wid, int lane) const {
        { int t_ = threadIdx.x; asm volatile("" : "+v"(t_)); fr = t_ & 15; fq = (t_ >> 4) & 3; }
        const int b = u.pm >> 4, col0 = u.pn * BM + wc * 64 + 8 * fq;
        LAS float* P = (LAS float*)lds;
        const bool lo = fr < 8; const int fr7 = fr & 7;
        f32x4 xn[2][2][4][2]; f32x4 gv[2][2], rgv[2][2];
#pragma unroll
        for (int bj = 0; bj < 2; ++bj)
#pragma unroll
            for (int n = 0; n < 2; ++n) { const size_t ci = (size_t)b * DM + col0 + 32 * bj + 4 * n; gv[bj][n] = *(const f32x4*)(gt + ci); const f32x4 gs = *(const f32x4*)(gsrc + ci); rgv[bj][n] = (f32x4){1.0f / gs[0], 1.0f / gs[1], 1.0f / gs[2], 1.0f / gs[3]}; }
#pragma unroll
        for (int ai = 0; ai < 2; ++ai)
#pragma unroll
            for (int m = 0; m < 4; ++m) { const size_t goff = (size_t)(u.pm * BM + ai * HALF + wr * 64 + m * 16) * DM + col0; float q = 0.f;
                u32x4 h0, h1; ld_lines16(xsrc_b + goff, DM, lo, fr7, h0, h1); f32x4 xs[2][2]; unpack8(h0, xs[0][0], xs[0][1]); unpack8(h1, xs[1][0], xs[1][1]);
#pragma unroll
                for (int bj = 0; bj < 2; ++bj) { const f32x4 x0 = xs[bj][0] * rgv[bj][0], x1 = xs[bj][1] * rgv[bj][1];
                    const f32x4 v0 = x0 + gv[bj][0] * acc[ai][bj][m][0], v1 = x1 + gv[bj][1] * acc[ai][bj][m][1]; xn[ai][bj][m][0] = v0; xn[ai][bj][m][1] = v1;
                    q += ((v0[0] * v0[0] + v0[1] * v0[1]) + (v0[2] * v0[2] + v0[3] * v0[3])) + ((v1[0] * v1[0] + v1[1] * v1[1]) + (v1[2] * v1[2] + v1[3] * v1[3]));
                    asm volatile("" : "+v"(xn[ai][bj][m][0]), "+v"(xn[ai][bj][m][1]), "+v"(q) :: "memory"); }
                q += __shfl_xor(q, 16); q += __shfl_xor(q, 32); if (fq == 0) P[(ai * HALF + wr * 64 + m * 16 + fr) * 4 + wc] = q; }
        asm volatile("s_waitcnt lgkmcnt(0)" ::: "memory"); __builtin_amdgcn_s_barrier(); asm volatile("" ::: "memory");
        const int t = wid * 64 + lane;
        if (t < 256) {
            const float s = (P[t * 4 + 0] + P[t * 4 + 1]) + (P[t * 4 + 2] + P[t * 4 + 3]);
            unsigned* w0 = fss + (size_t)u.pm * BM + t;
            __hip_atomic_store(w0 + (size_t)u.pn * M, __float_as_uint(-s), __ATOMIC_RELAXED, __HIP_MEMORY_SCOPE_AGENT);
            unsigned wv[8]; unsigned spins = 0;
            for (;;) { bool ok = true;
#pragma unroll
                for (int j = 0; j < 8; ++j) { wv[j] = __hip_atomic_load(w0 + (size_t)j * M, __ATOMIC_RELAXED, __HIP_MEMORY_SCOPE_AGENT); ok = ok && (wv[j] >> 31); }
                if (__all(ok) || ++spins > (1u << 20)) break;
                __builtin_amdgcn_s_sleep(4); }
            float tot = 0.f;
#pragma unroll
            for (int j = 0; j < 8; ++j) tot += -__uint_as_float(wv[j]);
            P[1024 + t] = __builtin_amdgcn_rsqf(tot * (1.0f / DM) + EPS);
        }
        asm volatile("s_waitcnt lgkmcnt(0)" ::: "memory"); __builtin_amdgcn_s_barrier(); asm volatile("" ::: "memory");
        f32x4 fv[2][2];
#pragma unroll
        for (int bj = 0; bj < 2; ++bj)
#pragma unroll
            for (int n = 0; n < 2; ++n) fv[bj][n] = *(const f32x4*)(fg + col0 + 32 * bj + 4 * n);
#pragma unroll
        for (int ai = 0; ai < 2; ++ai)
#pragma unroll
            for (int m = 0; m < 4; ++m) { const size_t goff = (size_t)(u.pm * BM + ai * HALF + wr * 64 + m * 16) * DM + col0; const float rs = P[1024 + ai * HALF + wr * 64 + m * 16 + fr];
#pragma unroll
                for (int bj = 0; bj < 2; ++bj) st_lines(out + goff + 32 * bj, DM, lo, fr7, xn[ai][bj][m][0] * rs * fv[bj][0], xn[ai][bj][m][1] * rs * fv[bj][1], 4);
                asm volatile("" ::: "memory"); }
    }
};

struct EpiUp {
    static constexpr int PERM = 1; static constexpr bool AFTER_DRAIN = false, MIDK = false;
    const LAS float* tab; const LAS float* btab; const float* cw; const float* cbias; bf16_t* act; float* uh; int midk_t;
    __device__ __forceinline__ void mid(Acc&, const Unit&, int, int, int, int) const {}
    __device__ __forceinline__ void operator()(const Acc& acc, const Unit& u, int ui, int wr, int wc, int fr, int fq) const {
        { int t_ = threadIdx.x; asm volatile("" : "+v"(t_)); fr = t_ & 15; fq = (t_ >> 4) & 3; }
        const int b = u.pm >> 4, lc0 = wc * 32 + 8 * fq;
        const LAS float* rtab = tab + ui * 256 + wr * 64 + fr;
        u32x2 keep[2][4];
#pragma unroll
        for (int n = 0; n < 2; ++n) {
            const int lc = lc0 + 4 * n, ca = u.pn * HALF + lc;
            f32x4 w0[2], w1[2], w2[2], cb[2], bv[2];
#pragma unroll
            for (int bj = 0; bj < 2; ++bj) { const int nc = bj * DFF + ca;
                w0[bj] = *(const f32x4*)(cw + nc); w1[bj] = *(const f32x4*)(cw + DUP + nc); w2[bj] = *(const f32x4*)(cw + 2 * DUP + nc); cb[bj] = *(const f32x4*)(cbias + nc);
                bv[bj] = *(const LAS f32x4*)(btab + ui * 256 + bj * HALF + lc); }
#pragma unroll
            for (int ai = 0; ai < 2; ++ai) {
                const int rbase = u.pm * BM + ai * HALF + wr * 64, sb = rbase >> 6;
                f32x4 pu[2] = {(f32x4){0.f, 0.f, 0.f, 0.f}, (f32x4){0.f, 0.f, 0.f, 0.f}};
#pragma unroll
                for (int m = 0; m < 4; ++m) { const int row = rbase + m * 16 + fr; const float rs = rtab[ai * HALF + m * 16];
                    f32x4 cv[2];
#pragma unroll
                    for (int bj = 0; bj < 2; ++bj) { const f32x4 uu = acc[ai][bj][m][n] * rs + bv[bj];
                        if (m == 0 && fr < 2) *(f32x4*)(uh + ((size_t)sb * 4 + fr) * DUP + u.pn * BM + bj * HALF + lc) = uu;
                        if (m == 3 && fr >= 14) *(f32x4*)(uh + ((size_t)sb * 4 + 2 + (fr - 14)) * DUP + u.pn * BM + bj * HALF + lc) = uu;
                        f32x4 c = cb[bj] + w2[bj] * uu;
#pragma unroll
                        for (int i = 0; i < 4; ++i) { const float u1 = dpp_old<0x111>(dpp0<0x10F>(pu[bj][i]), uu[i]), u2 = dpp_old<0x112>(dpp0<0x10E>(pu[bj][i]), uu[i]);
                            c[i] += w1[bj][i] * u1 + w0[bj][i] * u2; }
                        cv[bj] = c; pu[bj] = uu; }
                    f32x4 o;
#pragma unroll
                    for (int i = 0; i < 4; ++i) o[i] = cv[0][i] * sigmoid_f(cv[0][i]) * cv[1][i];
                    { u32x2 w; w.x = cvt_pk_bf16(o[0], o[1]); w.y = cvt_pk_bf16(o[2], o[3]);
                      if (n == 0) keep[ai][m] = w; else if (!(m == 0 && fr < 2)) { u32x4 w4; w4.x = keep[ai][m].x; w4.y = keep[ai][m].y; w4.z = w.x; w4.w = w.y; *(u32x4*)(act + (size_t)row * DFF + ca - 4) = w4; } }
                    asm volatile("" ::: "memory"); }
            }
        }
    }
};
}

constexpr int PTR_OFF = RING_BYTES + 512;
__device__ __forceinline__ unsigned long long lds_ptr(LAS unsigned char* lds, int i) {
    const volatile LAS unsigned* p = (const volatile LAS unsigned*)(lds + PTR_OFF) + 2 * i;
    const unsigned lo = __builtin_amdgcn_readfirstlane(p[0]), hi = __builtin_amdgcn_readfirstlane(p[1]);
    return ((unsigned long long)hi << 32) | lo;
}

#define XB_TMO      128
#define XB_XCNT(j)  (256  + 64 * (j))
#define XB_XSUB(j)  (1280 + 64 * (j))
#define XB_XGEN(j)  (2304 + 64 * (j))
#define XB_TOP      3328
#define XB_TOPGEN   3392
#define XCD_BAR_WORDS 3456
#define XB_SPIN_CAP (1u << 18)
__device__ __forceinline__ unsigned xb_ld(unsigned* p)              { return __hip_atomic_load(p, __ATOMIC_RELAXED, __HIP_MEMORY_SCOPE_AGENT); }
__device__ __forceinline__ unsigned xb_add(unsigned* p, unsigned v) { return __hip_atomic_fetch_add(p, v, __ATOMIC_RELAXED, __HIP_MEMORY_SCOPE_AGENT); }
__device__ __forceinline__ unsigned xb_xcc_id() { return (unsigned)__builtin_amdgcn_s_getreg((3 << 11) | 20) & 0xFu; }
#define XB_SPIN(cond, bar) do { unsigned _sp = 0; while (cond) { __builtin_amdgcn_s_sleep(1); \
    if ((++_sp & 255u) == 0u) { if (xb_ld(&(bar)[XB_TMO])) break; if (_sp > XB_SPIN_CAP) { atomicAdd(&(bar)[XB_TMO], 1u); break; } } } } while (0)
struct XcdBarrier { unsigned* bar; unsigned x; volatile LAS unsigned* st; };
__device__ __forceinline__ XcdBarrier xcd_barrier_post(unsigned* bar, volatile LAS unsigned* st) {
    XcdBarrier b; b.bar = bar; b.x = xb_xcc_id(); b.st = st;
    if (threadIdx.x == 0) (void)xb_add(&bar[XB_XCNT(b.x)], 1u);
    return b;
}
__device__ __forceinline__ void xcd_barrier_complete(unsigned* bar, unsigned x, unsigned& nloc, unsigned& nx) {
    const unsigned G = gridDim.x * gridDim.y * gridDim.z;
    unsigned sum, cnt, mine, sp = 0u;
    for (;;) {
        sum = 0u; cnt = 0u; mine = 0u;
#pragma unroll
        for (unsigned j = 0; j < 16; ++j) { const unsigned c = xb_ld(&bar[XB_XCNT(j)]); sum += c; cnt += (c > 0u) ? 1u : 0u; mine = (j == x) ? c : mine; }
        if (sum == G) break;
        __builtin_amdgcn_s_sleep(1);
        if ((++sp & 255u) == 0u) { if (xb_ld(&bar[XB_TMO])) break; if (sp > XB_SPIN_CAP) { atomicAdd(&bar[XB_TMO], 1u); break; } }
    }
    nloc = mine > 0u ? mine : 1u; nx = cnt > 0u ? cnt : 1u;
}
__device__ __forceinline__ void xcd_barrier(LAS unsigned char* lds) {
    asm volatile("s_waitcnt vmcnt(0)" ::: "memory");
    __syncthreads();
    if (threadIdx.x == 0) {
        XcdBarrier b; b.bar = (unsigned*)(lds_ptr(lds, 27) + WS_CTL) + CW_BAR; b.x = xb_xcc_id(); b.st = (volatile LAS unsigned*)(lds + MISC_OFF) + 8;
        unsigned* bar = b.bar; unsigned bx_ = b.x;
        asm volatile("" : "+v"(bar), "+s"(bx_));
        __builtin_amdgcn_s_waitcnt(0);
        unsigned nloc = b.st[0], nx = b.st[1];
        if (nloc == 0u) { xcd_barrier_complete(bar, bx_, nloc, nx); b.st[0] = nloc; b.st[1] = nx; }
        const unsigned old = xb_add(&bar[XB_XSUB(bx_)], 1u);
        const unsigned gen = old / nloc;
        if (old + 1u == (gen + 1u) * nloc) {
            __builtin_amdgcn_fence(__ATOMIC_RELEASE, "agent");
            asm volatile("s_waitcnt vmcnt(0)" ::: "memory");
            const unsigned og = xb_add(&bar[XB_TOP], 1u);
            const unsigned tg = og / nx;
            if (og + 1u == (tg + 1u) * nx) xb_add(&bar[XB_TOPGEN], 1u);
            else XB_SPIN(xb_ld(&bar[XB_TOPGEN]) == tg, bar);
            __builtin_amdgcn_fence(__ATOMIC_ACQUIRE, "agent");
            xb_add(&bar[XB_XGEN(bx_)], 1u);
            asm volatile("s_waitcnt vmcnt(0)" ::: "memory");
        } else {
            XB_SPIN(xb_ld(&bar[XB_XGEN(bx_)]) == gen, bar);
            __builtin_amdgcn_fence(__ATOMIC_ACQUIRE, "agent");
            asm volatile("s_waitcnt vmcnt(0)" ::: "memory");
        }
    }
    __syncthreads();
}

struct Args { const float* in[26]; float* out; unsigned char* ws; int ph_lo, ph_hi; };
enum { I_X = 0, I_C, I_ADAW, I_ADAB, I_NMG, I_WIN, I_BIN, I_CONVW, I_CONVB, I_WA, I_BA, I_WX, I_BX, I_LAM, I_POOLW, I_POOLB, I_POOLS, I_PROJA, I_PROJB, I_WOUT, I_NFG, I_WUP, I_FCW, I_FCB, I_WDOWN, I_FING };

template <bool BIAS>
__device__ __forceinline__ void cvt_item(const float* src, int N, bf16_t* dst, int dpitch, int k0, int n0, int drow0, int dcol, int lane,
                                         const float* sh0 = nullptr, const float* sh1 = nullptr, float* bias0 = nullptr, float* bias1 = nullptr, const float* binit = nullptr, int dstep = 32) {
    const int r = lane >> 3, q = lane & 7;
    f32x4 s0 = (f32x4){0.f, 0.f, 0.f, 0.f}, s1 = s0, t0 = s0, t1 = s0;
    f32x4 vv[2][8];
#pragma unroll
    for (int c = 0; c < 2; ++c)
#pragma unroll
        for (int j = 0; j < 8; ++j) vv[c][j] = __builtin_nontemporal_load((const f32x4*)(src + (size_t)(k0 + 8 * r + j) * N + n0 + 32 * c + 4 * q));
    if constexpr (BIAS) {
        const int kk = k0 + 8 * r; const f32x4 a0 = *(const f32x4*)(sh0 + kk), a1 = *(const f32x4*)(sh0 + kk + 4), b0 = *(const f32x4*)(sh1 + kk), b1 = *(const f32x4*)(sh1 + kk + 4);
#pragma unroll
        for (int j = 0; j < 4; ++j) { s0 += a0[j] * vv[0][j] + a1[j] * vv[0][4 + j]; s1 += b0[j] * vv[0][j] + b1[j] * vv[0][4 + j]; t0 += a0[j] * vv[1][j] + a1[j] * vv[1][4 + j]; t1 += b0[j] * vv[1][j] + b1[j] * vv[1][4 + j]; }
    }
#pragma unroll
    for (int c = 0; c < 2; ++c) {
        const f32x4 (&v)[8] = vv[c];
#pragma unroll
        for (int i = 0; i < 4; ++i) { u32x4 w; w.x = cvt_pk_bf16(v[0][i], v[1][i]); w.y = cvt_pk_bf16(v[2][i], v[3][i]); w.z = cvt_pk_bf16(v[4][i], v[5][i]); w.w = cvt_pk_bf16(v[6][i], v[7][i]);
            *(u32x4*)(dst + (size_t)(drow0 + dstep * c + 4 * q + i) * dpitch + dcol + k0 + 8 * r) = w; }
    }
    if constexpr (BIAS) {
        const int ii = r & 3, cc = r >> 2, col = 32 * cc + 4 * q + ii;
        f32x4 k0 = cc ? t0 : s0, x0 = cc ? s0 : t0, k1 = cc ? t1 : s1, x1 = cc ? s1 : t1;
#pragma unroll
        for (int i = 0; i < 4; ++i) { k0[i] += __shfl_xor(x0[i], 32); k1[i] += __shfl_xor(x1[i], 32); }
        const bool h1 = (r & 2) != 0, h0 = (r & 1) != 0;
        float a0 = h1 ? k0[2] : k0[0], a1 = h1 ? k0[3] : k0[1], b0 = h1 ? k1[2] : k1[0], b1 = h1 ? k1[3] : k1[1];
        const float xa0 = h1 ? k0[0] : k0[2], xa1 = h1 ? k0[1] : k0[3], xb0 = h1 ? k1[0] : k1[2], xb1 = h1 ? k1[1] : k1[3];
        a0 += __shfl_xor(xa0, 16); a1 += __shfl_xor(xa1, 16); b0 += __shfl_xor(xb0, 16); b1 += __shfl_xor(xb1, 16);
        float v0 = h0 ? a1 : a0, v1 = h0 ? b1 : b0;
        v0 += __shfl_xor(h0 ? a0 : a1, 8); v1 += __shfl_xor(h0 ? b0 : b1, 8);
        if (binit) { const float bi = binit[n0 + col]; v0 += bi; v1 += bi; }
        const int brow = drow0 + dstep * cc + 4 * q + ii;
        bias0[brow] = v0; bias1[brow] = v1;
    }
}
constexpr int IT_WIN = (DM / 64) * (DIN / 64), IT_LRU = 16 * 16, IT_POOL = 4 * 16, IT_PA = 32 * 32, IT_PB = 16 * 32, IT_WO = 32 * 32, IT_WUP = 32 * (DUP / 64), IT_WD = (DFF / 64) * 32;
constexpr int IT_LAYER = IT_WIN + IT_LRU + IT_POOL + IT_PA + IT_PB + IT_WO + IT_WUP + IT_WD;
__device__ __forceinline__ void cvt_one(const Args& a, int it, int lane) {
    const float* mod = (const float*)(a.ws + WS_MOD);
    {
        const int l = it / IT_LAYER; int r = it % IT_LAYER;
        bf16_t* wl = (bf16_t*)(a.ws + WS_W + (size_t)l * W_LAYER);
        const float* sh = mod + (size_t)l * NB * NADA;
        if (r < IT_WIN) { const int kb = r / (DIN / 64), nb = r % (DIN / 64), n0 = 64 * nb; int drow = n0;
            int dstep = 32;
            if (n0 >= 5120) { const int gsel = n0 - 5120, isb = gsel / 2048, ch = gsel % 2048; drow = 5120 + 256 * (ch / 128) + 64 * ((ch % 128) / 32) + 32 * isb; dstep = 64; }
            float* bo = (float*)(a.ws + WS_PB1) + ((size_t)(l * NB) * 32 + kb) * DIN;
            cvt_item<true>(a.in[I_WIN] + (size_t)l * DM * DIN, DIN, wl + W_BT1 / 2, DM, 64 * kb, n0, drow, 0, lane, sh, sh + NADA, bo, bo + (size_t)32 * DIN, kb == 0 ? a.in[I_BIN] + (size_t)l * DIN : nullptr, dstep); return; } r -= IT_WIN;
        if (r < IT_LRU) { const int mat = r / 16, idx = r % 16, isx = mat / 8, h = mat % 8, kb = idx / 4, nb = idx % 4, n0 = 64 * nb;
            const float* src = a.in[isx ? I_WX : I_WA] + ((size_t)l * 8 + h) * 256 * 256;
            cvt_item<false>(src, 256, wl + W_BTG / 2, 256, 64 * kb, n0, 512 * h + 256 * (n0 / 128) + 64 * ((n0 % 128) / 32) + 32 * isx, 0, lane, nullptr, nullptr, nullptr, nullptr, nullptr, 64); return; } r -= IT_LRU;
        if (r < IT_POOL) { const int gI = r / 16, idx = r % 16, kb = idx / 4, nb = idx % 4;
            cvt_item<false>(a.in[I_POOLW] + ((size_t)l * 4 + gI) * 256 * 256, 256, wl + W_BTP / 2, 256, 64 * kb, 64 * nb, 256 * gI + 64 * nb, 0, lane); return; } r -= IT_POOL;
        if (r < IT_PA) { const int kb = r / 32, nb = r % 32; cvt_item<false>(a.in[I_PROJA] + (size_t)l * DRNN * DM, DM, wl + W_BT3 / 2, 3072, 64 * kb, 64 * nb, 64 * nb, 0, lane); return; } r -= IT_PA;
        if (r < IT_PB) { const int kb = r / 32, nb = r % 32; cvt_item<false>(a.in[I_PROJB] + (size_t)l * DPOOL * DM, DM, wl + W_BT3 / 2, 3072, 64 * kb, 64 * nb, 64 * nb, 2048, lane); return; } r -= IT_PB;
        if (r < IT_WO) { const int kb = r / 32, nb = r % 32; cvt_item<false>(a.in[I_WOUT] + (size_t)l * DM * DM, DM, wl + W_BT4 / 2, DM, 64 * kb, 64 * nb, 64 * nb, 0, lane); return; } r -= IT_WO;
        if (r < IT_WUP) { const int kb = r / (DUP / 64), nb = r % (DUP / 64), n0 = 64 * nb, isl = n0 / DFF, ch = n0 % DFF;
            float* bo = (float*)(a.ws + WS_PB2) + ((size_t)(l * NB) * 32 + kb) * DUP;
            cvt_item<true>(a.in[I_WUP] + (size_t)l * DM * DUP, DUP, wl + W_BT5 / 2, DM, 64 * kb, n0, 256 * (ch / 128) + 128 * isl + (ch % 128), 0, lane, sh + 3 * DM, sh + NADA + 3 * DM, bo, bo + (size_t)32 * DUP, nullptr); return; } r -= IT_WUP;
        { const int kb = r / 32, nb = r % 32; cvt_item<false>(a.in[I_WDOWN] + (size_t)l * DFF * DM, DM, wl + W_BT6 / 2, DFF, 64 * kb, 64 * nb, 64 * nb, 0, lane); }
    }
}
__device__ __forceinline__ void p0_convert(const Args& a, int lo, int hi, int widx, int nw, int lane, unsigned* cnt = nullptr, int shard = 0) {
    if (cnt == nullptr) { for (int it = lo + widx; it < hi; it += nw) cvt_one(a, it, lane); return; }
    const int per = (hi - lo + 7) / 8, slo = lo + shard * per, shi = (slo + per < hi) ? slo + per : hi;
    for (;;) {
        unsigned base = 0; if (lane == 0) base = atomicAdd(cnt + 64 * shard, 2u);
        const int it0 = slo + (int)__builtin_amdgcn_readfirstlane(base);
        if (it0 >= shi) break;
        cvt_one(a, it0, lane); if (it0 + 1 < shi) cvt_one(a, it0 + 1, lane);
    }
}
constexpr int CVT_A_LO = 0, CVT_A_HI = IT_WIN;
__host__ __device__ constexpr int cvt_b_lo(int l) { return l * IT_LAYER + IT_WIN; }
__host__ __device__ constexpr int cvt_b_hi(int l) { return (l + 1) * IT_LAYER - IT_WD; }
__host__ __device__ constexpr int cvt_c_lo(int l) { return (l + 1) * IT_LAYER - IT_WD; }
__host__ __device__ constexpr int cvt_c_hi(int l) { return l + 1 < NL ? (l + 1) * IT_LAYER + IT_WIN : (l + 1) * IT_LAYER; }
__device__ __forceinline__ void p0_ada(const Args& a, LAS unsigned char* lds, int G, int tid, int bx) {
    const int wave = tid >> 6, lane = tid & 63;
    LAS float* cact = (LAS float*)lds;
    LAS float* red = (LAS float*)(lds + 16384);
    for (int i = tid; i < NB * DM; i += 512) { const float v = a.in[I_C][i]; cact[i] = v * sigmoid_f(v); }
    __syncthreads();
    float* mod = (float*)(a.ws + WS_MOD);
    for (int un = bx; un < NL * (NADA / 32); un += G) {
        const int l = un / (NADA / 32), nb = un % (NADA / 32);
        const float* wsrc = a.in[I_ADAW] + (size_t)l * DM * NADA + nb * 32 + 4 * (lane & 7);
        f32x4 s0 = (f32x4){0.f, 0.f, 0.f, 0.f}, s1 = s0;
#pragma unroll 8
        for (int rg = wave; rg < 256; rg += 8) { const int k = rg * 8 + (lane >> 3); const f32x4 wv = __builtin_nontemporal_load((const f32x4*)(wsrc + (size_t)k * NADA)); s0 += cact[k] * wv; s1 += cact[DM + k] * wv; }
#pragma unroll
        for (int i = 0; i < 4; ++i) {
#pragma unroll
            for (int o = 8; o < 64; o <<= 1) { s0[i] += __shfl_xor(s0[i], o); s1[i] += __shfl_xor(s1[i], o); } }
        if (lane < 8) {
#pragma unroll
            for (int i = 0; i < 4; ++i) { red[(wave * 2 + 0) * 32 + 4 * lane + i] = s0[i]; red[(wave * 2 + 1) * 32 + 4 * lane + i] = s1[i]; } }
        __syncthreads();
        if (tid < 64) { const int b = tid >> 5, c = tid & 31; float s = 0.f;
#pragma unroll
            for (int w = 0; w < 8; ++w) s += red[(w * 2 + b) * 32 + c];
            mod[((size_t)l * NB + b) * NADA + nb * 32 + c] = s + a.in[I_ADAB][(size_t)l * NADA + nb * 32 + c]; }
        __syncthreads();
    }
}

__device__ __forceinline__ void p0b(const Args& a, int gw, int ngw, int lane, int gtid, int ngt) {
    const float* mod = (const float*)(a.ws + WS_MOD);
    for (int i = gtid; i < NL * NB * DM; i += ngt) { const int l = i / (NB * DM), b = (i / DM) % NB, c = i % DM; const float* mm = mod + ((size_t)l * NB + b) * NADA;
        ((float*)(a.ws + WS_GM1))[i] = a.in[I_NMG][l * DM + c] * (1.f + mm[DM + c]);
        ((float*)(a.ws + WS_GT1))[i] = mm[2 * DM + c];
        ((float*)(a.ws + WS_GM2))[i] = a.in[I_NFG][l * DM + c] * (1.f + mm[4 * DM + c]);
        ((float*)(a.ws + WS_GT2))[i] = mm[5 * DM + c]; }
    for (int i = gtid; i < NL * DRNN; i += ngt) { const float lam = a.in[I_LAM][i]; ((float*)(a.ws + WS_LRUK))[i] = -8.0f * log1pf(expf(-lam)); }
    p0_convert(a, CVT_A_LO, CVT_A_HI, gw, ngw, lane);
    float* ss = (float*)(a.ws + WS_SS); bf16_t* xg = (bf16_t*)(a.ws + WS_XG);
    for (int row = gw; row < M; row += ngw) { const int b = row / SEQ; const float* xr = a.in[I_X] + (size_t)row * DM; const float* mm = mod + (size_t)b * NADA + DM; float s = 0.f;
#pragma unroll
        for (int j = 0; j < 8; ++j) { const int c = (j * 64 + lane) * 4; const f32x4 xv = __builtin_nontemporal_load((const f32x4*)(xr + c)), gv = *(const f32x4*)(a.in[I_NMG] + c), sc = *(const f32x4*)(mm + c);
            s += (xv[0] * xv[0] + xv[1] * xv[1]) + (xv[2] * xv[2] + xv[3] * xv[3]); const f32x4 y = xv * (gv * (1.f + sc));
            u32x2 w; w.x = cvt_pk_bf16(y[0], y[1]); w.y = cvt_pk_bf16(y[2], y[3]); *(u32x2*)(xg + (size_t)row * DM + c) = w; }
        s = wave_sum(s);
        if (lane < 8) ss[(size_t)lane * M + row] = lane == 0 ? s : 0.f; }
}

__device__ __forceinline__ void build_xr_tile(const Args& a, int l, int pm, int head, int tid) {
    const int strip = tid >> 5, c = head * 256 + (tid & 31) * 8, row0 = pm * 256 + strip * 16, t0 = row0 % SEQ;
    const float* cw = a.in[I_CONVW] + (size_t)l * 4 * DRNN + c; const float* cb = a.in[I_CONVB] + (size_t)l * DRNN + c;
    f32x4 w0[4], w1[4];
#pragma unroll
    for (int k = 0; k < 4; ++k) { w0[k] = *(const f32x4*)(cw + (size_t)k * DRNN); w1[k] = *(const f32x4*)(cw + (size_t)k * DRNN + 4); }
    const f32x4 b0 = *(const f32x4*)cb, b1 = *(const f32x4*)(cb + 4);
    const bf16_t* src = (const bf16_t*)(a.ws + WS_XRNN) + (size_t)row0 * DRNN + c; bf16_t* dst = (bf16_t*)(a.ws + WS_XR) + (size_t)row0 * DRNN + c;
    f32x4 h0[3], h1[3];
#pragma unroll
    for (int d = 0; d < 3; ++d) { h0[d] = (f32x4){0.f, 0.f, 0.f, 0.f}; h1[d] = h0[d]; if (t0 >= 3 - d) { const u32x4 w = *(const u32x4*)(src - (size_t)(3 - d) * DRNN); pg8::unpack8(w, h0[d], h1[d]); } }
#pragma unroll
    for (int j = 0; j < 16; ++j) { const u32x4 w = *(const u32x4*)(src + (size_t)j * DRNN); f32x4 x0, x1; pg8::unpack8(w, x0, x1);
        const f32x4 o0 = b0 + w0[0] * h0[0] + w0[1] * h0[1] + w0[2] * h0[2] + w0[3] * x0, o1 = b1 + w1[0] * h1[0] + w1[1] * h1[1] + w1[2] * h1[2] + w1[3] * x1;
        *(u32x4*)(dst + (size_t)j * DRNN) = pg8::pack8(o0, o1);
        h0[0] = h0[1]; h0[1] = h0[2]; h0[2] = x0; h1[0] = h1[1]; h1[1] = h1[2]; h1[2] = x1; }
}
__device__ __forceinline__ void build_pp_tile(const Args& a, int pm, int g, int tid) {
    const int strip = tid >> 5, c = g * 256 + (tid & 31) * 8, row0 = pm * 256 + strip * 16, t0 = row0 % SEQ, win = 2 << g;
    const bf16_t* src = (const bf16_t*)(a.ws + WS_XPOOL) + (size_t)row0 * DPOOL + c; bf16_t* dst = (bf16_t*)(a.ws + WS_PP) + (size_t)row0 * DPOOL + c;
    f32x4 s0 = (f32x4){0.f, 0.f, 0.f, 0.f}, s1 = s0;
    for (int d = 1; d < win; ++d) if (t0 >= d) { const u32x4 w = *(const u32x4*)(src - (size_t)d * DPOOL); f32x4 y0, y1; pg8::unpack8(w, y0, y1); s0 += y0; s1 += y1; }
#pragma unroll 4
    for (int j = 0; j < 16; ++j) { const int t = t0 + j; const u32x4 w = *(const u32x4*)(src + (size_t)j * DPOOL); f32x4 x0, x1; pg8::unpack8(w, x0, x1); s0 += x0; s1 += x1;
        const float inv = 1.0f / (float)((t + 1 < win) ? t + 1 : win);
        *(u32x4*)(dst + (size_t)j * DPOOL) = pg8::pack8(s0 * inv - x0, s1 * inv - x1);
        if (t - (win - 1) >= 0) { const u32x4 wo = *(const u32x4*)(src + (size_t)(j - (win - 1)) * DPOOL); f32x4 y0, y1; pg8::unpack8(wo, y0, y1); s0 -= y0; s1 -= y1; } }
}

__device__ __forceinline__ void p5_fixup(const Args& a, int l, int gtid, int ngt) {
    const float* uh = (const float*)(a.ws + WS_UH); bf16_t* act = (bf16_t*)(a.ws + WS_ACT);
    const float* cw = a.in[I_FCW] + (size_t)l * 3 * DUP; const float* cb = a.in[I_FCB] + (size_t)l * DUP;
    for (int it = gtid; it < 128 * 2 * DFF; it += ngt) { const int ch = it % DFF, r = (it / DFF) & 1, sb = it / (2 * DFF), row = 64 * sb + r;
        const int j = ch / 128, w = ch % 128; const bool edge = (sb % 64) == 0; float cv[2];
#pragma unroll
        for (int bj = 0; bj < 2; ++bj) { const int tc = 256 * j + 128 * bj + w, nc = bj * DFF + ch;
            const float u0 = uh[((size_t)sb * 4 + r) * DUP + tc];
            float u1, u2;
            if (r == 1) { u1 = uh[((size_t)sb * 4 + 0) * DUP + tc]; u2 = edge ? 0.f : uh[((size_t)(sb - 1) * 4 + 3) * DUP + tc]; }
            else { u1 = edge ? 0.f : uh[((size_t)(sb - 1) * 4 + 3) * DUP + tc]; u2 = edge ? 0.f : uh[((size_t)(sb - 1) * 4 + 2) * DUP + tc]; }
            cv[bj] = cb[nc] + cw[2 * DUP + nc] * u0 + cw[DUP + nc] * u1 + cw[nc] * u2; }
        const float o = cv[0] * sigmoid_f(cv[0]) * cv[1];
        act[(size_t)row * DFF + ch] = (bf16_t)(cvt_pk_bf16(o, 0.f) & 0xffffu); }
}

__device__ __forceinline__ void p_final(const Args& a, int gw, int ngw, int lane) {
    const float* X = (const float*)(a.ws + WS_X); const float* ss = (const float*)(a.ws + WS_SS);
    for (int row = gw; row < M; row += ngw) { const float rs = pg8::row_rstd(ss, row);
#pragma unroll
        for (int j = 0; j < 8; ++j) { const int c = (j * 64 + lane) * 4; *(f32x4*)(a.out + (size_t)row * DM + c) = *(const f32x4*)(X + (size_t)row * DM + c) * rs * *(const f32x4*)(a.in[I_FING] + c); } }
}

constexpr int PH_P0A = 0, PH_P0B = 1, PH_LAYER0 = 2, PH_PER_LAYER = 7, PH_FINAL = -1000, N_PHASES = PH_LAYER0 + NL * PH_PER_LAYER;
__host__ __device__ constexpr int phase_kind(int ph) {
    if (ph == PH_P0A) return 0; if (ph == PH_P0B) return 1; if (ph == PH_FINAL) return 11;
    const int sub = (ph - PH_LAYER0) % PH_PER_LAYER;
    return sub == 0 ? 2 : sub == 1 ? 4 : 4 + sub;
}
template <int KIND, bool DUMMY = false>
__device__ __forceinline__ void run_kind(int ph, LAS unsigned char* lds) {
    int tid = threadIdx.x, bx = blockIdx.x, G = gridDim.x; asm volatile("" : "+v"(tid), "+s"(bx), "+s"(G));
    const int lane = tid & 63, wave = __builtin_amdgcn_readfirstlane(tid >> 6);
    const int vcu = (G % 8 == 0) ? (bx % 8) * (G / 8) + bx / 8 : bx;
    const int gw = vcu * NWAVES + wave, ngw = G * NWAVES, gtid = bx * 512 + tid, ngt = G * 512;
    Args a;
#pragma unroll
    for (int i = 0; i < 26; ++i) a.in[i] = (const float*)lds_ptr(lds, i);
    a.out = (float*)lds_ptr(lds, 26); a.ws = (unsigned char*)lds_ptr(lds, 27); a.ph_lo = ph; a.ph_hi = ph + 1;
    asm volatile("" : "+s"(ph));
    const int l = (ph - PH_LAYER0) / PH_PER_LAYER;
    const bf16_t* wl = (const bf16_t*)(a.ws + WS_W + (size_t)l * W_LAYER);
    const float* ss = (const float*)(a.ws + WS_SS);
    pg8::StaticOrder S;
    if constexpr (KIND == 0) { p0_ada(a, lds, G, tid, bx); }
    else if constexpr (KIND == 1) { p0b(a, gw, ngw, lane, gtid, ngt); }
    else if constexpr (KIND == 11) { p_final(a, gw, ngw, lane); }
    else if constexpr (KIND == 2) {
        const int GGm = (G == 256 && !DUMMY) ? P1_GEMM_WGS : G;
        pg8::Gemm g{(const bf16_t*)(a.ws + WS_XG), wl + W_BT1 / 2, DM, DM, DM / 64, M / 256, DIN / 256, 31, 0}; S.init(g.nM, g.nN, GGm, bx);
        if (bx < GGm) {
        pg8::fill_tabs(lds, S, ss, (const float*)(a.ws + WS_PB1) + (size_t)(l * NB) * 32 * DIN, DIN, tid);
        pg8::EpiZ E{(const LAS float*)(lds + pg8::TAB_OFF), (const LAS float*)(lds + pg8::BTAB_OFF), (bf16_t*)(a.ws + WS_XRNN), (bf16_t*)(a.ws + WS_GG), (bf16_t*)(a.ws + WS_XPOOL), (bf16_t*)(a.ws + WS_RATIO), -1};
        pg8::gemm_phase<pg8::EpiZ, true>(lds, g, S, E);
        }
        if (!DUMMY) p0_convert(a, cvt_b_lo(l), cvt_b_hi(l), gw, ngw, lane, (unsigned*)(a.ws + WS_CTL) + CW_CVT + 512 * (2 * l), bx & 7);
    } else if constexpr (KIND == 4) {
        { pg8::Gemm g{(const bf16_t*)(a.ws + WS_XR), wl + W_BTG / 2, DRNN, 256, 4, M / 256, 16, 1, 256}; pg8::GateOrder GO{bx};
          { pg8::Unit u; for (int i = 0; i < 2 && GO.next(i, u); ++i) build_xr_tile(a, l, u.pm, u.pn >> 1, tid); }
          asm volatile("s_waitcnt vmcnt(0)" ::: "memory"); __syncthreads();
          pg8::EpiGates E{a.in[I_BA] + (size_t)l * DRNN, a.in[I_BX] + (size_t)l * DRNN, (const float*)(a.ws + WS_LRUK) + (size_t)l * DRNN, (const bf16_t*)(a.ws + WS_XR), (const bf16_t*)(a.ws + WS_GG), (bf16_t*)(a.ws + WS_YAB),
                          (unsigned long long*)(a.ws + WS_AGG) + (size_t)l * NB * 16 * DRNN, lds, -1};
          pg8::gemm_phase<pg8::EpiGates, true, pg8::GateOrder>(lds, g, GO, E); }
    } else if constexpr (KIND == 12) {
        { pg8::Gemm g{(const bf16_t*)(a.ws + WS_PP), wl + W_BTP / 2, DPOOL, 256, 4, M / 256, 4, 0, 256}; S.init(g.nM, g.nN, G, bx);
          { pg8::Unit u; for (int i = 0; i < 8 && S.next(i, u); ++i) build_pp_tile(a, u.pm, u.pn, tid); }
          asm volatile("s_waitcnt vmcnt(0)" ::: "memory"); __syncthreads();
          pg8::EpiPool E{a.in[I_POOLB] + (size_t)l * DPOOL, a.in[I_POOLS] + (size_t)l * DPOOL, (bf16_t*)(a.ws + WS_YAB), -1};
          pg8::gemm_phase<pg8::EpiPool, true>(lds, g, S, E); }
    } else if constexpr (KIND == 6) {
        pg8::Gemm g{(const bf16_t*)(a.ws + WS_YAB), wl + W_BT3 / 2, 3072, 3072, 48, M / 256, DM / 256, 31, 0}; S.init(g.nM, g.nN, G, bx);
        pg8::EpiMerge E{(const bf16_t*)(a.ws + WS_RATIO), (bf16_t*)(a.ws + WS_MERGED), 32};
        pg8::gemm_phase<pg8::EpiMerge, false>(lds, g, S, E);
    } else if constexpr (KIND == 7) {
        pg8::Gemm g{(const bf16_t*)(a.ws + WS_MERGED), wl + W_BT4 / 2, DM, DM, DM / 64, M / 256, DM / 256, 31, 0}; S.init(g.nM, g.nN, G, bx);
        const float* gt1 = (const float*)(a.ws + WS_GT1) + (size_t)l * NB * DM; const float* gm2 = (const float*)(a.ws + WS_GM2) + (size_t)l * NB * DM;
        if (l == 0) { pg8::EpiResid<true> E{a.in[I_X], nullptr, nullptr, (bf16_t*)(a.ws + WS_XG), gt1, gm2, (float*)(a.ws + WS_SS), -1}; pg8::gemm_phase<pg8::EpiResid<true>, false>(lds, g, S, E); }
        else { pg8::EpiResid<false> E{nullptr, (const bf16_t*)(a.ws + WS_XG), (const float*)(a.ws + WS_GM1) + (size_t)l * NB * DM, (bf16_t*)(a.ws + WS_XG), gt1, gm2, (float*)(a.ws + WS_SS), -1}; pg8::gemm_phase<pg8::EpiResid<false>, false>(lds, g, S, E); }
    } else if constexpr (KIND == 8) {
        const int GGm = (G == 256 && !DUMMY) ? P5_GEMM_WGS : G;
        pg8::Gemm g{(const bf16_t*)(a.ws + WS_XG), wl + W_BT5 / 2, DM, DM, DM / 64, M / 256, DUP / 256, 31, 0}; S.init(g.nM, g.nN, GGm, bx);
        if (bx < GGm) {
        pg8::fill_tabs(lds, S, ss, (const float*)(a.ws + WS_PB2) + (size_t)(l * NB) * 32 * DUP, DUP, tid);
        pg8::EpiUp E{(const LAS float*)(lds + pg8::TAB_OFF), (const LAS float*)(lds + pg8::BTAB_OFF), a.in[I_FCW] + (size_t)l * 3 * DUP, a.in[I_FCB] + (size_t)l * DUP, (bf16_t*)(a.ws + WS_ACT), (float*)(a.ws + WS_UH), -1};
        pg8::gemm_phase<pg8::EpiUp, true>(lds, g, S, E);
        }
        if (!DUMMY) p0_convert(a, cvt_c_lo(l), cvt_c_hi(l), gw, ngw, lane, (unsigned*)(a.ws + WS_CTL) + CW_CVT + 512 * (2 * l + 1), bx & 7);
    } else if constexpr (KIND == 9) { p5_fixup(a, l, gtid, ngt);
    } else {
        pg8::Gemm g{(const bf16_t*)(a.ws + WS_ACT), wl + W_BT6 / 2, DFF, DFF, DFF / 64, M / 256, DM / 256, 31, 0}; S.init(g.nM, g.nN, G, bx);
        if (l == NL - 1 && !DUMMY) {
            pg8::EpiFinal E{(const bf16_t*)(a.ws + WS_XG), (const float*)(a.ws + WS_GM2) + (size_t)l * NB * DM, a.out, (const float*)(a.ws + WS_GT2) + (size_t)l * NB * DM, a.in[I_FING], (unsigned*)(a.ws + WS_FSS), -1};
            pg8::gemm_phase<pg8::EpiFinal, false>(lds, g, S, E);
        } else {
        pg8::EpiResid<false> E{nullptr, (const bf16_t*)(a.ws + WS_XG), (const float*)(a.ws + WS_GM2) + (size_t)l * NB * DM, (bf16_t*)(a.ws + (DUMMY ? WS_RATIO : WS_XG)), (const float*)(a.ws + WS_GT2) + (size_t)l * NB * DM,
                        (const float*)(a.ws + WS_GM1) + (size_t)(l + 1 < NL ? l + 1 : l) * NB * DM, (float*)(a.ws + (DUMMY ? WS_AGG : WS_SS)), -1};
        pg8::gemm_phase<pg8::EpiResid<false>, false>(lds, g, S, E);
        }
    }
}
#define MK_PROLOGUE \
    extern __shared__ __attribute__((aligned(16))) unsigned char lds_raw[]; \
    LAS unsigned char* lds = (LAS unsigned char*)lds_raw; \
    const int tid = threadIdx.x; \
    volatile LAS unsigned* MISC = (volatile LAS unsigned*)(lds + MISC_OFF); \
    for (int u = tid; u < (LDS_BYTES - RING_BYTES) / 4; u += 512) ((LAS unsigned*)(lds + RING_BYTES))[u] = 0u; \
    __syncthreads(); \
    if (tid == 0) { LAS unsigned long long* pt = (LAS unsigned long long*)(lds + PTR_OFF); \
        _Pragma("unroll") for (int i = 0; i < 26; ++i) pt[i] = (unsigned long long)a.in[i]; \
        pt[26] = (unsigned long long)a.out; pt[27] = (unsigned long long)a.ws; } \
    __syncthreads();

#if MK_ONE_LAUNCH
template <int PH> __device__ __forceinline__ void run_from(LAS unsigned char* lds) {
    if constexpr (PH < N_PHASES) {
        if constexpr (PH == PROBE_PH) { run_kind<phase_kind(PH), true>(PH, lds); if constexpr (phase_kind(PH) == 4) run_kind<12, true>(PH, lds); xcd_barrier(lds); }
        run_kind<phase_kind(PH)>(PH, lds);
        if constexpr (phase_kind(PH) == 4) run_kind<12>(PH, lds);
        if constexpr (PH + 1 < N_PHASES) xcd_barrier(lds);
        run_from<PH + 1>(lds);
    }
}
__global__ void __launch_bounds__(NWAVES * 64, 2) mk_fwd(Args a) {
    MK_PROLOGUE
    (void)xcd_barrier_post((unsigned*)(a.ws + WS_CTL) + CW_BAR, MISC + 8);
    run_from<0>(lds);
}
#else
template <int KIND>
__global__ void __launch_bounds__(NWAVES * 64, 2) mk_phase(Args a) {
    MK_PROLOGUE
    (void)MISC;
    run_kind<KIND>(a.ph_lo, lds);
}
#endif

#if !MK_ONE_LAUNCH
template <int KIND> static void launch_kind(int grid, hipStream_t stream, const Args& a) {
    static bool attr = false;
    if (!attr) { (void)hipFuncSetAttribute((const void*)mk_phase<KIND>, hipFuncAttributeMaxDynamicSharedMemorySize, LDS_BYTES); attr = true; }
    hipLaunchKernelGGL(mk_phase<KIND>, dim3(grid), dim3(NWAVES * 64), LDS_BYTES, stream, a);
}
#endif
extern "C" void kernel_launch(void* const* d_in, const int* in_sizes, int n_in, void* d_out, int out_size, void* d_ws, size_t ws_size, hipStream_t stream) {
    static int grid = 0;
    if (grid == 0) {
        if (n_in != 26 || out_size != M * DM || ws_size < WS_END) { fprintf(stderr, "kernel_launch: unexpected problem (n_in %d out %d ws %zu need %zu)\n", n_in, out_size, ws_size, (size_t)WS_END); grid = -1; return; }
        int dev = 0, cus = 0;
        if (hipGetDevice(&dev) != hipSuccess || hipDeviceGetAttribute(&cus, hipDeviceAttributeMultiprocessorCount, dev) != hipSuccess) { grid = -1; return; }
#if MK_ONE_LAUNCH
        if (hipFuncSetAttribute((const void*)mk_fwd, hipFuncAttributeMaxDynamicSharedMemorySize, LDS_BYTES) != hipSuccess) { fprintf(stderr, "kernel_launch: hipFuncSetAttribute failed\n"); grid = -1; return; }
#endif
        (void)hipGetLastError();
        grid = cus;
        if (grid != 256) fprintf(stderr, "kernel_launch: %d CUs; the residual GEMM phases need exactly 256 workgroups\n", grid);
    }
    if (grid < 0) return;
    (void)hipMemsetAsync((char*)d_ws + WS_CTL, 0, CTL_ZERO_BYTES, stream);
    Args a{};
    for (int i = 0; i < 26; ++i) a.in[i] = (const float*)d_in[i];
    a.out = (float*)d_out; a.ws = (unsigned char*)d_ws;
#if MK_ONE_LAUNCH
    a.ph_lo = 0; a.ph_hi = N_PHASES;
    hipLaunchKernelGGL(mk_fwd, dim3(grid), dim3(NWAVES * 64), LDS_BYTES, stream, a);
#else
    for (int ph = 0; ph < N_PHASES; ++ph) { a.ph_lo = ph; a.ph_hi = ph + 1;
        switch (phase_kind(ph)) {
            case 0: launch_kind<0>(grid, stream, a); break;  case 1: launch_kind<1>(grid, stream, a); break;  case 2: launch_kind<2>(grid, stream, a); break;
            case 4: launch_kind<4>(grid, stream, a); launch_kind<12>(grid, stream, a); break;
            case 6: launch_kind<6>(grid, stream, a); break;  case 7: launch_kind<7>(grid, stream, a); break;  case 8: launch_kind<8>(grid, stream, a); break;
            case 9: launch_kind<9>(grid, stream, a); break;  case 10: launch_kind<10>(grid, stream, a); break; default: launch_kind<11>(grid, stream, a); break;
        } }
#endif
}
```

```cpp
#include <hip/hip_runtime.h>
#include <cstdio>
#include <cstdint>

#ifndef PROBE_PH
#define PROBE_PH -1
#endif
#ifndef P1_GEMM_WGS
#define P1_GEMM_WGS 232
#endif
#ifndef P5_GEMM_WGS
#define P5_GEMM_WGS 240
#endif
#ifndef MK_ONE_LAUNCH
#define MK_ONE_LAUNCH 1
#endif

#define GAS __attribute__((address_space(1)))
#define LAS __attribute__((address_space(3)))
typedef unsigned short bf16_t;
typedef short bf16x8 __attribute__((ext_vector_type(8)));
typedef float f32x4 __attribute__((ext_vector_type(4)));
typedef float f32x2 __attribute__((ext_vector_type(2)));
typedef unsigned u32x4 __attribute__((ext_vector_type(4)));
typedef unsigned u32x2 __attribute__((ext_vector_type(2)));

constexpr int NB = 2, SEQ = 4096, DM = 2048, M = NB * SEQ, DRNN = 2048, DPOOL = 1024, DIN = 9216, DFF = 5632, DUP = 11264, NADA = 12288, NL = 2;
constexpr float EPS = 1e-6f;
constexpr int NWAVES = 8;
constexpr int LDS_BYTES = 147456;
constexpr int RING_BYTES = 131072;
constexpr int MISC_OFF = RING_BYTES + 320;

constexpr size_t MiB = 1u << 20;
constexpr size_t WS_CTL = 0, CTL_ZERO_BYTES = 4 * MiB;
constexpr size_t WS_MOD = 1 * MiB;
constexpr size_t WS_GM1 = WS_MOD + (size_t)NL * NB * NADA * 4;
constexpr size_t WS_GT1 = WS_GM1 + (size_t)NL * NB * DM * 4;
constexpr size_t WS_GM2 = WS_GT1 + (size_t)NL * NB * DM * 4;
constexpr size_t WS_GT2 = WS_GM2 + (size_t)NL * NB * DM * 4;
constexpr size_t WS_LRUK = WS_GT2 + (size_t)NL * NB * DM * 4;
constexpr size_t WS_BIAS1 = WS_LRUK + (size_t)NL * DRNN * 4;
constexpr size_t WS_BIAS2 = WS_BIAS1 + (size_t)NL * NB * DIN * 4;
constexpr size_t WS_SS = WS_BIAS2 + (size_t)NL * NB * DUP * 4;
static_assert(WS_SS + 8 * (size_t)M * 4 <= 2 * MiB, "small region");
constexpr size_t WS_AGG = 2 * MiB;
constexpr size_t WS_FSS = 3 * MiB;
constexpr size_t WS_W = 4 * MiB;
constexpr size_t W_BT1 = 0, W_BTG = 36 * MiB, W_BTP = 38 * MiB, W_BT3 = 39 * MiB, W_BT4 = 51 * MiB, W_BT5 = 59 * MiB, W_BT6 = 103 * MiB, W_LAYER = 125 * MiB;
static_assert((size_t)DIN * DM * 2 == 36 * MiB && (size_t)DUP * DM * 2 == 44 * MiB && (size_t)DM * DFF * 2 == 22 * MiB, "weight sizes");
constexpr size_t WS_X = WS_W + 2 * W_LAYER;
constexpr size_t WS_PB1 = WS_X;
constexpr size_t WS_PB2 = WS_X + 16 * MiB;
static_assert((size_t)NL * NB * 32 * DIN * 4 <= 16 * MiB && (size_t)NL * NB * 32 * DUP * 4 <= 16 * MiB, "partial bias rows");
constexpr size_t WS_XG = WS_X + 64 * MiB;
constexpr size_t WS_XRNN = WS_XG + 32 * MiB;
constexpr size_t WS_GG = WS_XRNN + 32 * MiB;
constexpr size_t WS_XPOOL = WS_GG + 32 * MiB;
constexpr size_t WS_RATIO = WS_XPOOL + 16 * MiB;
constexpr size_t WS_GB = WS_RATIO + 32 * MiB;
constexpr size_t WS_XR = WS_GB + 32 * MiB;
constexpr size_t WS_MERGED = WS_XR;
constexpr size_t WS_PP = WS_XR + 32 * MiB;
constexpr size_t WS_YAB = WS_PP + 16 * MiB;
constexpr size_t WS_AA = WS_YAB + 48 * MiB;
constexpr size_t WS_BB = WS_AA + 64 * MiB;
constexpr size_t WS_ACT = WS_AA;
constexpr size_t WS_UH = WS_ACT + 88 * MiB;
constexpr size_t WS_END = WS_BB + 64 * MiB;
static_assert(WS_UH + (size_t)128 * 4 * DUP * 4 <= WS_END, "ws map");
constexpr int CW_BAR = 4096;
constexpr int CW_CVT = 8192;

__device__ __forceinline__ unsigned cvt_pk_bf16(float lo, float hi) { unsigned r; asm("v_cvt_pk_bf16_f32 %0, %1, %2" : "=v"(r) : "v"(lo), "v"(hi)); return r; }
__device__ __forceinline__ float bf_lo(unsigned w) { return __uint_as_float(w << 16); }
__device__ __forceinline__ float bf_hi(unsigned w) { return __uint_as_float(w & 0xffff0000u); }
__device__ __forceinline__ float bf1(bf16_t h) { return __uint_as_float((unsigned)h << 16); }
__device__ __forceinline__ float fexp2(float x) { return __builtin_amdgcn_exp2f(x); }
__device__ __forceinline__ float frcp(float x) { return __builtin_amdgcn_rcpf(x); }
__device__ __forceinline__ float sigmoid_f(float x) { return frcp(1.f + fexp2(-1.4426950409f * x)); }
__device__ __forceinline__ float gelu_tanh_f(float x) { const float t = x + 0.044715f * x * x * x; return x * frcp(1.f + fexp2(-2.3022082f * t)); }
__device__ __forceinline__ float wave_sum(float v) {
#pragma unroll
    for (int o = 1; o < 64; o <<= 1) v += __shfl_xor(v, o);
    return v;
}
template <int CTRL> __device__ __forceinline__ float dpp0(float x) { return __builtin_bit_cast(float, __builtin_amdgcn_update_dpp(0, __builtin_bit_cast(int, x), CTRL, 0xf, 0xf, true)); }

namespace pg8 {
constexpr int BM = 256, BK = 64, HALF = 128, HTB = HALF * BK * 2, STAGE_BYTES = 8 * HTB, NXCD = 8, WGM = 4;
__host__ __device__ __forceinline__ int lds_byte(int r, int c) { const int st = (r >> 4) * 2 + (c >> 5), rr = r & 15, cc = c & 31, ob = rr * 64 + cc * 2; return st * 1024 + (ob ^ (((ob >> 9) & 1) << 5)); }
__host__ __device__ __forceinline__ void stage_rc(int b, int& R, int& C) { const int st = b / 1024, sb = b % 1024, swz = sb ^ (((sb >> 9) & 1) << 5); R = (st >> 1) * 16 + swz / 64; C = (st & 1) * 32 + (swz % 64) / 2; }
__host__ __device__ __forceinline__ int perm32(int rho) { const int n = rho >> 4, i = rho & 15; return 8 * (i >> 2) + 4 * n + (i & 3); }

struct Unit { int pm, pn; };
struct Gemm { const bf16_t* A; const bf16_t* Bt; int lda, ldb, nt, nM, nN, a_sh, a_mul, a_swz = 0; };

struct StaticOrder {
    int nM, nN, nwg, G, c;
    __device__ void init(int nM_, int nN_, int G_, int c_) { nM = nM_; nN = nN_; nwg = nM * nN; G = G_; c = c_; }
    __device__ bool next(int i, Unit& u) const {
        const long L = (long)i * G + c; if (L >= nwg) return false;
        int wgid = (int)L; { const int q = nwg / NXCD, r = nwg % NXCD, xcd = wgid % NXCD, off = wgid / NXCD; wgid = (xcd < r ? xcd * (q + 1) : r * (q + 1) + (xcd - r) * q) + off; }
        const int nig = WGM * nN, gid = wgid / nig, fm = gid * WGM, gsz = (nM - fm) < WGM ? (nM - fm) : WGM;
        u.pm = fm + ((wgid % nig) % gsz); u.pn = (wgid % nig) / gsz; return true;
    }
};

template <class Epi, bool ALIGN_EPI, class Sched = StaticOrder>
__device__ __forceinline__ void gemm_phase(LAS unsigned char* lds, const Gemm g, const Sched& S, const Epi& E) {
    int tid = threadIdx.x; asm volatile("" : "+v"(tid)); tid &= 511;
    const int wid = __builtin_amdgcn_readfirstlane(tid >> 6), lane = tid & 63, wr = wid >> 2, wc = wid & 3, fr = lane & 15, fq = lane >> 4;
    const int nt = g.nt;
    unsigned voffA[2], voffB[2];
#pragma unroll
    for (int i = 0; i < 2; ++i) { int R, C; stage_rc(tid * 16 + i * 8192, R, C); const int Rb = Epi::PERM == 2 ? ((R >> 5) * 64 + perm32(R & 31)) : Epi::PERM == 1 ? ((R & ~31) + perm32(R & 31)) : R;
        const int Ra = g.a_swz ? ((R & ~8) | (((C >> 5) & 1) << 3)) : R, Ca = g.a_swz ? ((C & ~32) | (((R >> 3) & 1) << 5)) : C;
        voffA[i] = (unsigned)(Ra * g.lda + Ca) * 2u; voffB[i] = (unsigned)(Rb * g.ldb + C) * 2u; }
    const size_t kstep = (size_t)(BK * 2);
    const size_t hstepA = (size_t)HALF * g.lda * 2, hstepB = (size_t)(Epi::PERM == 2 ? 32 : HALF) * g.ldb * 2;
    const size_t tstepA = 2 * hstepA, tstepB = (size_t)BM * g.ldb * 2;
    const unsigned ldsw = (unsigned)wid * 1024u;
    const int aoff = lds_byte(wr * 64 + fr, fq * 8), boff = lds_byte(wc * 32 + fr, fq * 8);
#define PG8_SA(b, h) (((b) * 2 + (h)) * HTB)
#define PG8_SB(b, h) ((4 + (b) * 2 + (h)) * HTB)
#define PG8_STAGE(bufoff, gbase, voff) do { _Pragma("unroll") for (int _i = 0; _i < 2; ++_i) \
        __builtin_amdgcn_global_load_lds((const unsigned*)((const char*)(gbase) + (voff)[_i]), (LAS unsigned*)(lds + (bufoff) + ldsw + _i * 8192), 16, 0, 0); } while (0)
#define PG8_LDA(dst, b, h) do { _Pragma("unroll") for (int m = 0; m < 4; ++m) _Pragma("unroll") for (int k = 0; k < 2; ++k) dst[m][k] = *(const LAS bf16x8*)(lds + PG8_SA(b, h) + aoff + m * 2048 + k * 1024); } while (0)
#define PG8_LDB(dst, b, h) do { _Pragma("unroll") for (int n = 0; n < 2; ++n) _Pragma("unroll") for (int k = 0; k < 2; ++k) dst[n][k] = *(const LAS bf16x8*)(lds + PG8_SB(b, h) + boff + n * 2048 + k * 1024); } while (0)
#define PG8_MMA(ai, bj, At, Bt) do { __builtin_amdgcn_s_setprio(1); _Pragma("unroll") for (int m = 0; m < 4; ++m) _Pragma("unroll") for (int n = 0; n < 2; ++n) _Pragma("unroll") for (int k = 0; k < 2; ++k) \
        acc[ai][bj][m][n] = __builtin_amdgcn_mfma_f32_16x16x32_bf16(Bt[n][k], At[m][k], acc[ai][bj][m][n], 0, 0, 0); __builtin_amdgcn_s_setprio(0); } while (0)
#define PG8_WAIT_V(n) asm volatile("s_waitcnt vmcnt(" #n ")" ::: "memory")
#define PG8_WAIT_L(n) asm volatile("s_waitcnt lgkmcnt(" #n ")" ::: "memory")
#define PG8_BAR __builtin_amdgcn_s_barrier()
#define PG8_SCHED __builtin_amdgcn_sched_barrier(0)
#define PG8_ABASE(u) ((const char*)g.A + (size_t)(u).pm * tstepA + (size_t)(((u).pn >> g.a_sh) * g.a_mul) * 2)
#define PG8_BBASE(u) ((const char*)g.Bt + (size_t)(u).pn * tstepB)
    Unit cur, nxt; int ui = 0;
    if (!S.next(0, cur)) return;
    f32x4 acc[2][2][4][2];
#pragma unroll
    for (int a = 0; a < 2; ++a)
#pragma unroll
        for (int b = 0; b < 2; ++b)
#pragma unroll
            for (int m = 0; m < 4; ++m)
#pragma unroll
                for (int n = 0; n < 2; ++n) acc[a][b][m][n] = (f32x4){0.f, 0.f, 0.f, 0.f};
    bf16x8 At[4][2], B0[2][2], B1[2][2];
    const char* cA = PG8_ABASE(cur); const char* cB = PG8_BBASE(cur);
    PG8_STAGE(PG8_SB(0, 0), cB, voffB); PG8_STAGE(PG8_SB(0, 1), cB + hstepB, voffB); PG8_STAGE(PG8_SA(0, 0), cA, voffA); PG8_STAGE(PG8_SA(0, 1), cA + hstepA, voffA);
    if (wr == 1) PG8_BAR;
    PG8_WAIT_V(2); PG8_BAR;
    PG8_STAGE(PG8_SB(1, 0), cB + kstep, voffB); PG8_STAGE(PG8_SA(1, 0), cA + kstep, voffA); PG8_STAGE(PG8_SB(1, 1), cB + hstepB + kstep, voffB);
    PG8_WAIT_V(6); PG8_BAR;
    for (;;) {
        const bool has_next = S.next(ui + 1, nxt);
        const char* nA = has_next ? PG8_ABASE(nxt) : cA; const char* nB = has_next ? PG8_BBASE(nxt) : cB;
#pragma unroll 1
        for (int t = 0; t < nt; t += 2) {
            const bool last = (t == nt - 2);
            if constexpr (Epi::MIDK) { if (t == E.midk_t) E.mid(acc, cur, wr, wc, fr, fq); }
            const char* a1 = cA + (size_t)(t + 1) * kstep;
            const char* a2 = last ? nA : cA + (size_t)(t + 2) * kstep; const char* b2 = last ? nB : cB + (size_t)(t + 2) * kstep;
            const char* a3 = a2 + kstep; const char* b3 = b2 + kstep;
            PG8_LDB(B0, 0, 0); PG8_LDB(B1, 0, 1); PG8_SCHED; PG8_LDA(At, 0, 0); PG8_STAGE(PG8_SA(1, 1), a1 + hstepA, voffA);
            PG8_WAIT_V(8); PG8_WAIT_L(0); PG8_BAR; PG8_MMA(0, 0, At, B0); PG8_MMA(0, 1, At, B1); PG8_BAR; PG8_SCHED;
            PG8_LDA(At, 0, 1); PG8_STAGE(PG8_SB(0, 0), b2, voffB); PG8_STAGE(PG8_SB(0, 1), b2 + hstepB, voffB); PG8_STAGE(PG8_SA(0, 0), a2, voffA);
            PG8_WAIT_V(8); PG8_WAIT_L(0); PG8_BAR; PG8_MMA(1, 0, At, B0); PG8_MMA(1, 1, At, B1); PG8_BAR; PG8_SCHED;
            PG8_LDB(B0, 1, 0); PG8_LDB(B1, 1, 1); PG8_SCHED; PG8_LDA(At, 1, 0); PG8_STAGE(PG8_SA(0, 1), a2 + hstepA, voffA);
            PG8_WAIT_V(8); PG8_WAIT_L(0); PG8_BAR; PG8_MMA(0, 0, At, B0); PG8_MMA(0, 1, At, B1); PG8_BAR; PG8_SCHED;
            PG8_LDA(At, 1, 1); PG8_STAGE(PG8_SB(1, 0), b3, voffB); PG8_STAGE(PG8_SB(1, 1), b3 + hstepB, voffB); PG8_STAGE(PG8_SA(1, 0), a3, voffA);
            PG8_WAIT_V(8); PG8_WAIT_L(0); PG8_BAR; PG8_MMA(1, 0, At, B0); PG8_MMA(1, 1, At, B1); PG8_BAR; PG8_SCHED;
        }
        if constexpr (ALIGN_EPI) { if (wr == 0) PG8_BAR; }
        if constexpr (!Epi::AFTER_DRAIN) { E(acc, cur, ui, wr, wc, fr, fq); }
        if (!has_next) break;
#pragma unroll
        for (int a = 0; a < 2; ++a)
#pragma unroll
            for (int b = 0; b < 2; ++b)
#pragma unroll
                for (int m = 0; m < 4; ++m)
#pragma unroll
                    for (int n = 0; n < 2; ++n) acc[a][b][m][n] = (f32x4){0.f, 0.f, 0.f, 0.f};
        cur = nxt; cA = nA; cB = nB; ++ui;
        if constexpr (ALIGN_EPI) { if (wr == 1) PG8_BAR; }
    }
    PG8_WAIT_V(0);
    if constexpr (!ALIGN_EPI) { if (wr == 0) PG8_BAR; }
    PG8_BAR;
    if constexpr (Epi::AFTER_DRAIN) { E.fused(acc, cur, wr, wc, fr, fq, lds, wid, lane); }
#undef PG8_SA
#undef PG8_SB
#undef PG8_STAGE
#undef PG8_LDA
#undef PG8_LDB
#undef PG8_MMA
#undef PG8_WAIT_V
#undef PG8_WAIT_L
#undef PG8_BAR
#undef PG8_SCHED
#undef PG8_ABASE
#undef PG8_BBASE
}

typedef f32x4 Acc[2][2][4][2];
__device__ __forceinline__ float ror8_1(float x) { float r; asm volatile("s_nop 1\n\tv_mov_b32_dpp %0, %1 row_ror:8 row_mask:0xf bank_mask:0xf" : "=v"(r) : "v"(x)); return r; }
__device__ __forceinline__ f32x4 ror8(const f32x4 v) { f32x4 r; r[0] = ror8_1(v[0]); r[1] = ror8_1(v[1]); r[2] = ror8_1(v[2]); r[3] = ror8_1(v[3]); return r; }
__device__ __forceinline__ f32x4 sel4(bool c, const f32x4 a, const f32x4 b) { f32x4 r;
#pragma unroll
    for (int i = 0; i < 4; ++i) r[i] = c ? a[i] : b[i]; return r; }
__device__ __forceinline__ void ld_lines(const float* p, int ldf, bool lo, int fr7, f32x4& n0, f32x4& n1, int hoff = 16) {
    const float* q = p + (size_t)fr7 * ldf + (lo ? 0 : hoff); const f32x4 A = __builtin_nontemporal_load((const f32x4*)q), B = __builtin_nontemporal_load((const f32x4*)(q + (size_t)8 * ldf));
    n0 = sel4(lo, A, ror8(B)); n1 = sel4(lo, ror8(A), B); }
__device__ __forceinline__ void st_lines(float* p, int ldf, bool lo, int fr7, const f32x4 n0, const f32x4 n1, int hoff = 16) {
    float* q = p + (size_t)fr7 * ldf + (lo ? 0 : hoff); *(f32x4*)q = sel4(lo, n0, ror8(n1)); *(f32x4*)(q + (size_t)8 * ldf) = sel4(lo, ror8(n0), n1); }
__device__ __forceinline__ u32x4 asu(const f32x4 v) { return __builtin_bit_cast(u32x4, v); }
__device__ __forceinline__ f32x4 asf(const u32x4 v) { return __builtin_bit_cast(f32x4, v); }
__device__ __forceinline__ void st_lines16(bf16_t* p, int ld, bool lo, int fr7, const u32x4 h0, const u32x4 h1) {
    bf16_t* q = p + (size_t)fr7 * ld + (lo ? 0 : 32); *(u32x4*)q = asu(sel4(lo, asf(h0), ror8(asf(h1)))); *(u32x4*)(q + (size_t)8 * ld) = asu(sel4(lo, ror8(asf(h0)), asf(h1))); }
__device__ __forceinline__ void ld_lines16(const bf16_t* p, int ld, bool lo, int fr7, u32x4& h0, u32x4& h1) {
    const bf16_t* q = p + (size_t)fr7 * ld + (lo ? 0 : 32); const f32x4 A = asf(*(const u32x4*)q), B = asf(*(const u32x4*)(q + (size_t)8 * ld));
    h0 = asu(sel4(lo, A, ror8(B))); h1 = asu(sel4(lo, ror8(A), B)); }

constexpr int TAB_OFF = RING_BYTES + 1024;

__device__ __forceinline__ float row_rstd(const float* ss, int row) {
    float s = 0.f;
#pragma unroll
    for (int j = 0; j < 8; ++j) s += ss[(size_t)j * M + row];
    return __builtin_amdgcn_rsqf(s * (1.0f / DM) + EPS);
}
__device__ __forceinline__ u32x4 pack8(const f32x4 a, const f32x4 b) { u32x4 w; w.x = cvt_pk_bf16(a[0], a[1]); w.y = cvt_pk_bf16(a[2], a[3]); w.z = cvt_pk_bf16(b[0], b[1]); w.w = cvt_pk_bf16(b[2], b[3]); return w; }
__device__ __forceinline__ void unpack8(const u32x4 w, f32x4& a, f32x4& b) { a = (f32x4){bf_lo(w.x), bf_hi(w.x), bf_lo(w.y), bf_hi(w.y)}; b = (f32x4){bf_lo(w.z), bf_hi(w.z), bf_lo(w.w), bf_hi(w.w)}; }

__device__ __forceinline__ void fill_rstd_tab(LAS unsigned char* lds, const StaticOrder& S, const float* ss, int tid) {
    LAS float* tab = (LAS float*)(lds + TAB_OFF); Unit u;
    for (int i = 0; i < 8 && S.next(i, u); ++i) if (tid < 256) tab[i * 256 + tid] = row_rstd(ss, u.pm * BM + tid);
    __syncthreads();
}
constexpr int BTAB_OFF = RING_BYTES + 9216;
__device__ __forceinline__ void fill_tabs(LAS unsigned char* lds, const StaticOrder& S, const float* ss, const float* pb, int ncols, int tid) {
    LAS float* tab = (LAS float*)(lds + TAB_OFF); LAS float* bt = (LAS float*)(lds + BTAB_OFF); LAS float* bh = (LAS float*)lds;
    const int c = tid & 255, h = tid >> 8;
    Unit u0; S.next(0, u0);
    float sb[6], sr[3];
#pragma unroll
    for (int i = 0; i < 6; ++i) { Unit u; if (!S.next(i, u)) u = u0; const float* p = pb + (size_t)((u.pm >> 4) * 32 + 16 * h) * ncols + u.pn * BM + c; float s = 0.f;
#pragma unroll
        for (int kb = 0; kb < 16; ++kb) s += p[(size_t)kb * ncols];
        sb[i] = s; }
#pragma unroll
    for (int j = 0; j < 3; ++j) { Unit u; if (!S.next(2 * j + h, u)) u = u0; sr[j] = row_rstd(ss, u.pm * BM + c); }
#pragma unroll
    for (int j = 0; j < 3; ++j) tab[(2 * j + h) * 256 + c] = sr[j];
    if (h) {
#pragma unroll
        for (int i = 0; i < 6; ++i) bh[i * 256 + c] = sb[i]; }
    __syncthreads();
    if (!h) {
#pragma unroll
        for (int i = 0; i < 6; ++i) bt[i * 256 + c] = sb[i] + bh[i * 256 + c]; }
    __syncthreads();
}
struct EpiZ {
    static constexpr int PERM = 2; static constexpr bool AFTER_DRAIN = false, MIDK = false;
    const LAS float* tab; const LAS float* btab; bf16_t* xrnn; bf16_t* gg; bf16_t* xpool; bf16_t* rg; int midk_t;
    __device__ __forceinline__ void mid(Acc&, const Unit&, int, int, int, int) const {}
    __device__ __forceinline__ void operator()(const Acc& acc, const Unit& u, int ui, int wr, int wc, int fr, int fq) const {
        { int t_ = threadIdx.x; asm volatile("" : "+v"(t_)); fr = t_ & 15; fq = (t_ >> 4) & 3; }
        const int row0 = u.pm * BM + wr * 64, b = u.pm >> 4, lc0 = wc * 64 + 8 * fq; const bool lo = fr < 8; const int fr7 = fr & 7;
        const LAS float* rtab = tab + ui * 256 + wr * 64 + fr;
        const LAS float* bp = btab + ui * 256 + lc0;
        f32x4 bv[2][2];
#pragma unroll
        for (int bj = 0; bj < 2; ++bj)
#pragma unroll
            for (int n = 0; n < 2; ++n) bv[bj][n] = *(const LAS f32x4*)(bp + 32 * bj + 4 * n);
        bf16_t* d0; int ld, mode = 0;
        if (u.pn < 8) { d0 = xrnn + u.pn * BM + lc0; ld = DRNN; }
        else if (u.pn < 16) { d0 = gg + (u.pn - 8) * BM + lc0; ld = DRNN; mode = 1; }
        else if (u.pn < 20) { d0 = xpool + (u.pn - 16) * BM + lc0; ld = DPOOL; }
        else { d0 = rg + (u.pn - 20) * BM + lc0; ld = 2 * DM; mode = 2; }
#pragma unroll
        for (int ai = 0; ai < 2; ++ai)
#pragma unroll
            for (int m = 0; m < 4; ++m) { const int rowg = row0 + ai * HALF + m * 16; const float rs = rtab[ai * HALF + m * 16];
                f32x4 z[2][2];
#pragma unroll
                for (int bj = 0; bj < 2; ++bj)
#pragma unroll
                    for (int n = 0; n < 2; ++n) z[bj][n] = acc[ai][bj][m][n] * rs + bv[bj][n];
                if (mode == 1) {
#pragma unroll
                    for (int bj = 0; bj < 2; ++bj)
#pragma unroll
                        for (int n = 0; n < 2; ++n)
#pragma unroll
                            for (int i = 0; i < 4; ++i) z[bj][n][i] = gelu_tanh_f(z[bj][n][i]);
                } else if (mode == 2) {
#pragma unroll
                    for (int n = 0; n < 2; ++n)
#pragma unroll
                        for (int i = 0; i < 4; ++i) { const float eu = fexp2(-1.4426950409f * z[0][n][i]), ev = fminf(fexp2(-1.4426950409f * z[1][n][i]), 1e30f);
                            z[1][n][i] = frcp(1.f + ev); z[0][n][i] = (1.f + ev) * frcp(1.f + eu); }
                }
                st_lines16(d0 + (size_t)rowg * ld, ld, lo, fr7, pack8(z[0][0], z[0][1]), pack8(z[1][0], z[1][1])); }
    }
};

struct GateOrder {
    int c;
    __device__ bool next(int i, Unit& u) const { if (i >= 2 || c >= 256) return false; const int pmi = c >> 4; u.pn = c & 15; u.pm = ((pmi < 8) ? pmi : pmi + 8) + 8 * i; return true; }
};
constexpr int SCAN_OFF = RING_BYTES + 9216;
template <int CTRL> __device__ __forceinline__ float dpp_old(float oldv, float x) { return __builtin_bit_cast(float, __builtin_amdgcn_update_dpp(__builtin_bit_cast(int, oldv), __builtin_bit_cast(int, x), CTRL, 0xf, 0xf, false)); }
__device__ __forceinline__ float bcast15(float x) { return __builtin_bit_cast(float, __builtin_amdgcn_ds_swizzle(__builtin_bit_cast(int, x), 0x1F0)); }
struct EpiGates {
    static constexpr int PERM = 2; static constexpr bool AFTER_DRAIN = false, MIDK = false;
    const float* ba; const float* bx; const float* lruk; const bf16_t* xr; const bf16_t* gg; bf16_t* yab; unsigned long long* aggu; LAS unsigned char* lds; int midk_t;
    __device__ __forceinline__ void mid(Acc&, const Unit&, int, int, int, int) const {}
    __device__ __forceinline__ void operator()(const Acc& acc, const Unit& u, int ui, int wr, int wc, int fr, int fq) const {
        int tid; { int t_ = threadIdx.x; asm volatile("" : "+v"(t_)); tid = t_ & 511; fr = t_ & 15; fq = (t_ >> 4) & 3; }
        const int b = u.pm >> 4, pmb = u.pm & 15;
        const int row0 = u.pm * BM + wr * 64 + fr, chl0 = wc * 32 + 8 * fq, ch0 = u.pn * HALF + chl0;
        LAS float* CH = (LAS float*)(lds + SCAN_OFF); LAS float* CARRY = CH + 1024;
        f32x4 Pf[2][4][2], Hf[2][4][2];
        f32x4 vba[2], vbx[2], vk[2];
#pragma unroll
        for (int n = 0; n < 2; ++n) { vba[n] = *(const f32x4*)(ba + ch0 + 4 * n); vbx[n] = *(const f32x4*)(bx + ch0 + 4 * n); vk[n] = *(const f32x4*)(lruk + ch0 + 4 * n); }
#pragma unroll
        for (int ai = 0; ai < 2; ++ai) {
            f32x4 Pc[2] = {(f32x4){1.f, 1.f, 1.f, 1.f}, (f32x4){1.f, 1.f, 1.f, 1.f}}, Hc[2] = {(f32x4){0.f, 0.f, 0.f, 0.f}, (f32x4){0.f, 0.f, 0.f, 0.f}};
            const bf16_t* px = xr + (size_t)(row0 + ai * HALF) * DRNN + ch0; asm volatile("" : "+v"(px));
#pragma unroll
            for (int m = 0; m < 4; ++m) { const u32x4 xw = *(const u32x4*)px; px += 16 * DRNN; f32x4 xv[2]; unpack8(xw, xv[0], xv[1]);
#pragma unroll
                for (int n = 0; n < 2; ++n) {
#pragma unroll
                    for (int i = 0; i < 4; ++i) { const float r = sigmoid_f(acc[ai][0][m][n][i] + vba[n][i]), g = sigmoid_f(acc[ai][1][m][n][i] + vbx[n][i]);
                        float P = fexp2(1.4426950409f * vk[n][i] * r), H = __builtin_amdgcn_sqrtf(fmaxf(1.f - P * P, 0.f)) * (g * xv[n][i]);
                        { const float Pp = dpp_old<0x111>(1.f, P), Hp = dpp_old<0x111>(0.f, H); H = P * Hp + H; P = P * Pp; }
                        { const float Pp = dpp_old<0x112>(1.f, P), Hp = dpp_old<0x112>(0.f, H); H = P * Hp + H; P = P * Pp; }
                        { const float Pp = dpp_old<0x114>(1.f, P), Hp = dpp_old<0x114>(0.f, H); H = P * Hp + H; P = P * Pp; }
                        { const float Pp = dpp_old<0x118>(1.f, P), Hp = dpp_old<0x118>(0.f, H); H = P * Hp + H; P = P * Pp; }
                        const float Pt = bcast15(P), Ht = bcast15(H);
                        Hf[ai][m][n][i] = P * Hc[n][i] + H; Pf[ai][m][n][i] = P * Pc[n][i];
                        Hc[n][i] = Pt * Hc[n][i] + Ht; Pc[n][i] = Pt * Pc[n][i]; }
                    asm volatile("" : "+v"(Hf[ai][m][n]), "+v"(Pf[ai][m][n]), "+v"(Hc[n]), "+v"(Pc[n]) :: "memory"); } }
            if (fr == 0) {
#pragma unroll
                for (int n = 0; n < 2; ++n) { *(LAS f32x4*)(CH + ((2 * ai + wr) * 2 + 0) * 128 + chl0 + 4 * n) = Pc[n]; *(LAS f32x4*)(CH + ((2 * ai + wr) * 2 + 1) * 128 + chl0 + 4 * n) = Hc[n]; } }
        }
        asm volatile("s_waitcnt lgkmcnt(0)" ::: "memory"); __builtin_amdgcn_s_barrier(); asm volatile("" ::: "memory");
        {
            const int tc = tid & 127, jg = tid >> 7;
            unsigned long long* gbase = aggu + (size_t)(b * 16) * DRNN + u.pn * HALF + tc;
            if (jg == 0) { float P = 1.f, H = 0.f;
#pragma unroll
                for (int c = 0; c < 4; ++c) { const float p = CH[(c * 2 + 0) * 128 + tc], h = CH[(c * 2 + 1) * 128 + tc]; H = p * H + h; P = p * P; }
                __hip_atomic_store(gbase + (size_t)pmb * DRNN, ((unsigned long long)__float_as_uint(H) << 32) | (unsigned long long)__float_as_uint(-P), __ATOMIC_RELAXED, __HIP_MEMORY_SCOPE_AGENT); }
            float Pq = 1.f, Hq = 0.f;
            if (4 * jg < pmb) {
                unsigned long long gq[4]; unsigned spins = 0;
                for (;;) { bool ok = true;
#pragma unroll
                    for (int j = 0; j < 4; ++j) { gq[j] = 0x80000000ull; if (4 * jg + j < pmb) { gq[j] = __hip_atomic_load(gbase + (size_t)(4 * jg + j) * DRNN, __ATOMIC_RELAXED, __HIP_MEMORY_SCOPE_AGENT); ok = ok && ((gq[j] >> 31) & 1ull); } }
                    if (__all(ok) || ++spins > (1u << 20)) break;
                    __builtin_amdgcn_s_sleep(4); }
#pragma unroll
                for (int j = 0; j < 4; ++j) if (4 * jg + j < pmb) { const float p = -__uint_as_float((unsigned)gq[j]), h = __uint_as_float((unsigned)(gq[j] >> 32)); Hq = p * Hq + h; Pq = p * Pq; }
            }
            LAS float* PART = (LAS float*)(lds + TAB_OFF);
            PART[(jg * 2 + 0) * 128 + tc] = Pq; PART[(jg * 2 + 1) * 128 + tc] = Hq;
        }
        asm volatile("s_waitcnt lgkmcnt(0)" ::: "memory"); __builtin_amdgcn_s_barrier(); asm volatile("" ::: "memory");
        if (tid < 128) { const LAS float* PART = (const LAS float*)(lds + TAB_OFF); float hin = 0.f;
#pragma unroll
            for (int jg = 0; jg < 4; ++jg) hin = PART[(jg * 2 + 0) * 128 + tid] * hin + PART[(jg * 2 + 1) * 128 + tid];
            CARRY[tid] = hin; }
        asm volatile("s_waitcnt lgkmcnt(0)" ::: "memory"); __builtin_amdgcn_s_barrier(); asm volatile("" ::: "memory");
#pragma unroll
        for (int ai = 0; ai < 2; ++ai) {
            f32x4 hp[2];
#pragma unroll
            for (int n = 0; n < 2; ++n) { hp[n] = *(const LAS f32x4*)(CARRY + chl0 + 4 * n);
#pragma unroll
                for (int c = 0; c < 3; ++c) if (c < 2 * ai + wr) hp[n] = *(const LAS f32x4*)(CH + (c * 2 + 0) * 128 + chl0 + 4 * n) * hp[n] + *(const LAS f32x4*)(CH + (c * 2 + 1) * 128 + chl0 + 4 * n); }
            const bf16_t* pg = gg + (size_t)(row0 + ai * HALF) * DRNN + ch0; bf16_t* py = yab + (size_t)(row0 + ai * HALF) * 3072 + ch0; asm volatile("" : "+v"(pg), "+v"(py));
#pragma unroll
            for (int m = 0; m < 4; ++m) { const u32x4 gw = __builtin_nontemporal_load((const u32x4*)pg); pg += 16 * DRNN; f32x4 g0, g1; unpack8(gw, g0, g1);
                *(u32x4*)py = pack8((Hf[ai][m][0] + Pf[ai][m][0] * hp[0]) * g0, (Hf[ai][m][1] + Pf[ai][m][1] * hp[1]) * g1); py += 16 * 3072; asm volatile("" ::: "memory"); }
        }
    }
};

struct EpiPool {
    static constexpr int PERM = 2; static constexpr bool AFTER_DRAIN = false, MIDK = false;
    const float* pb; const float* ps; bf16_t* yab; int midk_t;
    __device__ __forceinline__ void mid(Acc&, const Unit&, int, int, int, int) const {}
    __device__ __forceinline__ void operator()(const Acc& acc, const Unit& u, int ui, int wr, int wc, int fr, int fq) const {
        { int t_ = threadIdx.x; asm volatile("" : "+v"(t_)); fr = t_ & 15; fq = (t_ >> 4) & 3; }
        const int c0 = u.pn * BM + wc * 64 + 8 * fq; const bool lo = fr < 8; const int fr7 = fr & 7;
        f32x4 bv[2][2], sv[2][2];
#pragma unroll
        for (int bj = 0; bj < 2; ++bj)
#pragma unroll
            for (int n = 0; n < 2; ++n) { bv[bj][n] = *(const f32x4*)(pb + c0 + 32 * bj + 4 * n); sv[bj][n] = *(const f32x4*)(ps + c0 + 32 * bj + 4 * n); }
#pragma unroll
        for (int ai = 0; ai < 2; ++ai)
#pragma unroll
            for (int m = 0; m < 4; ++m) { bf16_t* p = yab + (size_t)(u.pm * BM + ai * HALF + wr * 64 + m * 16) * 3072 + 2048 + c0;
                st_lines16(p, 3072, lo, fr7, pack8((acc[ai][0][m][0] + bv[0][0]) * sv[0][0], (acc[ai][0][m][1] + bv[0][1]) * sv[0][1]), pack8((acc[ai][1][m][0] + bv[1][0]) * sv[1][0], (acc[ai][1][m][1] + bv[1][1]) * sv[1][1]));
                asm volatile("" ::: "memory"); }
    }
};

struct EpiMerge {
    static constexpr int PERM = 2; static constexpr bool AFTER_DRAIN = false, MIDK = true;
    const bf16_t* rg; bf16_t* merged; int midk_t;
    __device__ __forceinline__ void mid(Acc& acc, const Unit& u, int wr, int wc, int fr, int fq) const {
        { int t_ = threadIdx.x; asm volatile("" : "+v"(t_)); fr = t_ & 15; fq = (t_ >> 4) & 3; }
        const int rc0 = 256 * (2 * u.pn + (wc >> 1)) + 128 * (wc & 1) + 8 * fq;
#pragma unroll
        for (int ai = 0; ai < 2; ++ai)
#pragma unroll
            for (int m = 0; m < 4; ++m) {
                const bf16_t* pr = rg + (size_t)(u.pm * BM + ai * HALF + wr * 64 + m * 16 + fr) * (2 * DM) + rc0; const u32x4 h0 = __builtin_nontemporal_load((const u32x4*)pr), h1 = __builtin_nontemporal_load((const u32x4*)(pr + 64));
                f32x4 a, b; unpack8(h0, a, b); acc[ai][0][m][0] *= a; acc[ai][0][m][1] *= b; unpack8(h1, a, b); acc[ai][1][m][0] *= a; acc[ai][1][m][1] *= b;
                asm volatile("" ::: "memory"); }
    }
    __device__ __forceinline__ void operator()(const Acc& acc, const Unit& u, int ui, int wr, int wc, int fr, int fq) const {
        { int t_ = threadIdx.x; asm volatile("" : "+v"(t_)); fr = t_ & 15; fq = (t_ >> 4) & 3; }
        const int c0 = u.pn * BM + wc * 64 + 8 * fq; const bool lo = fr < 8; const int fr7 = fr & 7;
        const int rc0 = 256 * (2 * u.pn + (wc >> 1)) + 128 * (wc & 1) + 8 * fq + 32;
#pragma unroll
        for (int ai = 0; ai < 2; ++ai)
#pragma unroll
            for (int m = 0; m < 4; ++m) { const size_t goff = (size_t)(u.pm * BM + ai * HALF + wr * 64 + m * 16) * DM + c0;
                const bf16_t* pr = rg + (size_t)(u.pm * BM + ai * HALF + wr * 64 + m * 16 + fr) * (2 * DM) + rc0; const u32x4 h0 = __builtin_nontemporal_load((const u32x4*)pr), h1 = __builtin_nontemporal_load((const u32x4*)(pr + 64)); f32x4 a0, b0, a1, b1; unpack8(h0, a0, b0); unpack8(h1, a1, b1);
                st_lines16(merged + goff, DM, lo, fr7, pack8(acc[ai][0][m][0] * a0, acc[ai][0][m][1] * b0), pack8(acc[ai][1][m][0] * a1, acc[ai][1][m][1] * b1));
                asm volatile("" ::: "memory"); }
    }
};

template <bool F32SRC>
struct EpiResid {
    static constexpr int PERM = 2; static constexpr bool AFTER_DRAIN = true, MIDK = false;
    const float* xsrc_f;
    const bf16_t* xsrc_b; const float* gsrc;
    bf16_t* xg; const float* gt; const float* gm; float* ss; int midk_t;
    __device__ __forceinline__ void mid(Acc&, const Unit&, int, int, int, int) const {}
    __device__ __forceinline__ void operator()(const Acc&, const Unit&, int, int, int, int, int) const {}
    __device__ __forceinline__ void fused(const Acc& acc, const Unit& u, int wr, int wc, int fr, int fq, LAS unsigned char* lds, int wid, int lane) const {
        { int t_ = threadIdx.x; asm volatile("" : "+v"(t_)); fr = t_ & 15; fq = (t_ >> 4) & 3; }
        const int b = u.pm >> 4, col0 = u.pn * BM + wc * 64 + 8 * fq;
        LAS float* P = (LAS float*)lds;
        const bool lo = fr < 8; const int fr7 = fr & 7;
        f32x4 gv[2][2], gmv[2][2], rgv[2][2];
#pragma unroll
        for (int bj = 0; bj < 2; ++bj)
#pragma unroll
            for (int n = 0; n < 2; ++n) { const size_t ci = (size_t)b * DM + col0 + 32 * bj + 4 * n; gv[bj][n] = *(const f32x4*)(gt + ci); gmv[bj][n] = *(const f32x4*)(gm + ci);
                if constexpr (!F32SRC) { const f32x4 gs = *(const f32x4*)(gsrc + ci); rgv[bj][n] = (f32x4){1.0f / gs[0], 1.0f / gs[1], 1.0f / gs[2], 1.0f / gs[3]}; } else rgv[bj][n] = (f32x4){1.f, 1.f, 1.f, 1.f}; }
#pragma unroll
        for (int ai = 0; ai < 2; ++ai)
#pragma unroll
            for (int m = 0; m < 4; ++m) { const size_t goff = (size_t)(u.pm * BM + ai * HALF + wr * 64 + m * 16) * DM + col0;
                float q = 0.f; u32x4 pk[2]; f32x4 x[2][2];
                if constexpr (F32SRC) {
#pragma unroll
                    for (int bj = 0; bj < 2; ++bj) ld_lines(xsrc_f + goff + 32 * bj, DM, lo, fr7, x[bj][0], x[bj][1], 4);
                } else { u32x4 h0, h1; ld_lines16(xsrc_b + goff, DM, lo, fr7, h0, h1); unpack8(h0, x[0][0], x[0][1]); unpack8(h1, x[1][0], x[1][1]);
#pragma unroll
                    for (int bj = 0; bj < 2; ++bj) { x[bj][0] *= rgv[bj][0]; x[bj][1] *= rgv[bj][1]; } }
#pragma unroll
                for (int bj = 0; bj < 2; ++bj) { const f32x4 y0 = x[bj][0] + gv[bj][0] * acc[ai][bj][m][0], y1 = x[bj][1] + gv[bj][1] * acc[ai][bj][m][1];
                    q += ((y0[0] * y0[0] + y0[1] * y0[1]) + (y0[2] * y0[2] + y0[3] * y0[3])) + ((y1[0] * y1[0] + y1[1] * y1[1]) + (y1[2] * y1[2] + y1[3] * y1[3]));
                    pk[bj] = pack8(y0 * gmv[bj][0], y1 * gmv[bj][1]); }
                st_lines16(xg + goff, DM, lo, fr7, pk[0], pk[1]);
                q += __shfl_xor(q, 16); q += __shfl_xor(q, 32); if (fq == 0) P[(ai * HALF + wr * 64 + m * 16 + fr) * 4 + wc] = q;
                asm volatile("" ::: "memory"); }
        asm volatile("s_waitcnt lgkmcnt(0)" ::: "memory"); __builtin_amdgcn_s_barrier(); asm volatile("" ::: "memory");
        const int t = wid * 64 + lane;
        if (t < 256) { const float s = (P[t * 4 + 0] + P[t * 4 + 1]) + (P[t * 4 + 2] + P[t * 4 + 3]); ss[(size_t)u.pn * M + u.pm * BM + t] = s; }
    }
};

struct EpiFinal {
    static constexpr int PERM = 2; static constexpr bool AFTER_DRAIN = true, MIDK = false;
    const bf16_t* xsrc_b; const float* gsrc; float* out; const float* gt; const float* fg; unsigned* fss; int midk_t;
    __device__ __forceinline__ void mid(Acc&, const Unit&, int, int, int, int) const {}
    __device__ __forceinline__ void operator()(const Acc&, const Unit&, int, int, int, int, int) const {}
    __device__ __forceinline__ void fused(const Acc& acc, const Unit& u, int wr, int wc, int fr, int fq, LAS unsigned char* lds, int wid, int lane) const {
        { int t_ = threadIdx.x; asm volatile("" : "+v"(t_)); fr = t_ & 15; fq = (t_ >> 4) & 3; }
        const int b = u.pm >> 4, col0 = u.pn * BM + wc * 64 + 8 * fq;
        LAS float* P = (LAS float*)lds;
        const bool lo = fr < 8; const int fr7 = fr & 7;
        f32x4 xn[2][2][4][2]; f32x4 gv[2][2], rgv[2][2];
#pragma unroll
        for (int bj = 0; bj < 2; ++bj)
#pragma unroll
            for (int n = 0; n < 2; ++n) { const size_t ci = (size_t)b * DM + col0 + 32 * bj + 4 * n; gv[bj][n] = *(const f32x4*)(gt + ci); const f32x4 gs = *(const f32x4*)(gsrc + ci); rgv[bj][n] = (f32x4){1.0f / gs[0], 1.0f / gs[1], 1.0f / gs[2], 1.0f / gs[3]}; }
#pragma unroll
        for (int ai = 0; ai < 2; ++ai)
#pragma unroll
            for (int m = 0; m < 4; ++m) { const size_t goff = (size_t)(u.pm * BM + ai * HALF + wr * 64 + m * 16) * DM + col0; float q = 0.f;
                u32x4 h0, h1; ld_lines16(xsrc_b + goff, DM, lo, fr7, h0, h1); f32x4 xs[2][2]; unpack8(h0, xs[0][0], xs[0][1]); unpack8(h1, xs[1][0], xs[1][1]);
#pragma unroll
                for (int bj = 0; bj < 2; ++bj) { const f32x4 x0 = xs[bj][0] * rgv[bj][0], x1 = xs[bj][1] * rgv[bj][1];
                    const f32x4 v0 = x0 + gv[bj][0] * acc[ai][bj][m][0], v1 = x1 + gv[bj][1] * acc[ai][bj][m][1]; xn[ai][bj][m][0] = v0; xn[ai][bj][m][1] = v1;
                    q += ((v0[0] * v0[0] + v0[1] * v0[1]) + (v0[2] * v0[2] + v0[3] * v0[3])) + ((v1[0] * v1[0] + v1[1] * v1[1]) + (v1[2] * v1[2] + v1[3] * v1[3]));
                    asm volatile("" : "+v"(xn[ai][bj][m][0]), "+v"(xn[ai][bj][m][1]), "+v"(q) :: "memory"); }
                q += __shfl_xor(q, 16); q += __shfl_xor(q, 32); if (fq == 0) P[(ai * HALF + wr * 64 + m * 16 + fr) * 4 + wc] = q; }
        asm volatile("s_waitcnt lgkmcnt(0)" ::: "memory"); __builtin_amdgcn_s_barrier(); asm volatile("" ::: "memory");
        const int t = wid * 64 + lane;
        if (t < 256) {
            const float s = (P[t * 4 + 0] + P[t * 4 + 1]) + (P[t * 4 + 2] + P[t * 4 + 3]);
            unsigned* w0 = fss + (size_t)u.pm * BM + t;
            __hip_atomic_store(w0 + (size_t)u.pn * M, __float_as_uint(-s), __ATOMIC_RELAXED, __HIP_MEMORY_SCOPE_AGENT);
            unsigned wv[8]; unsigned spins = 0;
            for (;;) { bool ok = true;
#pragma unroll
                for (int j = 0; j < 8; ++j) { wv[j] = __hip_atomic_load(w0 + (size_t)j * M, __ATOMIC_RELAXED, __HIP_MEMORY_SCOPE_AGENT); ok = ok && (wv[j] >> 31); }
                if (__all(ok) || ++spins > (1u << 20)) break;
                __builtin_amdgcn_s_sleep(4); }
            float tot = 0.f;
#pragma unroll
            for (int j = 0; j < 8; ++j) tot += -__uint_as_float(wv[j]);
            P[1024 + t] = __builtin_amdgcn_rsqf(tot * (1.0f / DM) + EPS);
        }
        asm volatile("s_waitcnt lgkmcnt(0)" ::: "memory"); __builtin_amdgcn_s_barrier(); asm volatile("" ::: "memory");
        f32x4 fv[2][2];
#pragma unroll
        for (int bj = 0; bj < 2; ++bj)
#pragma unroll
            for (int n = 0; n < 2; ++n) fv[bj][n] = *(const f32x4*)(fg + col0 + 32 * bj + 4 * n);
#pragma unroll
        for (int ai = 0; ai < 2; ++ai)
#pragma unroll
            for (int m = 0; m < 4; ++m) { const size_t goff = (size_t)(u.pm * BM + ai * HALF + wr * 64 + m * 16) * DM + col0; const float rs = P[1024 + ai * HALF + wr * 64 + m * 16 + fr];
#pragma unroll
                for (int bj = 0; bj < 2; ++bj) st_lines(out + goff + 32 * bj, DM, lo, fr7, xn[ai][bj][m][0] * rs * fv[bj][0], xn[ai][bj][m][1] * rs * fv[bj][1], 4);
                asm volatile("" ::: "memory"); }
    }
};

template <bool PREV> __device__ __forceinline__ f32x4 conv_taps(const f32x4 c, const f32x4 uu, const f32x4 pu, const f32x4 w1, const f32x4 w0) {
    float c0 = c[0], c1 = c[1], c2 = c[2], c3 = c[3];
    asm("s_nop 1\n\t"
        "v_fmac_f32_dpp %0, %4, %8 row_shr:1 row_mask:0xf bank_mask:0xf\n\t"
        "v_fmac_f32_dpp %1, %5, %9 row_shr:1 row_mask:0xf bank_mask:0xf\n\t"
        "v_fmac_f32_dpp %2, %6, %10 row_shr:1 row_mask:0xf bank_mask:0xf\n\t"
        "v_fmac_f32_dpp %3, %7, %11 row_shr:1 row_mask:0xf bank_mask:0xf\n\t"
        "v_fmac_f32_dpp %0, %4, %12 row_shr:2 row_mask:0xf bank_mask:0xf\n\t"
        "v_fmac_f32_dpp %1, %5, %13 row_shr:2 row_mask:0xf bank_mask:0xf\n\t"
        "v_fmac_f32_dpp %2, %6, %14 row_shr:2 row_mask:0xf bank_mask:0xf\n\t"
        "v_fmac_f32_dpp %3, %7, %15 row_shr:2 row_mask:0xf bank_mask:0xf"
        : "+v"(c0), "+v"(c1), "+v"(c2), "+v"(c3)
        : "v"(uu[0]), "v"(uu[1]), "v"(uu[2]), "v"(uu[3]), "v"(w1[0]), "v"(w1[1]), "v"(w1[2]), "v"(w1[3]), "v"(w0[0]), "v"(w0[1]), "v"(w0[2]), "v"(w0[3]));
    if constexpr (PREV) {
        asm("s_nop 1\n\t"
            "v_fmac_f32_dpp %0, %4, %8 row_shl:15 row_mask:0xf bank_mask:0xf\n\t"
            "v_fmac_f32_dpp %1, %5, %9 row_shl:15 row_mask:0xf bank_mask:0xf\n\t"
            "v_fmac_f32_dpp %2, %6, %10 row_shl:15 row_mask:0xf bank_mask:0xf\n\t"
            "v_fmac_f32_dpp %3, %7, %11 row_shl:15 row_mask:0xf bank_mask:0xf\n\t"
            "v_fmac_f32_dpp %0, %4, %12 row_shl:14 row_mask:0xf bank_mask:0xf\n\t"
            "v_fmac_f32_dpp %1, %5, %13 row_shl:14 row_mask:0xf bank_mask:0xf\n\t"
            "v_fmac_f32_dpp %2, %6, %14 row_shl:14 row_mask:0xf bank_mask:0xf\n\t"
            "v_fmac_f32_dpp %3, %7, %15 row_shl:14 row_mask:0xf bank_mask:0xf"
            : "+v"(c0), "+v"(c1), "+v"(c2), "+v"(c3)
            : "v"(pu[0]), "v"(pu[1]), "v"(pu[2]), "v"(pu[3]), "v"(w1[0]), "v"(w1[1]), "v"(w1[2]), "v"(w1[3]), "v"(w0[0]), "v"(w0[1]), "v"(w0[2]), "v"(w0[3]));
    }
    return (f32x4){c0, c1, c2, c3};
}
struct EpiUp {
    static constexpr int PERM = 1; static constexpr bool AFTER_DRAIN = false, MIDK = false;
    const LAS float* tab; const LAS float* btab; const float* cw; const float* cbias; bf16_t* act; float* uh; int midk_t;
    __device__ __forceinline__ void mid(Acc&, const Unit&, int, int, int, int) const {}
    __device__ __forceinline__ void operator()(const Acc& acc, const Unit& u, int ui, int wr, int wc, int fr, int fq) const {
        { int t_ = threadIdx.x; asm volatile("" : "+v"(t_)); fr = t_ & 15; fq = (t_ >> 4) & 3; }
        const int b = u.pm >> 4, lc0 = wc * 32 + 8 * fq;
        const LAS float* rtab = tab + ui * 256 + wr * 64 + fr;
        u32x2 keep[2][4];
#pragma unroll
        for (int n = 0; n < 2; ++n) {
            const int lc = lc0 + 4 * n, ca = u.pn * HALF + lc;
            f32x4 w0[2], w1[2], w2[2], cb[2], bv[2];
#pragma unroll
            for (int bj = 0; bj < 2; ++bj) { const int nc = bj * DFF + ca;
                w0[bj] = *(const f32x4*)(cw + nc); w1[bj] = *(const f32x4*)(cw + DUP + nc); w2[bj] = *(const f32x4*)(cw + 2 * DUP + nc); cb[bj] = *(const f32x4*)(cbias + nc);
                bv[bj] = *(const LAS f32x4*)(btab + ui * 256 + bj * HALF + lc); }
#pragma unroll
            for (int ai = 0; ai < 2; ++ai) {
                const int rbase = u.pm * BM + ai * HALF + wr * 64, sb = rbase >> 6;
                f32x4 pu[2] = {(f32x4){0.f, 0.f, 0.f, 0.f}, (f32x4){0.f, 0.f, 0.f, 0.f}};
#pragma unroll
                for (int m = 0; m < 4; ++m) { const int row = rbase + m * 16 + fr; const float rs = rtab[ai * HALF + m * 16];
                    f32x4 cv[2];
#pragma unroll
                    for (int bj = 0; bj < 2; ++bj) { const f32x4 uu = acc[ai][bj][m][n] * rs + bv[bj];
                        if (m == 0 && fr < 2) *(f32x4*)(uh + ((size_t)sb * 4 + fr) * DUP + u.pn * BM + bj * HALF + lc) = uu;
                        if (m == 3 && fr >= 14) *(f32x4*)(uh + ((size_t)sb * 4 + 2 + (fr - 14)) * DUP + u.pn * BM + bj * HALF + lc) = uu;
                        const f32x4 c = cb[bj] + w2[bj] * uu;
                        cv[bj] = m == 0 ? conv_taps<false>(c, uu, uu, w1[bj], w0[bj]) : conv_taps<true>(c, uu, pu[bj], w1[bj], w0[bj]); pu[bj] = uu; }
                    f32x4 o;
#pragma unroll
                    for (int i = 0; i < 4; ++i) o[i] = cv[0][i] * sigmoid_f(cv[0][i]) * cv[1][i];
                    { u32x2 w; w.x = cvt_pk_bf16(o[0], o[1]); w.y = cvt_pk_bf16(o[2], o[3]);
                      if (n == 0) keep[ai][m] = w; else if (!(m == 0 && fr < 2)) { u32x4 w4; w4.x = keep[ai][m].x; w4.y = keep[ai][m].y; w4.z = w.x; w4.w = w.y; *(u32x4*)(act + (size_t)(rbase + m * 16 + (fr & 7) + 8 * (wc & 1)) * DFF + u.pn * HALF + 64 * (wc >> 1) + 32 * (fr >> 3) + 8 * fq) = w4; } }
                    asm volatile("" ::: "memory"); }
            }
        }
    }
};
}

constexpr int PTR_OFF = RING_BYTES + 512;
__device__ __forceinline__ unsigned long long lds_ptr(LAS unsigned char* lds, int i) {
    const volatile LAS unsigned* p = (const volatile LAS unsigned*)(lds + PTR_OFF) + 2 * i;
    const unsigned lo = __builtin_amdgcn_readfirstlane(p[0]), hi = __builtin_amdgcn_readfirstlane(p[1]);
    return ((unsigned long long)hi << 32) | lo;
}

#define XB_TMO      128
#define XB_XCNT(j)  (256  + 64 * (j))
#define XB_XSUB(j)  (1280 + 64 * (j))
#define XB_XGEN(j)  (2304 + 64 * (j))
#define XB_TOP      3328
#define XB_TOPGEN   3392
#define XCD_BAR_WORDS 3456
#define XB_SPIN_CAP (1u << 18)
__device__ __forceinline__ unsigned xb_ld(unsigned* p)              { return __hip_atomic_load(p, __ATOMIC_RELAXED, __HIP_MEMORY_SCOPE_AGENT); }
__device__ __forceinline__ unsigned xb_add(unsigned* p, unsigned v) { return __hip_atomic_fetch_add(p, v, __ATOMIC_RELAXED, __HIP_MEMORY_SCOPE_AGENT); }
__device__ __forceinline__ unsigned xb_xcc_id() { return (unsigned)__builtin_amdgcn_s_getreg((3 << 11) | 20) & 0xFu; }
#define XB_SPIN(cond, bar) do { unsigned _sp = 0; while (cond) { __builtin_amdgcn_s_sleep(1); \
    if ((++_sp & 255u) == 0u) { if (xb_ld(&(bar)[XB_TMO])) break; if (_sp > XB_SPIN_CAP) { atomicAdd(&(bar)[XB_TMO], 1u); break; } } } } while (0)
struct XcdBarrier { unsigned* bar; unsigned x; volatile LAS unsigned* st; };
__device__ __forceinline__ XcdBarrier xcd_barrier_post(unsigned* bar, volatile LAS unsigned* st) {
    XcdBarrier b; b.bar = bar; b.x = xb_xcc_id(); b.st = st;
    if (threadIdx.x == 0) (void)xb_add(&bar[XB_XCNT(b.x)], 1u);
    return b;
}
__device__ __forceinline__ void xcd_barrier_complete(unsigned* bar, unsigned x, unsigned& nloc, unsigned& nx) {
    const unsigned G = gridDim.x * gridDim.y * gridDim.z;
    unsigned sum, cnt, mine, sp = 0u;
    for (;;) {
        sum = 0u; cnt = 0u; mine = 0u;
#pragma unroll
        for (unsigned j = 0; j < 16; ++j) { const unsigned c = xb_ld(&bar[XB_XCNT(j)]); sum += c; cnt += (c > 0u) ? 1u : 0u; mine = (j == x) ? c : mine; }
        if (sum == G) break;
        __builtin_amdgcn_s_sleep(1);
        if ((++sp & 255u) == 0u) { if (xb_ld(&bar[XB_TMO])) break; if (sp > XB_SPIN_CAP) { atomicAdd(&bar[XB_TMO], 1u); break; } }
    }
    nloc = mine > 0u ? mine : 1u; nx = cnt > 0u ? cnt : 1u;
}
__device__ __forceinline__ void xcd_barrier(LAS unsigned char* lds) {
    asm volatile("s_waitcnt vmcnt(0)" ::: "memory");
    __syncthreads();
    if (threadIdx.x == 0) {
        XcdBarrier b; b.bar = (unsigned*)(lds_ptr(lds, 27) + WS_CTL) + CW_BAR; b.x = xb_xcc_id(); b.st = (volatile LAS unsigned*)(lds + MISC_OFF) + 8;
        unsigned* bar = b.bar; unsigned bx_ = b.x;
        asm volatile("" : "+v"(bar), "+s"(bx_));
        __builtin_amdgcn_s_waitcnt(0);
        unsigned nloc = b.st[0], nx = b.st[1];
        if (nloc == 0u) { xcd_barrier_complete(bar, bx_, nloc, nx); b.st[0] = nloc; b.st[1] = nx; }
        const unsigned old = xb_add(&bar[XB_XSUB(bx_)], 1u);
        const unsigned gen = old / nloc;
        if (old + 1u == (gen + 1u) * nloc) {
            __builtin_amdgcn_fence(__ATOMIC_RELEASE, "agent");
            asm volatile("s_waitcnt vmcnt(0)" ::: "memory");
            const unsigned og = xb_add(&bar[XB_TOP], 1u);
            const unsigned tg = og / nx;
            if (og + 1u == (tg + 1u) * nx) xb_add(&bar[XB_TOPGEN], 1u);
            else XB_SPIN(xb_ld(&bar[XB_TOPGEN]) == tg, bar);
            __builtin_amdgcn_fence(__ATOMIC_ACQUIRE, "agent");
            xb_add(&bar[XB_XGEN(bx_)], 1u);
            asm volatile("s_waitcnt vmcnt(0)" ::: "memory");
        } else {
            XB_SPIN(xb_ld(&bar[XB_XGEN(bx_)]) == gen, bar);
            __builtin_amdgcn_fence(__ATOMIC_ACQUIRE, "agent");
            asm volatile("s_waitcnt vmcnt(0)" ::: "memory");
        }
    }
    __syncthreads();
}

struct Args { const float* in[26]; float* out; unsigned char* ws; int ph_lo, ph_hi; };
enum { I_X = 0, I_C, I_ADAW, I_ADAB, I_NMG, I_WIN, I_BIN, I_CONVW, I_CONVB, I_WA, I_BA, I_WX, I_BX, I_LAM, I_POOLW, I_POOLB, I_POOLS, I_PROJA, I_PROJB, I_WOUT, I_NFG, I_WUP, I_FCW, I_FCB, I_WDOWN, I_FING };

template <bool BIAS>
__device__ __forceinline__ void cvt_item(const float* src, int N, bf16_t* dst, int dpitch, int k0, int n0, int drow0, int dcol, int lane,
                                         const float* sh0 = nullptr, const float* sh1 = nullptr, float* bias0 = nullptr, float* bias1 = nullptr, const float* binit = nullptr, int dstep = 32) {
    const int r = lane >> 3, q = lane & 7;
    f32x4 s0 = (f32x4){0.f, 0.f, 0.f, 0.f}, s1 = s0, t0 = s0, t1 = s0;
    f32x4 vv[2][8];
#pragma unroll
    for (int c = 0; c < 2; ++c)
#pragma unroll
        for (int j = 0; j < 8; ++j) vv[c][j] = __builtin_nontemporal_load((const f32x4*)(src + (size_t)(k0 + 8 * r + j) * N + n0 + 32 * c + 4 * q));
    if constexpr (BIAS) {
        const int kk = k0 + 8 * r; const f32x4 a0 = *(const f32x4*)(sh0 + kk), a1 = *(const f32x4*)(sh0 + kk + 4), b0 = *(const f32x4*)(sh1 + kk), b1 = *(const f32x4*)(sh1 + kk + 4);
#pragma unroll
        for (int j = 0; j < 4; ++j) { s0 += a0[j] * vv[0][j] + a1[j] * vv[0][4 + j]; s1 += b0[j] * vv[0][j] + b1[j] * vv[0][4 + j]; t0 += a0[j] * vv[1][j] + a1[j] * vv[1][4 + j]; t1 += b0[j] * vv[1][j] + b1[j] * vv[1][4 + j]; }
    }
#pragma unroll
    for (int c = 0; c < 2; ++c) {
        const f32x4 (&v)[8] = vv[c];
#pragma unroll
        for (int i = 0; i < 4; ++i) { u32x4 w; w.x = cvt_pk_bf16(v[0][i], v[1][i]); w.y = cvt_pk_bf16(v[2][i], v[3][i]); w.z = cvt_pk_bf16(v[4][i], v[5][i]); w.w = cvt_pk_bf16(v[6][i], v[7][i]);
            *(u32x4*)(dst + (size_t)(drow0 + dstep * c + 4 * q + i) * dpitch + dcol + k0 + 8 * r) = w; }
    }
    if constexpr (BIAS) {
        const int ii = r & 3, cc = r >> 2, col = 32 * cc + 4 * q + ii;
        f32x4 k0 = cc ? t0 : s0, x0 = cc ? s0 : t0, k1 = cc ? t1 : s1, x1 = cc ? s1 : t1;
#pragma unroll
        for (int i = 0; i < 4; ++i) { k0[i] += __shfl_xor(x0[i], 32); k1[i] += __shfl_xor(x1[i], 32); }
        const bool h1 = (r & 2) != 0, h0 = (r & 1) != 0;
        float a0 = h1 ? k0[2] : k0[0], a1 = h1 ? k0[3] : k0[1], b0 = h1 ? k1[2] : k1[0], b1 = h1 ? k1[3] : k1[1];
        const float xa0 = h1 ? k0[0] : k0[2], xa1 = h1 ? k0[1] : k0[3], xb0 = h1 ? k1[0] : k1[2], xb1 = h1 ? k1[1] : k1[3];
        a0 += __shfl_xor(xa0, 16); a1 += __shfl_xor(xa1, 16); b0 += __shfl_xor(xb0, 16); b1 += __shfl_xor(xb1, 16);
        float v0 = h0 ? a1 : a0, v1 = h0 ? b1 : b0;
        v0 += __shfl_xor(h0 ? a0 : a1, 8); v1 += __shfl_xor(h0 ? b0 : b1, 8);
        if (binit) { const float bi = binit[n0 + col]; v0 += bi; v1 += bi; }
        const int brow = drow0 + dstep * cc + 4 * q + ii;
        bias0[brow] = v0; bias1[brow] = v1;
    }
}
constexpr int IT_WIN = (DM / 64) * (DIN / 64), IT_LRU = 16 * 16, IT_POOL = 4 * 16, IT_PA = 32 * 32, IT_PB = 16 * 32, IT_WO = 32 * 32, IT_WUP = 32 * (DUP / 64), IT_WD = (DFF / 64) * 32;
constexpr int IT_LAYER = IT_WIN + IT_LRU + IT_POOL + IT_PA + IT_PB + IT_WO + IT_WUP + IT_WD;
__device__ __forceinline__ void cvt_one(const Args& a, int it, int lane) {
    const float* mod = (const float*)(a.ws + WS_MOD);
    {
        const int l = it / IT_LAYER; int r = it % IT_LAYER;
        bf16_t* wl = (bf16_t*)(a.ws + WS_W + (size_t)l * W_LAYER);
        const float* sh = mod + (size_t)l * NB * NADA;
        if (r < IT_WIN) { const int kb = r / (DIN / 64), nb = r % (DIN / 64), n0 = 64 * nb; int drow = n0;
            int dstep = 32;
            if (n0 >= 5120) { const int gsel = n0 - 5120, isb = gsel / 2048, ch = gsel % 2048; drow = 5120 + 256 * (ch / 128) + 64 * ((ch % 128) / 32) + 32 * isb; dstep = 64; }
            float* bo = (float*)(a.ws + WS_PB1) + ((size_t)(l * NB) * 32 + kb) * DIN;
            cvt_item<true>(a.in[I_WIN] + (size_t)l * DM * DIN, DIN, wl + W_BT1 / 2, DM, 64 * kb, n0, drow, 0, lane, sh, sh + NADA, bo, bo + (size_t)32 * DIN, kb == 0 ? a.in[I_BIN] + (size_t)l * DIN : nullptr, dstep); return; } r -= IT_WIN;
        if (r < IT_LRU) { const int mat = r / 16, idx = r % 16, isx = mat / 8, h = mat % 8, kb = idx / 4, nb = idx % 4, n0 = 64 * nb;
            const float* src = a.in[isx ? I_WX : I_WA] + ((size_t)l * 8 + h) * 256 * 256;
            cvt_item<false>(src, 256, wl + W_BTG / 2, 256, 64 * kb, n0, 512 * h + 256 * (n0 / 128) + 64 * ((n0 % 128) / 32) + 32 * isx, 0, lane, nullptr, nullptr, nullptr, nullptr, nullptr, 64); return; } r -= IT_LRU;
        if (r < IT_POOL) { const int gI = r / 16, idx = r % 16, kb = idx / 4, nb = idx % 4;
            cvt_item<false>(a.in[I_POOLW] + ((size_t)l * 4 + gI) * 256 * 256, 256, wl + W_BTP / 2, 256, 64 * kb, 64 * nb, 256 * gI + 64 * nb, 0, lane); return; } r -= IT_POOL;
        if (r < IT_PA) { const int kb = r / 32, nb = r % 32; cvt_item<false>(a.in[I_PROJA] + (size_t)l * DRNN * DM, DM, wl + W_BT3 / 2, 3072, 64 * kb, 64 * nb, 64 * nb, 0, lane); return; } r -= IT_PA;
        if (r < IT_PB) { const int kb = r / 32, nb = r % 32; cvt_item<false>(a.in[I_PROJB] + (size_t)l * DPOOL * DM, DM, wl + W_BT3 / 2, 3072, 64 * kb, 64 * nb, 64 * nb, 2048, lane); return; } r -= IT_PB;
        if (r < IT_WO) { const int kb = r / 32, nb = r % 32; cvt_item<false>(a.in[I_WOUT] + (size_t)l * DM * DM, DM, wl + W_BT4 / 2, DM, 64 * kb, 64 * nb, 64 * nb, 0, lane); return; } r -= IT_WO;
        if (r < IT_WUP) { const int kb = r / (DUP / 64), nb = r % (DUP / 64), n0 = 64 * nb, isl = n0 / DFF, ch = n0 % DFF;
            float* bo = (float*)(a.ws + WS_PB2) + ((size_t)(l * NB) * 32 + kb) * DUP;
            cvt_item<true>(a.in[I_WUP] + (size_t)l * DM * DUP, DUP, wl + W_BT5 / 2, DM, 64 * kb, n0, 256 * (ch / 128) + 128 * isl + (ch % 128), 0, lane, sh + 3 * DM, sh + NADA + 3 * DM, bo, bo + (size_t)32 * DUP, nullptr); return; } r -= IT_WUP;
        { const int kb = r / 32, nb = r % 32; cvt_item<false>(a.in[I_WDOWN] + (size_t)l * DFF * DM, DM, wl + W_BT6 / 2, DFF, 64 * kb, 64 * nb, 64 * nb, 0, lane); }
    }
}
__device__ __forceinline__ void p0_convert(const Args& a, int lo, int hi, int widx, int nw, int lane, unsigned* cnt = nullptr, int shard = 0) {
    if (cnt == nullptr) { for (int it = lo + widx; it < hi; it += nw) cvt_one(a, it, lane); return; }
    const int per = (hi - lo + 7) / 8, slo = lo + shard * per, shi = (slo + per < hi) ? slo + per : hi;
    for (;;) {
        unsigned base = 0; if (lane == 0) base = atomicAdd(cnt + 64 * shard, 2u);
        const int it0 = slo + (int)__builtin_amdgcn_readfirstlane(base);
        if (it0 >= shi) break;
        cvt_one(a, it0, lane); if (it0 + 1 < shi) cvt_one(a, it0 + 1, lane);
    }
}
constexpr int CVT_A_LO = 0, CVT_A_HI = IT_WIN;
__host__ __device__ constexpr int cvt_b_lo(int l) { return l * IT_LAYER + IT_WIN; }
__host__ __device__ constexpr int cvt_b_hi(int l) { return (l + 1) * IT_LAYER - IT_WD; }
__host__ __device__ constexpr int cvt_c_lo(int l) { return (l + 1) * IT_LAYER - IT_WD; }
__host__ __device__ constexpr int cvt_c_hi(int l) { return l + 1 < NL ? (l + 1) * IT_LAYER + IT_WIN : (l + 1) * IT_LAYER; }
__device__ __forceinline__ void p0_ada(const Args& a, LAS unsigned char* lds, int G, int tid, int bx) {
    const int wave = tid >> 6, lane = tid & 63;
    LAS float* cact = (LAS float*)lds;
    LAS float* red = (LAS float*)(lds + 16384);
    for (int i = tid; i < NB * DM; i += 512) { const float v = a.in[I_C][i]; cact[i] = v * sigmoid_f(v); }
    __syncthreads();
    float* mod = (float*)(a.ws + WS_MOD);
    for (int un = bx; un < NL * (NADA / 32); un += G) {
        const int l = un / (NADA / 32), nb = un % (NADA / 32);
        const float* wsrc = a.in[I_ADAW] + (size_t)l * DM * NADA + nb * 32 + 4 * (lane & 7);
        f32x4 s0 = (f32x4){0.f, 0.f, 0.f, 0.f}, s1 = s0;
#pragma unroll 8
        for (int rg = wave; rg < 256; rg += 8) { const int k = rg * 8 + (lane >> 3); const f32x4 wv = __builtin_nontemporal_load((const f32x4*)(wsrc + (size_t)k * NADA)); s0 += cact[k] * wv; s1 += cact[DM + k] * wv; }
#pragma unroll
        for (int i = 0; i < 4; ++i) {
#pragma unroll
            for (int o = 8; o < 64; o <<= 1) { s0[i] += __shfl_xor(s0[i], o); s1[i] += __shfl_xor(s1[i], o); } }
        if (lane < 8) {
#pragma unroll
            for (int i = 0; i < 4; ++i) { red[(wave * 2 + 0) * 32 + 4 * lane + i] = s0[i]; red[(wave * 2 + 1) * 32 + 4 * lane + i] = s1[i]; } }
        __syncthreads();
        if (tid < 64) { const int b = tid >> 5, c = tid & 31; float s = 0.f;
#pragma unroll
            for (int w = 0; w < 8; ++w) s += red[(w * 2 + b) * 32 + c];
            mod[((size_t)l * NB + b) * NADA + nb * 32 + c] = s + a.in[I_ADAB][(size_t)l * NADA + nb * 32 + c]; }
        __syncthreads();
    }
}

__device__ __forceinline__ void p0b(const Args& a, int gw, int ngw, int lane, int gtid, int ngt) {
    const float* mod = (const float*)(a.ws + WS_MOD);
    for (int i = gtid; i < NL * NB * DM; i += ngt) { const int l = i / (NB * DM), b = (i / DM) % NB, c = i % DM; const float* mm = mod + ((size_t)l * NB + b) * NADA;
        ((float*)(a.ws + WS_GM1))[i] = a.in[I_NMG][l * DM + c] * (1.f + mm[DM + c]);
        ((float*)(a.ws + WS_GT1))[i] = mm[2 * DM + c];
        ((float*)(a.ws + WS_GM2))[i] = a.in[I_NFG][l * DM + c] * (1.f + mm[4 * DM + c]);
        ((float*)(a.ws + WS_GT2))[i] = mm[5 * DM + c]; }
    for (int i = gtid; i < NL * DRNN; i += ngt) { const float lam = a.in[I_LAM][i]; ((float*)(a.ws + WS_LRUK))[i] = -8.0f * log1pf(expf(-lam)); }
    p0_convert(a, CVT_A_LO, CVT_A_HI, gw, ngw, lane);
    float* ss = (float*)(a.ws + WS_SS); bf16_t* xg = (bf16_t*)(a.ws + WS_XG);
    for (int row = gw; row < M; row += ngw) { const int b = row / SEQ; const float* xr = a.in[I_X] + (size_t)row * DM; const float* mm = mod + (size_t)b * NADA + DM; float s = 0.f;
#pragma unroll
        for (int j = 0; j < 8; ++j) { const int c = (j * 64 + lane) * 4; const f32x4 xv = __builtin_nontemporal_load((const f32x4*)(xr + c)), gv = *(const f32x4*)(a.in[I_NMG] + c), sc = *(const f32x4*)(mm + c);
            s += (xv[0] * xv[0] + xv[1] * xv[1]) + (xv[2] * xv[2] + xv[3] * xv[3]); const f32x4 y = xv * (gv * (1.f + sc));
            u32x2 w; w.x = cvt_pk_bf16(y[0], y[1]); w.y = cvt_pk_bf16(y[2], y[3]); *(u32x2*)(xg + (size_t)row * DM + c) = w; }
        s = wave_sum(s);
        if (lane < 8) ss[(size_t)lane * M + row] = lane == 0 ? s : 0.f; }
}

__device__ __forceinline__ void build_xr_tile(const Args& a, int l, int pm, int head, int tid) {
    const int strip = tid >> 5, c = head * 256 + (tid & 31) * 8, row0 = pm * 256 + strip * 16, t0 = row0 % SEQ;
    const float* cw = a.in[I_CONVW] + (size_t)l * 4 * DRNN + c; const float* cb = a.in[I_CONVB] + (size_t)l * DRNN + c;
    f32x4 w0[4], w1[4];
#pragma unroll
    for (int k = 0; k < 4; ++k) { w0[k] = *(const f32x4*)(cw + (size_t)k * DRNN); w1[k] = *(const f32x4*)(cw + (size_t)k * DRNN + 4); }
    const f32x4 b0 = *(const f32x4*)cb, b1 = *(const f32x4*)(cb + 4);
    const bf16_t* src = (const bf16_t*)(a.ws + WS_XRNN) + (size_t)row0 * DRNN + c; bf16_t* dst = (bf16_t*)(a.ws + WS_XR) + (size_t)row0 * DRNN + c;
    f32x4 h0[3], h1[3];
#pragma unroll
    for (int d = 0; d < 3; ++d) { h0[d] = (f32x4){0.f, 0.f, 0.f, 0.f}; h1[d] = h0[d]; if (t0 >= 3 - d) { const u32x4 w = *(const u32x4*)(src - (size_t)(3 - d) * DRNN); pg8::unpack8(w, h0[d], h1[d]); } }
#pragma unroll
    for (int j = 0; j < 16; ++j) { const u32x4 w = *(const u32x4*)(src + (size_t)j * DRNN); f32x4 x0, x1; pg8::unpack8(w, x0, x1);
        const f32x4 o0 = b0 + w0[0] * h0[0] + w0[1] * h0[1] + w0[2] * h0[2] + w0[3] * x0, o1 = b1 + w1[0] * h1[0] + w1[1] * h1[1] + w1[2] * h1[2] + w1[3] * x1;
        *(u32x4*)(dst + (size_t)j * DRNN) = pg8::pack8(o0, o1);
        h0[0] = h0[1]; h0[1] = h0[2]; h0[2] = x0; h1[0] = h1[1]; h1[1] = h1[2]; h1[2] = x1; }
}
__device__ __forceinline__ void build_pp_tile(const Args& a, int pm, int g, int tid) {
    const int strip = tid >> 5, c = g * 256 + (tid & 31) * 8, row0 = pm * 256 + strip * 16, t0 = row0 % SEQ, win = 2 << g;
    const bf16_t* src = (const bf16_t*)(a.ws + WS_XPOOL) + (size_t)row0 * DPOOL + c; bf16_t* dst = (bf16_t*)(a.ws + WS_PP) + (size_t)row0 * DPOOL + c;
    f32x4 s0 = (f32x4){0.f, 0.f, 0.f, 0.f}, s1 = s0;
    for (int d = 1; d < win; ++d) if (t0 >= d) { const u32x4 w = *(const u32x4*)(src - (size_t)d * DPOOL); f32x4 y0, y1; pg8::unpack8(w, y0, y1); s0 += y0; s1 += y1; }
#pragma unroll 4
    for (int j = 0; j < 16; ++j) { const int t = t0 + j; const u32x4 w = *(const u32x4*)(src + (size_t)j * DPOOL); f32x4 x0, x1; pg8::unpack8(w, x0, x1); s0 += x0; s1 += x1;
        const float inv = 1.0f / (float)((t + 1 < win) ? t + 1 : win);
        *(u32x4*)(dst + (size_t)j * DPOOL) = pg8::pack8(s0 * inv - x0, s1 * inv - x1);
        if (t - (win - 1) >= 0) { const u32x4 wo = *(const u32x4*)(src + (size_t)(j - (win - 1)) * DPOOL); f32x4 y0, y1; pg8::unpack8(wo, y0, y1); s0 -= y0; s1 -= y1; } }
}

__device__ __forceinline__ void p5_fixup(const Args& a, int l, int gtid, int ngt) {
    const float* uh = (const float*)(a.ws + WS_UH); bf16_t* act = (bf16_t*)(a.ws + WS_ACT);
    const float* cw = a.in[I_FCW] + (size_t)l * 3 * DUP; const float* cb = a.in[I_FCB] + (size_t)l * DUP;
    for (int it = gtid; it < 128 * 2 * DFF; it += ngt) { const int ch = it % DFF, r = (it / DFF) & 1, sb = it / (2 * DFF), row = 64 * sb + r;
        const int j = ch / 128, w = ch % 128; const bool edge = (sb % 64) == 0; float cv[2];
#pragma unroll
        for (int bj = 0; bj < 2; ++bj) { const int tc = 256 * j + 128 * bj + w, nc = bj * DFF + ch;
            const float u0 = uh[((size_t)sb * 4 + r) * DUP + tc];
            float u1, u2;
            if (r == 1) { u1 = uh[((size_t)sb * 4 + 0) * DUP + tc]; u2 = edge ? 0.f : uh[((size_t)(sb - 1) * 4 + 3) * DUP + tc]; }
            else { u1 = edge ? 0.f : uh[((size_t)(sb - 1) * 4 + 3) * DUP + tc]; u2 = edge ? 0.f : uh[((size_t)(sb - 1) * 4 + 2) * DUP + tc]; }
            cv[bj] = cb[nc] + cw[2 * DUP + nc] * u0 + cw[DUP + nc] * u1 + cw[nc] * u2; }
        const float o = cv[0] * sigmoid_f(cv[0]) * cv[1];
        act[(size_t)(row + 8 * ((ch >> 5) & 1)) * DFF + (ch & ~32)] = (bf16_t)(cvt_pk_bf16(o, 0.f) & 0xffffu); }
}

__device__ __forceinline__ void p_final(const Args& a, int gw, int ngw, int lane) {
    const float* X = (const float*)(a.ws + WS_X); const float* ss = (const float*)(a.ws + WS_SS);
    for (int row = gw; row < M; row += ngw) { const float rs = pg8::row_rstd(ss, row);
#pragma unroll
        for (int j = 0; j < 8; ++j) { const int c = (j * 64 + lane) * 4; *(f32x4*)(a.out + (size_t)row * DM + c) = *(const f32x4*)(X + (size_t)row * DM + c) * rs * *(const f32x4*)(a.in[I_FING] + c); } }
}

constexpr int PH_P0A = 0, PH_P0B = 1, PH_LAYER0 = 2, PH_PER_LAYER = 7, PH_FINAL = -1000, N_PHASES = PH_LAYER0 + NL * PH_PER_LAYER;
__host__ __device__ constexpr int phase_kind(int ph) {
    if (ph == PH_P0A) return 0; if (ph == PH_P0B) return 1; if (ph == PH_FINAL) return 11;
    const int sub = (ph - PH_LAYER0) % PH_PER_LAYER;
    return sub == 0 ? 2 : sub == 1 ? 4 : 4 + sub;
}
template <int KIND, bool DUMMY = false>
__device__ __forceinline__ void run_kind(int ph, LAS unsigned char* lds) {
    int tid = threadIdx.x, bx = blockIdx.x, G = gridDim.x; asm volatile("" : "+v"(tid), "+s"(bx), "+s"(G));
    const int lane = tid & 63, wave = __builtin_amdgcn_readfirstlane(tid >> 6);
    const int vcu = (G % 8 == 0) ? (bx % 8) * (G / 8) + bx / 8 : bx;
    const int gw = vcu * NWAVES + wave, ngw = G * NWAVES, gtid = bx * 512 + tid, ngt = G * 512;
    Args a;
#pragma unroll
    for (int i = 0; i < 26; ++i) a.in[i] = (const float*)lds_ptr(lds, i);
    a.out = (float*)lds_ptr(lds, 26); a.ws = (unsigned char*)lds_ptr(lds, 27); a.ph_lo = ph; a.ph_hi = ph + 1;
    asm volatile("" : "+s"(ph));
    const int l = (ph - PH_LAYER0) / PH_PER_LAYER;
    const bf16_t* wl = (const bf16_t*)(a.ws + WS_W + (size_t)l * W_LAYER);
    const float* ss = (const float*)(a.ws + WS_SS);
    pg8::StaticOrder S;
    if constexpr (KIND == 0) { p0_ada(a, lds, G, tid, bx); }
    else if constexpr (KIND == 1) { p0b(a, gw, ngw, lane, gtid, ngt); }
    else if constexpr (KIND == 11) { p_final(a, gw, ngw, lane); }
    else if constexpr (KIND == 2) {
        const int GGm = (G == 256 && !DUMMY) ? P1_GEMM_WGS : G;
        pg8::Gemm g{(const bf16_t*)(a.ws + WS_XG), wl + W_BT1 / 2, DM, DM, DM / 64, M / 256, DIN / 256, 31, 0}; S.init(g.nM, g.nN, GGm, bx);
        if (bx < GGm) {
        pg8::fill_tabs(lds, S, ss, (const float*)(a.ws + WS_PB1) + (size_t)(l * NB) * 32 * DIN, DIN, tid);
        pg8::EpiZ E{(const LAS float*)(lds + pg8::TAB_OFF), (const LAS float*)(lds + pg8::BTAB_OFF), (bf16_t*)(a.ws + WS_XRNN), (bf16_t*)(a.ws + WS_GG), (bf16_t*)(a.ws + WS_XPOOL), (bf16_t*)(a.ws + WS_RATIO), -1};
        pg8::gemm_phase<pg8::EpiZ, true>(lds, g, S, E);
        }
        if (!DUMMY) p0_convert(a, cvt_b_lo(l), cvt_b_hi(l), gw, ngw, lane, (unsigned*)(a.ws + WS_CTL) + CW_CVT + 512 * (2 * l), bx & 7);
    } else if constexpr (KIND == 4) {
        { pg8::Gemm g{(const bf16_t*)(a.ws + WS_XR), wl + W_BTG / 2, DRNN, 256, 4, M / 256, 16, 1, 256}; pg8::GateOrder GO{bx};
          { pg8::Unit u; for (int i = 0; i < 2 && GO.next(i, u); ++i) build_xr_tile(a, l, u.pm, u.pn >> 1, tid); }
          asm volatile("s_waitcnt vmcnt(0)" ::: "memory"); __syncthreads();
          pg8::EpiGates E{a.in[I_BA] + (size_t)l * DRNN, a.in[I_BX] + (size_t)l * DRNN, (const float*)(a.ws + WS_LRUK) + (size_t)l * DRNN, (const bf16_t*)(a.ws + WS_XR), (const bf16_t*)(a.ws + WS_GG), (bf16_t*)(a.ws + WS_YAB),
                          (unsigned long long*)(a.ws + WS_AGG) + (size_t)l * NB * 16 * DRNN, lds, -1};
          pg8::gemm_phase<pg8::EpiGates, true, pg8::GateOrder>(lds, g, GO, E); }
    } else if constexpr (KIND == 12) {
        { pg8::Gemm g{(const bf16_t*)(a.ws + WS_PP), wl + W_BTP / 2, DPOOL, 256, 4, M / 256, 4, 0, 256}; S.init(g.nM, g.nN, G, bx);
          { pg8::Unit u; for (int i = 0; i < 8 && S.next(i, u); ++i) build_pp_tile(a, u.pm, u.pn, tid); }
          asm volatile("s_waitcnt vmcnt(0)" ::: "memory"); __syncthreads();
          pg8::EpiPool E{a.in[I_POOLB] + (size_t)l * DPOOL, a.in[I_POOLS] + (size_t)l * DPOOL, (bf16_t*)(a.ws + WS_YAB), -1};
          pg8::gemm_phase<pg8::EpiPool, true>(lds, g, S, E); }
    } else if constexpr (KIND == 6) {
        pg8::Gemm g{(const bf16_t*)(a.ws + WS_YAB), wl + W_BT3 / 2, 3072, 3072, 48, M / 256, DM / 256, 31, 0}; S.init(g.nM, g.nN, G, bx);
        pg8::EpiMerge E{(const bf16_t*)(a.ws + WS_RATIO), (bf16_t*)(a.ws + WS_MERGED), 32};
        pg8::gemm_phase<pg8::EpiMerge, false>(lds, g, S, E);
    } else if constexpr (KIND == 7) {
        pg8::Gemm g{(const bf16_t*)(a.ws + WS_MERGED), wl + W_BT4 / 2, DM, DM, DM / 64, M / 256, DM / 256, 31, 0}; S.init(g.nM, g.nN, G, bx);
        const float* gt1 = (const float*)(a.ws + WS_GT1) + (size_t)l * NB * DM; const float* gm2 = (const float*)(a.ws + WS_GM2) + (size_t)l * NB * DM;
        if (l == 0) { pg8::EpiResid<true> E{a.in[I_X], nullptr, nullptr, (bf16_t*)(a.ws + WS_XG), gt1, gm2, (float*)(a.ws + WS_SS), -1}; pg8::gemm_phase<pg8::EpiResid<true>, false>(lds, g, S, E); }
        else { pg8::EpiResid<false> E{nullptr, (const bf16_t*)(a.ws + WS_XG), (const float*)(a.ws + WS_GM1) + (size_t)l * NB * DM, (bf16_t*)(a.ws + WS_XG), gt1, gm2, (float*)(a.ws + WS_SS), -1}; pg8::gemm_phase<pg8::EpiResid<false>, false>(lds, g, S, E); }
    } else if constexpr (KIND == 8) {
        const int GGm = (G == 256 && !DUMMY) ? P5_GEMM_WGS : G;
        pg8::Gemm g{(const bf16_t*)(a.ws + WS_XG), wl + W_BT5 / 2, DM, DM, DM / 64, M / 256, DUP / 256, 31, 0}; S.init(g.nM, g.nN, GGm, bx);
        if (bx < GGm) {
        pg8::fill_tabs(lds, S, ss, (const float*)(a.ws + WS_PB2) + (size_t)(l * NB) * 32 * DUP, DUP, tid);
        pg8::EpiUp E{(const LAS float*)(lds + pg8::TAB_OFF), (const LAS float*)(lds + pg8::BTAB_OFF), a.in[I_FCW] + (size_t)l * 3 * DUP, a.in[I_FCB] + (size_t)l * DUP, (bf16_t*)(a.ws + WS_ACT), (float*)(a.ws + WS_UH), -1};
        pg8::gemm_phase<pg8::EpiUp, true>(lds, g, S, E);
        }
        if (!DUMMY) p0_convert(a, cvt_c_lo(l), cvt_c_hi(l), gw, ngw, lane, (unsigned*)(a.ws + WS_CTL) + CW_CVT + 512 * (2 * l + 1), bx & 7);
    } else if constexpr (KIND == 9) { p5_fixup(a, l, gtid, ngt);
    } else {
        pg8::Gemm g{(const bf16_t*)(a.ws + WS_ACT), wl + W_BT6 / 2, DFF, DFF, DFF / 64, M / 256, DM / 256, 31, 0, 1}; S.init(g.nM, g.nN, G, bx);
        if (l == NL - 1 && !DUMMY) {
            pg8::EpiFinal E{(const bf16_t*)(a.ws + WS_XG), (const float*)(a.ws + WS_GM2) + (size_t)l * NB * DM, a.out, (const float*)(a.ws + WS_GT2) + (size_t)l * NB * DM, a.in[I_FING], (unsigned*)(a.ws + WS_FSS), -1};
            pg8::gemm_phase<pg8::EpiFinal, false>(lds, g, S, E);
        } else {
        pg8::EpiResid<false> E{nullptr, (const bf16_t*)(a.ws + WS_XG), (const float*)(a.ws + WS_GM2) + (size_t)l * NB * DM, (bf16_t*)(a.ws + (DUMMY ? WS_RATIO : WS_XG)), (const float*)(a.ws + WS_GT2) + (size_t)l * NB * DM,
                        (const float*)(a.ws + WS_GM1) + (size_t)(l + 1 < NL ? l + 1 : l) * NB * DM, (float*)(a.ws + (DUMMY ? WS_AGG : WS_SS)), -1};
        pg8::gemm_phase<pg8::EpiResid<false>, false>(lds, g, S, E);
        }
    }
}
#define MK_PROLOGUE \
    extern __shared__ __attribute__((aligned(16))) unsigned char lds_raw[]; \
    LAS unsigned char* lds = (LAS unsigned char*)lds_raw; \
    const int tid = threadIdx.x; \
    volatile LAS unsigned* MISC = (volatile LAS unsigned*)(lds + MISC_OFF); \
    for (int u = tid; u < (LDS_BYTES - RING_BYTES) / 4; u += 512) ((LAS unsigned*)(lds + RING_BYTES))[u] = 0u; \
    __syncthreads(); \
    if (tid == 0) { LAS unsigned long long* pt = (LAS unsigned long long*)(lds + PTR_OFF); \
        _Pragma("unroll") for (int i = 0; i < 26; ++i) pt[i] = (unsigned long long)a.in[i]; \
        pt[26] = (unsigned long long)a.out; pt[27] = (unsigned long long)a.ws; } \
    __syncthreads();

#if MK_ONE_LAUNCH
template <int PH> __device__ __forceinline__ void run_from(LAS unsigned char* lds) {
    if constexpr (PH < N_PHASES) {
        if constexpr (PH == PROBE_PH) { run_kind<phase_kind(PH), true>(PH, lds); if constexpr (phase_kind(PH) == 4) run_kind<12, true>(PH, lds); xcd_barrier(lds); }
        run_kind<phase_kind(PH)>(PH, lds);
        if constexpr (phase_kind(PH) == 4) run_kind<12>(PH, lds);
        if constexpr (PH + 1 < N_PHASES) xcd_barrier(lds);
        run_from<PH + 1>(lds);
    }
}
__global__ void __launch_bounds__(NWAVES * 64, 2) mk_fwd(Args a) {
    MK_PROLOGUE
    (void)xcd_barrier_post((unsigned*)(a.ws + WS_CTL) + CW_BAR, MISC + 8);
    run_from<0>(lds);
}
#else
template <int KIND>
__global__ void __launch_bounds__(NWAVES * 64, 2) mk_phase(Args a) {
    MK_PROLOGUE
    (void)MISC;
    run_kind<KIND>(a.ph_lo, lds);
}
#endif

#if !MK_ONE_LAUNCH
template <int KIND> static void launch_kind(int grid, hipStream_t stream, const Args& a) {
    static bool attr = false;
    if (!attr) { (void)hipFuncSetAttribute((const void*)mk_phase<KIND>, hipFuncAttributeMaxDynamicSharedMemorySize, LDS_BYTES); attr = true; }
    hipLaunchKernelGGL(mk_phase<KIND>, dim3(grid), dim3(NWAVES * 64), LDS_BYTES, stream, a);
}
#endif
extern "C" void kernel_launch(void* const* d_in, const int* in_sizes, int n_in, void* d_out, int out_size, void* d_ws, size_t ws_size, hipStream_t stream) {
    static int grid = 0;
    if (grid == 0) {
        if (n_in != 26 || out_size != M * DM || ws_size < WS_END) { fprintf(stderr, "kernel_launch: unexpected problem (n_in %d out %d ws %zu need %zu)\n", n_in, out_size, ws_size, (size_t)WS_END); grid = -1; return; }
        int dev = 0, cus = 0;
        if (hipGetDevice(&dev) != hipSuccess || hipDeviceGetAttribute(&cus, hipDeviceAttributeMultiprocessorCount, dev) != hipSuccess) { grid = -1; return; }
#if MK_ONE_LAUNCH
        if (hipFuncSetAttribute((const void*)mk_fwd, hipFuncAttributeMaxDynamicSharedMemorySize, LDS_BYTES) != hipSuccess) { fprintf(stderr, "kernel_launch: hipFuncSetAttribute failed\n"); grid = -1; return; }
#endif
        (void)hipGetLastError();
        grid = cus;
        if (grid != 256) fprintf(stderr, "kernel_launch: %d CUs; the residual GEMM phases need exactly 256 workgroups\n", grid);
    }
    if (grid < 0) return;
    (void)hipMemsetAsync((char*)d_ws + WS_CTL, 0, CTL_ZERO_BYTES, stream);
    Args a{};
    for (int i = 0; i < 26; ++i) a.in[i] = (const float*)d_in[i];
    a.out = (float*)d_out; a.ws = (unsigned char*)d_ws;
#if MK_ONE_LAUNCH
    a.ph_lo = 0; a.ph_hi = N_PHASES;
    hipLaunchKernelGGL(mk_fwd, dim3(grid), dim3(NWAVES * 64), LDS_BYTES, stream, a);
#else
    for (int ph = 0; ph < N_PHASES; ++ph) { a.ph_lo = ph; a.ph_hi = ph + 1;
        switch (phase_kind(ph)) {
            case 0: launch_kind<0>(grid, stream, a); break;  case 1: launch_kind<1>(grid, stream, a); break;  case 2: launch_kind<2>(grid, stream, a); break;
            case 4: launch_kind<4>(grid, stream, a); launch_kind<12>(grid, stream, a); break;
            case 6: launch_kind<6>(grid, stream, a); break;  case 7: launch_kind<7>(grid, stream, a); break;  case 8: launch_kind<8>(grid, stream, a); break;
            case 9: launch_kind<9>(grid, stream, a); break;  case 10: launch_kind<10>(grid, stream, a); break; default: launch_kind<11>(grid, stream, a); break;
        } }
#endif
}
```

```cpp
#include <hip/hip_runtime.h>
#include <cstdio>
#include <cstdint>

#ifndef PROBE_PH
#define PROBE_PH -1
#endif
#ifndef P1_GEMM_WGS
#define P1_GEMM_WGS 232
#endif
#ifndef P5_GEMM_WGS
#define P5_GEMM_WGS 240
#endif
#ifndef MK_ONE_LAUNCH
#define MK_ONE_LAUNCH 1
#endif

#define GAS __attribute__((address_space(1)))
#define LAS __attribute__((address_space(3)))
typedef unsigned short bf16_t;
typedef short bf16x8 __attribute__((ext_vector_type(8)));
typedef float f32x4 __attribute__((ext_vector_type(4)));
typedef float f32x2 __attribute__((ext_vector_type(2)));
typedef unsigned u32x4 __attribute__((ext_vector_type(4)));
typedef unsigned u32x2 __attribute__((ext_vector_type(2)));

constexpr int NB = 2, SEQ = 4096, DM = 2048, M = NB * SEQ, DRNN = 2048, DPOOL = 1024, DIN = 9216, DFF = 5632, DUP = 11264, NADA = 12288, NL = 2;
constexpr float EPS = 1e-6f;
constexpr int NWAVES = 8;
constexpr int LDS_BYTES = 147456;
constexpr int RING_BYTES = 131072;
constexpr int MISC_OFF = RING_BYTES + 320;

constexpr size_t MiB = 1u << 20;
constexpr size_t WS_CTL = 0, CTL_ZERO_BYTES = 4 * MiB;
constexpr size_t WS_MOD = 1 * MiB;
constexpr size_t WS_GM1 = WS_MOD + (size_t)NL * NB * NADA * 4;
constexpr size_t WS_GT1 = WS_GM1 + (size_t)NL * NB * DM * 4;
constexpr size_t WS_GM2 = WS_GT1 + (size_t)NL * NB * DM * 4;
constexpr size_t WS_GT2 = WS_GM2 + (size_t)NL * NB * DM * 4;
constexpr size_t WS_LRUK = WS_GT2 + (size_t)NL * NB * DM * 4;
constexpr size_t WS_BIAS1 = WS_LRUK + (size_t)NL * DRNN * 4;
constexpr size_t WS_BIAS2 = WS_BIAS1 + (size_t)NL * NB * DIN * 4;
constexpr size_t WS_SS = WS_BIAS2 + (size_t)NL * NB * DUP * 4;
static_assert(WS_SS + 8 * (size_t)M * 4 <= 2 * MiB, "small region");
constexpr size_t WS_AGG = 2 * MiB;
constexpr size_t WS_FSS = 3 * MiB;
constexpr size_t WS_W = 4 * MiB;
constexpr size_t W_BT1 = 0, W_BTG = 36 * MiB, W_BTP = 38 * MiB, W_BT3 = 39 * MiB, W_BT4 = 51 * MiB, W_BT5 = 59 * MiB, W_BT6 = 103 * MiB, W_LAYER = 125 * MiB;
static_assert((size_t)DIN * DM * 2 == 36 * MiB && (size_t)DUP * DM * 2 == 44 * MiB && (size_t)DM * DFF * 2 == 22 * MiB, "weight sizes");
constexpr size_t WS_X = WS_W + 2 * W_LAYER;
constexpr size_t WS_PB1 = WS_X;
constexpr size_t WS_PB2 = WS_X + 16 * MiB;
static_assert((size_t)NL * NB * 32 * DIN * 4 <= 16 * MiB && (size_t)NL * NB * 32 * DUP * 4 <= 16 * MiB, "partial bias rows");
constexpr size_t WS_PB3 = WS_X + 32 * MiB;
constexpr size_t WS_XG = WS_X + 64 * MiB;
constexpr size_t WS_XRNN = WS_XG + 32 * MiB;
constexpr size_t WS_GG = WS_XRNN + 32 * MiB;
constexpr size_t WS_XPOOL = WS_GG + 32 * MiB;
constexpr size_t WS_RATIO = WS_XPOOL + 16 * MiB;
constexpr size_t WS_GB = WS_RATIO + 32 * MiB;
constexpr size_t WS_XR = WS_GB + 32 * MiB;
constexpr size_t WS_MERGED = WS_XR;
constexpr size_t WS_PP = WS_XR + 32 * MiB;
constexpr size_t WS_YAB = WS_PP + 16 * MiB;
constexpr size_t WS_AA = WS_YAB + 48 * MiB;
constexpr size_t WS_BB = WS_AA + 64 * MiB;
constexpr size_t WS_ACT = WS_AA;
constexpr size_t WS_UH = WS_ACT + 88 * MiB;
constexpr size_t WS_END = WS_BB + 64 * MiB;
static_assert(WS_UH + (size_t)128 * 4 * DUP * 4 <= WS_END, "ws map");
constexpr int CW_BAR = 4096;
constexpr int CW_CVT = 8192;

__device__ __forceinline__ unsigned cvt_pk_bf16(float lo, float hi) { unsigned r; asm("v_cvt_pk_bf16_f32 %0, %1, %2" : "=v"(r) : "v"(lo), "v"(hi)); return r; }
__device__ __forceinline__ float bf_lo(unsigned w) { return __uint_as_float(w << 16); }
__device__ __forceinline__ float bf_hi(unsigned w) { return __uint_as_float(w & 0xffff0000u); }
__device__ __forceinline__ float bf1(bf16_t h) { return __uint_as_float((unsigned)h << 16); }
__device__ __forceinline__ float fexp2(float x) { return __builtin_amdgcn_exp2f(x); }
__device__ __forceinline__ float frcp(float x) { return __builtin_amdgcn_rcpf(x); }
__device__ __forceinline__ float sigmoid_f(float x) { return frcp(1.f + fexp2(-1.4426950409f * x)); }
__device__ __forceinline__ float gelu_tanh_f(float x) { const float t = x + 0.044715f * x * x * x; return x * frcp(1.f + fexp2(-2.3022082f * t)); }
__device__ __forceinline__ float wave_sum(float v) {
#pragma unroll
    for (int o = 1; o < 64; o <<= 1) v += __shfl_xor(v, o);
    return v;
}
template <int CTRL> __device__ __forceinline__ float dpp0(float x) { return __builtin_bit_cast(float, __builtin_amdgcn_update_dpp(0, __builtin_bit_cast(int, x), CTRL, 0xf, 0xf, true)); }

namespace pg8 {
constexpr int BM = 256, BK = 64, HALF = 128, HTB = HALF * BK * 2, STAGE_BYTES = 8 * HTB, NXCD = 8, WGM = 4;
__host__ __device__ __forceinline__ int lds_byte(int r, int c) { const int st = (r >> 4) * 2 + (c >> 5), rr = r & 15, cc = c & 31, ob = rr * 64 + cc * 2; return st * 1024 + (ob ^ (((ob >> 9) & 1) << 5)); }
__host__ __device__ __forceinline__ void stage_rc(int b, int& R, int& C) { const int st = b / 1024, sb = b % 1024, swz = sb ^ (((sb >> 9) & 1) << 5); R = (st >> 1) * 16 + swz / 64; C = (st & 1) * 32 + (swz % 64) / 2; }
__host__ __device__ __forceinline__ int perm32(int rho) { const int n = rho >> 4, i = rho & 15; return 8 * (i >> 2) + 4 * n + (i & 3); }

struct Unit { int pm, pn; };
struct Gemm { const bf16_t* A; const bf16_t* Bt; int lda, ldb, nt, nM, nN, a_sh, a_mul, a_swz = 0, b_pm = 0; };

struct StaticOrder {
    int nM, nN, nwg, G, c;
    __device__ void init(int nM_, int nN_, int G_, int c_) { nM = nM_; nN = nN_; nwg = nM * nN; G = G_; c = c_; }
    __device__ bool next(int i, Unit& u) const {
        const long L = (long)i * G + c; if (L >= nwg) return false;
        int wgid = (int)L; { const int q = nwg / NXCD, r = nwg % NXCD, xcd = wgid % NXCD, off = wgid / NXCD; wgid = (xcd < r ? xcd * (q + 1) : r * (q + 1) + (xcd - r) * q) + off; }
        const int nig = WGM * nN, gid = wgid / nig, fm = gid * WGM, gsz = (nM - fm) < WGM ? (nM - fm) : WGM;
        u.pm = fm + ((wgid % nig) % gsz); u.pn = (wgid % nig) / gsz; return true;
    }
};

template <class Epi, bool ALIGN_EPI, class Sched = StaticOrder>
__device__ __forceinline__ void gemm_phase(LAS unsigned char* lds, const Gemm g, const Sched& S, const Epi& E) {
    int tid = threadIdx.x; asm volatile("" : "+v"(tid)); tid &= 511;
    const int wid = __builtin_amdgcn_readfirstlane(tid >> 6), lane = tid & 63, wr = wid >> 2, wc = wid & 3, fr = lane & 15, fq = lane >> 4;
    const int nt = g.nt;
    unsigned voffA[2], voffB[2];
#pragma unroll
    for (int i = 0; i < 2; ++i) { int R, C; stage_rc(tid * 16 + i * 8192, R, C); const int Rb = Epi::PERM == 2 ? ((R >> 5) * 64 + perm32(R & 31)) : Epi::PERM == 1 ? ((R & ~31) + perm32(R & 31)) : R;
        const int Ra = g.a_swz ? ((R & ~8) | (((C >> 5) & 1) << 3)) : R, Ca = g.a_swz ? ((C & ~32) | (((R >> 3) & 1) << 5)) : C;
        voffA[i] = (unsigned)(Ra * g.lda + Ca) * 2u; voffB[i] = (unsigned)(Rb * g.ldb + C) * 2u; }
    const size_t kstep = (size_t)(BK * 2);
    const size_t hstepA = (size_t)HALF * g.lda * 2, hstepB = (size_t)(Epi::PERM == 2 ? 32 : HALF) * g.ldb * 2;
    const size_t tstepA = 2 * hstepA, tstepB = (size_t)BM * g.ldb * 2;
    const unsigned ldsw = (unsigned)wid * 1024u;
    const int aoff = lds_byte(wr * 64 + fr, fq * 8), boff = lds_byte(wc * 32 + fr, fq * 8);
#define PG8_SA(b, h) (((b) * 2 + (h)) * HTB)
#define PG8_SB(b, h) ((4 + (b) * 2 + (h)) * HTB)
#define PG8_STAGE(bufoff, gbase, voff) do { _Pragma("unroll") for (int _i = 0; _i < 2; ++_i) \
        __builtin_amdgcn_global_load_lds((const unsigned*)((const char*)(gbase) + (voff)[_i]), (LAS unsigned*)(lds + (bufoff) + ldsw + _i * 8192), 16, 0, 0); } while (0)
#define PG8_LDA(dst, b, h) do { _Pragma("unroll") for (int m = 0; m < 4; ++m) _Pragma("unroll") for (int k = 0; k < 2; ++k) dst[m][k] = *(const LAS bf16x8*)(lds + PG8_SA(b, h) + aoff + m * 2048 + k * 1024); } while (0)
#define PG8_LDB(dst, b, h) do { _Pragma("unroll") for (int n = 0; n < 2; ++n) _Pragma("unroll") for (int k = 0; k < 2; ++k) dst[n][k] = *(const LAS bf16x8*)(lds + PG8_SB(b, h) + boff + n * 2048 + k * 1024); } while (0)
#define PG8_MMA(ai, bj, At, Bt) do { __builtin_amdgcn_s_setprio(1); _Pragma("unroll") for (int m = 0; m < 4; ++m) _Pragma("unroll") for (int n = 0; n < 2; ++n) _Pragma("unroll") for (int k = 0; k < 2; ++k) \
        acc[ai][bj][m][n] = __builtin_amdgcn_mfma_f32_16x16x32_bf16(Bt[n][k], At[m][k], acc[ai][bj][m][n], 0, 0, 0); __builtin_amdgcn_s_setprio(0); } while (0)
#define PG8_WAIT_V(n) asm volatile("s_waitcnt vmcnt(" #n ")" ::: "memory")
#define PG8_WAIT_L(n) asm volatile("s_waitcnt lgkmcnt(" #n ")" ::: "memory")
#define PG8_BAR __builtin_amdgcn_s_barrier()
#define PG8_SCHED __builtin_amdgcn_sched_barrier(0)
#define PG8_ABASE(u) ((const char*)g.A + (size_t)(u).pm * tstepA + (size_t)(((u).pn >> g.a_sh) * g.a_mul) * 2)
#define PG8_BBASE(u) ((const char*)g.Bt + (size_t)(u).pn * tstepB + (size_t)((u).pm * g.b_pm))
    Unit cur, nxt; int ui = 0;
    if (!S.next(0, cur)) return;
    f32x4 acc[2][2][4][2];
#pragma unroll
    for (int a = 0; a < 2; ++a)
#pragma unroll
        for (int b = 0; b < 2; ++b)
#pragma unroll
            for (int m = 0; m < 4; ++m)
#pragma unroll
                for (int n = 0; n < 2; ++n) acc[a][b][m][n] = (f32x4){0.f, 0.f, 0.f, 0.f};
    bf16x8 At[4][2], B0[2][2], B1[2][2];
    const char* cA = PG8_ABASE(cur); const char* cB = PG8_BBASE(cur);
    PG8_STAGE(PG8_SB(0, 0), cB, voffB); PG8_STAGE(PG8_SB(0, 1), cB + hstepB, voffB); PG8_STAGE(PG8_SA(0, 0), cA, voffA); PG8_STAGE(PG8_SA(0, 1), cA + hstepA, voffA);
    if (wr == 1) PG8_BAR;
    PG8_WAIT_V(2); PG8_BAR;
    PG8_STAGE(PG8_SB(1, 0), cB + kstep, voffB); PG8_STAGE(PG8_SA(1, 0), cA + kstep, voffA); PG8_STAGE(PG8_SB(1, 1), cB + hstepB + kstep, voffB);
    PG8_WAIT_V(6); PG8_BAR;
    for (;;) {
        const bool has_next = S.next(ui + 1, nxt);
        const char* nA = has_next ? PG8_ABASE(nxt) : cA; const char* nB = has_next ? PG8_BBASE(nxt) : cB;
#pragma unroll 1
        for (int t = 0; t < nt; t += 2) {
            const bool last = (t == nt - 2);
            if constexpr (Epi::MIDK) { if (t == E.midk_t) E.mid(acc, cur, wr, wc, fr, fq); }
            const char* a1 = cA + (size_t)(t + 1) * kstep;
            const char* a2 = last ? nA : cA + (size_t)(t + 2) * kstep; const char* b2 = last ? nB : cB + (size_t)(t + 2) * kstep;
            const char* a3 = a2 + kstep; const char* b3 = b2 + kstep;
            PG8_LDB(B0, 0, 0); PG8_LDB(B1, 0, 1); PG8_SCHED; PG8_LDA(At, 0, 0); PG8_STAGE(PG8_SA(1, 1), a1 + hstepA, voffA);
            PG8_WAIT_V(8); PG8_WAIT_L(0); PG8_BAR; PG8_MMA(0, 0, At, B0); PG8_MMA(0, 1, At, B1); PG8_BAR; PG8_SCHED;
            PG8_LDA(At, 0, 1); PG8_STAGE(PG8_SB(0, 0), b2, voffB); PG8_STAGE(PG8_SB(0, 1), b2 + hstepB, voffB); PG8_STAGE(PG8_SA(0, 0), a2, voffA);
            PG8_WAIT_V(8); PG8_WAIT_L(0); PG8_BAR; PG8_MMA(1, 0, At, B0); PG8_MMA(1, 1, At, B1); PG8_BAR; PG8_SCHED;
            PG8_LDB(B0, 1, 0); PG8_LDB(B1, 1, 1); PG8_SCHED; PG8_LDA(At, 1, 0); PG8_STAGE(PG8_SA(0, 1), a2 + hstepA, voffA);
            PG8_WAIT_V(8); PG8_WAIT_L(0); PG8_BAR; PG8_MMA(0, 0, At, B0); PG8_MMA(0, 1, At, B1); PG8_BAR; PG8_SCHED;
            PG8_LDA(At, 1, 1); PG8_STAGE(PG8_SB(1, 0), b3, voffB); PG8_STAGE(PG8_SB(1, 1), b3 + hstepB, voffB); PG8_STAGE(PG8_SA(1, 0), a3, voffA);
            PG8_WAIT_V(8); PG8_WAIT_L(0); PG8_BAR; PG8_MMA(1, 0, At, B0); PG8_MMA(1, 1, At, B1); PG8_BAR; PG8_SCHED;
        }
        if constexpr (ALIGN_EPI) { if (wr == 0) PG8_BAR; }
        if constexpr (!Epi::AFTER_DRAIN) { E(acc, cur, ui, wr, wc, fr, fq); }
        if (!has_next) break;
#pragma unroll
        for (int a = 0; a < 2; ++a)
#pragma unroll
            for (int b = 0; b < 2; ++b)
#pragma unroll
                for (int m = 0; m < 4; ++m)
#pragma unroll
                    for (int n = 0; n < 2; ++n) acc[a][b][m][n] = (f32x4){0.f, 0.f, 0.f, 0.f};
        cur = nxt; cA = nA; cB = nB; ++ui;
        if constexpr (ALIGN_EPI) { if (wr == 1) PG8_BAR; }
    }
    PG8_WAIT_V(0);
    if constexpr (!ALIGN_EPI) { if (wr == 0) PG8_BAR; }
    PG8_BAR;
    if constexpr (Epi::AFTER_DRAIN) { E.fused(acc, cur, wr, wc, fr, fq, lds, wid, lane); }
#undef PG8_SA
#undef PG8_SB
#undef PG8_STAGE
#undef PG8_LDA
#undef PG8_LDB
#undef PG8_MMA
#undef PG8_WAIT_V
#undef PG8_WAIT_L
#undef PG8_BAR
#undef PG8_SCHED
#undef PG8_ABASE
#undef PG8_BBASE
}

typedef f32x4 Acc[2][2][4][2];
__device__ __forceinline__ float ror8_1(float x) { float r; asm volatile("s_nop 1\n\tv_mov_b32_dpp %0, %1 row_ror:8 row_mask:0xf bank_mask:0xf" : "=v"(r) : "v"(x)); return r; }
__device__ __forceinline__ f32x4 ror8(const f32x4 v) { f32x4 r; r[0] = ror8_1(v[0]); r[1] = ror8_1(v[1]); r[2] = ror8_1(v[2]); r[3] = ror8_1(v[3]); return r; }
__device__ __forceinline__ f32x4 sel4(bool c, const f32x4 a, const f32x4 b) { f32x4 r;
#pragma unroll
    for (int i = 0; i < 4; ++i) r[i] = c ? a[i] : b[i]; return r; }
__device__ __forceinline__ void ld_lines(const float* p, int ldf, bool lo, int fr7, f32x4& n0, f32x4& n1, int hoff = 16) {
    const float* q = p + (size_t)fr7 * ldf + (lo ? 0 : hoff); const f32x4 A = __builtin_nontemporal_load((const f32x4*)q), B = __builtin_nontemporal_load((const f32x4*)(q + (size_t)8 * ldf));
    n0 = sel4(lo, A, ror8(B)); n1 = sel4(lo, ror8(A), B); }
__device__ __forceinline__ void st_lines(float* p, int ldf, bool lo, int fr7, const f32x4 n0, const f32x4 n1, int hoff = 16) {
    float* q = p + (size_t)fr7 * ldf + (lo ? 0 : hoff); *(f32x4*)q = sel4(lo, n0, ror8(n1)); *(f32x4*)(q + (size_t)8 * ldf) = sel4(lo, ror8(n0), n1); }
__device__ __forceinline__ u32x4 asu(const f32x4 v) { return __builtin_bit_cast(u32x4, v); }
__device__ __forceinline__ f32x4 asf(const u32x4 v) { return __builtin_bit_cast(f32x4, v); }
__device__ __forceinline__ void st_lines16(bf16_t* p, int ld, bool lo, int fr7, const u32x4 h0, const u32x4 h1) {
    bf16_t* q = p + (size_t)fr7 * ld + (lo ? 0 : 32); *(u32x4*)q = asu(sel4(lo, asf(h0), ror8(asf(h1)))); *(u32x4*)(q + (size_t)8 * ld) = asu(sel4(lo, ror8(asf(h0)), asf(h1))); }
__device__ __forceinline__ void ld_lines16_raw(const bf16_t* p, int ld, bool lo, int fr7, f32x4& A, f32x4& B) { const bf16_t* q = p + (size_t)fr7 * ld + (lo ? 0 : 32); A = asf(*(const u32x4*)q); B = asf(*(const u32x4*)(q + (size_t)8 * ld)); }
__device__ __forceinline__ void lines16_fix(bool lo, const f32x4 A, const f32x4 B, u32x4& h0, u32x4& h1) { h0 = asu(sel4(lo, A, ror8(B))); h1 = asu(sel4(lo, ror8(A), B)); }
__device__ __forceinline__ void ld_lines16(const bf16_t* p, int ld, bool lo, int fr7, u32x4& h0, u32x4& h1) {
    const bf16_t* q = p + (size_t)fr7 * ld + (lo ? 0 : 32); const f32x4 A = asf(*(const u32x4*)q), B = asf(*(const u32x4*)(q + (size_t)8 * ld));
    h0 = asu(sel4(lo, A, ror8(B))); h1 = asu(sel4(lo, ror8(A), B)); }

constexpr int TAB_OFF = RING_BYTES + 1024;

__device__ __forceinline__ float row_rstd(const float* ss, int row) {
    float s = 0.f;
#pragma unroll
    for (int j = 0; j < 8; ++j) s += ss[(size_t)j * M + row];
    return __builtin_amdgcn_rsqf(s * (1.0f / DM) + EPS);
}
__device__ __forceinline__ u32x4 pack8(const f32x4 a, const f32x4 b) { u32x4 w; w.x = cvt_pk_bf16(a[0], a[1]); w.y = cvt_pk_bf16(a[2], a[3]); w.z = cvt_pk_bf16(b[0], b[1]); w.w = cvt_pk_bf16(b[2], b[3]); return w; }
__device__ __forceinline__ void unpack8(const u32x4 w, f32x4& a, f32x4& b) { a = (f32x4){bf_lo(w.x), bf_hi(w.x), bf_lo(w.y), bf_hi(w.y)}; b = (f32x4){bf_lo(w.z), bf_hi(w.z), bf_lo(w.w), bf_hi(w.w)}; }

__device__ __forceinline__ void fill_rstd_tab(LAS unsigned char* lds, const StaticOrder& S, const float* ss, int tid) {
    LAS float* tab = (LAS float*)(lds + TAB_OFF); Unit u;
    for (int i = 0; i < 8 && S.next(i, u); ++i) if (tid < 256) tab[i * 256 + tid] = row_rstd(ss, u.pm * BM + tid);
    __syncthreads();
}
constexpr int BTAB_OFF = RING_BYTES + 9216;
__device__ __forceinline__ void fill_tabs(LAS unsigned char* lds, const StaticOrder& S, const float* ss, const float* pb, int ncols, int tid) {
    LAS float* tab = (LAS float*)(lds + TAB_OFF); LAS float* bt = (LAS float*)(lds + BTAB_OFF); LAS float* bh = (LAS float*)lds;
    const int c = tid & 255, h = tid >> 8;
    Unit u0; S.next(0, u0);
    float sb[6], sr[3];
#pragma unroll
    for (int i = 0; i < 6; ++i) { Unit u; if (!S.next(i, u)) u = u0; const float* p = pb + (size_t)((u.pm >> 4) * 32 + 16 * h) * ncols + u.pn * BM + c; float s = 0.f;
#pragma unroll
        for (int kb = 0; kb < 16; ++kb) s += p[(size_t)kb * ncols];
        sb[i] = s; }
#pragma unroll
    for (int j = 0; j < 3; ++j) { Unit u; if (!S.next(2 * j + h, u)) u = u0; sr[j] = row_rstd(ss, u.pm * BM + c); }
#pragma unroll
    for (int j = 0; j < 3; ++j) tab[(2 * j + h) * 256 + c] = sr[j];
    if (h) {
#pragma unroll
        for (int i = 0; i < 6; ++i) bh[i * 256 + c] = sb[i]; }
    __syncthreads();
    if (!h) {
#pragma unroll
        for (int i = 0; i < 6; ++i) bt[i * 256 + c] = sb[i] + bh[i * 256 + c]; }
    __syncthreads();
}
struct EpiZ {
    static constexpr int PERM = 2; static constexpr bool AFTER_DRAIN = false, MIDK = false;
    const LAS float* tab; const LAS float* btab; bf16_t* xrnn; bf16_t* gg; bf16_t* xpool; bf16_t* rg; int midk_t;
    __device__ __forceinline__ void mid(Acc&, const Unit&, int, int, int, int) const {}
    __device__ __forceinline__ void operator()(const Acc& acc, const Unit& u, int ui, int wr, int wc, int fr, int fq) const {
        { int t_ = threadIdx.x; asm volatile("" : "+v"(t_)); fr = t_ & 15; fq = (t_ >> 4) & 3; }
        const int row0 = u.pm * BM + wr * 64, b = u.pm >> 4, lc0 = wc * 64 + 8 * fq; const bool lo = fr < 8; const int fr7 = fr & 7;
        const LAS float* rtab = tab + ui * 256 + wr * 64 + fr;
        const LAS float* bp = btab + ui * 256 + lc0;
        f32x4 bv[2][2];
#pragma unroll
        for (int bj = 0; bj < 2; ++bj)
#pragma unroll
            for (int n = 0; n < 2; ++n) bv[bj][n] = *(const LAS f32x4*)(bp + 32 * bj + 4 * n);
        bf16_t* d0; int ld, mode = 0;
        if (u.pn < 8) { d0 = xrnn + u.pn * BM + lc0; ld = DRNN; }
        else if (u.pn < 16) { d0 = gg + (u.pn - 8) * BM + lc0; ld = DRNN; mode = 1; }
        else if (u.pn < 20) { d0 = xpool + (u.pn - 16) * BM + lc0; ld = DPOOL; }
        else { d0 = rg + (u.pn - 20) * BM + lc0; ld = 2 * DM; mode = 2; }
#pragma unroll
        for (int ai = 0; ai < 2; ++ai)
#pragma unroll
            for (int m = 0; m < 4; ++m) { const int rowg = row0 + ai * HALF + m * 16; const float rs = rtab[ai * HALF + m * 16];
                f32x4 z[2][2];
#pragma unroll
                for (int bj = 0; bj < 2; ++bj)
#pragma unroll
                    for (int n = 0; n < 2; ++n) z[bj][n] = acc[ai][bj][m][n] * rs + bv[bj][n];
                if (mode == 1) {
#pragma unroll
                    for (int bj = 0; bj < 2; ++bj)
#pragma unroll
                        for (int n = 0; n < 2; ++n)
#pragma unroll
                            for (int i = 0; i < 4; ++i) z[bj][n][i] = gelu_tanh_f(z[bj][n][i]);
                } else if (mode == 2) {
#pragma unroll
                    for (int n = 0; n < 2; ++n)
#pragma unroll
                        for (int i = 0; i < 4; ++i) { const float eu = fexp2(-1.4426950409f * z[0][n][i]), ev = fminf(fexp2(-1.4426950409f * z[1][n][i]), 1e30f);
                            z[1][n][i] = frcp(1.f + ev); z[0][n][i] = (1.f + ev) * frcp(1.f + eu); }
                }
                st_lines16(d0 + (size_t)rowg * ld, ld, lo, fr7, pack8(z[0][0], z[0][1]), pack8(z[1][0], z[1][1])); }
    }
};

struct GateOrder {
    int c;
    __device__ bool next(int i, Unit& u) const { if (i >= 2 || c >= 256) return false; const int pmi = c >> 4; u.pn = c & 15; u.pm = ((pmi < 8) ? pmi : pmi + 8) + 8 * i; return true; }
};
constexpr int SCAN_OFF = RING_BYTES + 9216;
template <int CTRL> __device__ __forceinline__ float dpp_old(float oldv, float x) { return __builtin_bit_cast(float, __builtin_amdgcn_update_dpp(__builtin_bit_cast(int, oldv), __builtin_bit_cast(int, x), CTRL, 0xf, 0xf, false)); }
__device__ __forceinline__ float bcast15(float x) { return __builtin_bit_cast(float, __builtin_amdgcn_ds_swizzle(__builtin_bit_cast(int, x), 0x1F0)); }
#define SCAN16_STEP(k) \
    "v_fmac_f32_dpp %4, %4, %0 row_shr:" #k " row_mask:0xf bank_mask:0xf\n\tv_fmac_f32_dpp %5, %5, %1 row_shr:" #k " row_mask:0xf bank_mask:0xf\n\t" \
    "v_fmac_f32_dpp %6, %6, %2 row_shr:" #k " row_mask:0xf bank_mask:0xf\n\tv_fmac_f32_dpp %7, %7, %3 row_shr:" #k " row_mask:0xf bank_mask:0xf\n\t" \
    "v_mul_f32_dpp %0, %0, %0 row_shr:" #k " row_mask:0xf bank_mask:0xf\n\tv_mul_f32_dpp %1, %1, %1 row_shr:" #k " row_mask:0xf bank_mask:0xf\n\t" \
    "v_mul_f32_dpp %2, %2, %2 row_shr:" #k " row_mask:0xf bank_mask:0xf\n\tv_mul_f32_dpp %3, %3, %3 row_shr:" #k " row_mask:0xf bank_mask:0xf\n\t"
__device__ __forceinline__ void scan16(f32x4& P, f32x4& H) {
    float p0 = P[0], p1 = P[1], p2 = P[2], p3 = P[3], h0 = H[0], h1 = H[1], h2 = H[2], h3 = H[3];
    asm("s_nop 1\n\t" SCAN16_STEP(1) SCAN16_STEP(2) SCAN16_STEP(4) SCAN16_STEP(8) "s_nop 0"
        : "+v"(p0), "+v"(p1), "+v"(p2), "+v"(p3), "+v"(h0), "+v"(h1), "+v"(h2), "+v"(h3));
    P = (f32x4){p0, p1, p2, p3}; H = (f32x4){h0, h1, h2, h3};
}
#undef SCAN16_STEP
struct EpiGates {
    static constexpr int PERM = 2; static constexpr bool AFTER_DRAIN = false, MIDK = false;
    const float* ba; const float* bx; const float* lruk; const bf16_t* xr; const bf16_t* gg; bf16_t* yab; unsigned long long* aggu; LAS unsigned char* lds; int midk_t;
    __device__ __forceinline__ void mid(Acc&, const Unit&, int, int, int, int) const {}
    __device__ __forceinline__ void operator()(const Acc& acc, const Unit& u, int ui, int wr, int wc, int fr, int fq) const {
        int tid; { int t_ = threadIdx.x; asm volatile("" : "+v"(t_)); tid = t_ & 511; fr = t_ & 15; fq = (t_ >> 4) & 3; }
        const int b = u.pm >> 4, pmb = u.pm & 15;
        const int row0 = u.pm * BM + wr * 64 + fr, chl0 = wc * 32 + 8 * fq, ch0 = u.pn * HALF + chl0;
        LAS float* CH = (LAS float*)(lds + SCAN_OFF); LAS float* CARRY = CH + 1024;
        f32x4 Pf[2][4][2], Hf[2][4][2];
        f32x4 vba[2], vbx[2], vk[2];
#pragma unroll
        for (int n = 0; n < 2; ++n) { vba[n] = *(const f32x4*)(ba + ch0 + 4 * n); vbx[n] = *(const f32x4*)(bx + ch0 + 4 * n); vk[n] = *(const f32x4*)(lruk + ch0 + 4 * n); }
#pragma unroll
        for (int ai = 0; ai < 2; ++ai) {
            f32x4 Pc[2] = {(f32x4){1.f, 1.f, 1.f, 1.f}, (f32x4){1.f, 1.f, 1.f, 1.f}}, Hc[2] = {(f32x4){0.f, 0.f, 0.f, 0.f}, (f32x4){0.f, 0.f, 0.f, 0.f}};
            const bf16_t* px = xr + (size_t)(row0 + ai * HALF) * DRNN + ch0; asm volatile("" : "+v"(px)); px = (const bf16_t*)(const __attribute__((address_space(1))) bf16_t*)(unsigned long long)px;
            u32x4 xw4[4];
#pragma unroll
            for (int m = 0; m < 4; ++m) { xw4[m] = *(const u32x4*)px; px += 16 * DRNN; }
#pragma unroll
            for (int m = 0; m < 4; ++m) { const u32x4 xw = xw4[m]; f32x4 xv[2]; unpack8(xw, xv[0], xv[1]);
#pragma unroll
                for (int n = 0; n < 2; ++n) { f32x4 Pv, Hv;
#pragma unroll
                    for (int i = 0; i < 4; ++i) { const float r = sigmoid_f(acc[ai][0][m][n][i] + vba[n][i]), g = sigmoid_f(acc[ai][1][m][n][i] + vbx[n][i]);
                        const float P = fexp2(1.4426950409f * vk[n][i] * r); Pv[i] = P; Hv[i] = __builtin_amdgcn_sqrtf(fmaxf(1.f - P * P, 0.f)) * (g * xv[n][i]); }
                    scan16(Pv, Hv);
#pragma unroll
                    for (int i = 0; i < 4; ++i) { const float P = Pv[i], H = Hv[i];
                        const float Pt = bcast15(P), Ht = bcast15(H);
                        Hf[ai][m][n][i] = P * Hc[n][i] + H; Pf[ai][m][n][i] = P * Pc[n][i];
                        Hc[n][i] = Pt * Hc[n][i] + Ht; Pc[n][i] = Pt * Pc[n][i]; }
                    asm volatile("" : "+v"(Hf[ai][m][n]), "+v"(Pf[ai][m][n]), "+v"(Hc[n]), "+v"(Pc[n]) :: "memory"); } }
            if (fr == 0) {
#pragma unroll
                for (int n = 0; n < 2; ++n) { *(LAS f32x4*)(CH + ((2 * ai + wr) * 2 + 0) * 128 + chl0 + 4 * n) = Pc[n]; *(LAS f32x4*)(CH + ((2 * ai + wr) * 2 + 1) * 128 + chl0 + 4 * n) = Hc[n]; } }
        }
        u32x4 gw8[2][4];
#pragma unroll
        for (int ai = 0; ai < 2; ++ai) { const bf16_t* pg = gg + (size_t)(row0 + ai * HALF) * DRNN + ch0; asm volatile("" : "+v"(pg)); pg = (const bf16_t*)(const __attribute__((address_space(1))) bf16_t*)(unsigned long long)pg;
#pragma unroll
            for (int m = 0; m < 4; ++m) { gw8[ai][m] = __builtin_nontemporal_load((const u32x4*)pg); pg += 16 * DRNN; } }
        asm volatile("s_waitcnt lgkmcnt(0)" ::: "memory"); __builtin_amdgcn_s_barrier(); asm volatile("" ::: "memory");
        {
            const int tc = tid & 127, jg = tid >> 7;
            unsigned long long* gbase = aggu + (size_t)(b * 16) * DRNN + u.pn * HALF + tc;
            if (jg == 0) { float P = 1.f, H = 0.f;
#pragma unroll
                for (int c = 0; c < 4; ++c) { const float p = CH[(c * 2 + 0) * 128 + tc], h = CH[(c * 2 + 1) * 128 + tc]; H = p * H + h; P = p * P; }
                __hip_atomic_store(gbase + (size_t)pmb * DRNN, ((unsigned long long)__float_as_uint(H) << 32) | (unsigned long long)__float_as_uint(-P), __ATOMIC_RELAXED, __HIP_MEMORY_SCOPE_AGENT); }
            float Pq = 1.f, Hq = 0.f;
            if (4 * jg < pmb) {
                unsigned long long gq[4]; unsigned spins = 0;
                for (;;) { bool ok = true;
#pragma unroll
                    for (int j = 0; j < 4; ++j) { gq[j] = 0x80000000ull; if (4 * jg + j < pmb) { gq[j] = __hip_atomic_load(gbase + (size_t)(4 * jg + j) * DRNN, __ATOMIC_RELAXED, __HIP_MEMORY_SCOPE_AGENT); ok = ok && ((gq[j] >> 31) & 1ull); } }
                    if (__all(ok) || ++spins > (1u << 20)) break;
                    __builtin_amdgcn_s_sleep(4); }
#pragma unroll
                for (int j = 0; j < 4; ++j) if (4 * jg + j < pmb) { const float p = -__uint_as_float((unsigned)gq[j]), h = __uint_as_float((unsigned)(gq[j] >> 32)); Hq = p * Hq + h; Pq = p * Pq; }
            }
            LAS float* PART = (LAS float*)(lds + TAB_OFF);
            PART[(jg * 2 + 0) * 128 + tc] = Pq; PART[(jg * 2 + 1) * 128 + tc] = Hq;
        }
        asm volatile("s_waitcnt lgkmcnt(0)" ::: "memory"); __builtin_amdgcn_s_barrier(); asm volatile("" ::: "memory");
        if (tid < 128) { const LAS float* PART = (const LAS float*)(lds + TAB_OFF); float hin = 0.f;
#pragma unroll
            for (int jg = 0; jg < 4; ++jg) hin = PART[(jg * 2 + 0) * 128 + tid] * hin + PART[(jg * 2 + 1) * 128 + tid];
            CARRY[tid] = hin; }
        asm volatile("s_waitcnt lgkmcnt(0)" ::: "memory"); __builtin_amdgcn_s_barrier(); asm volatile("" ::: "memory");
#pragma unroll
        for (int ai = 0; ai < 2; ++ai) {
            f32x4 hp[2];
#pragma unroll
            for (int n = 0; n < 2; ++n) { hp[n] = *(const LAS f32x4*)(CARRY + chl0 + 4 * n);
#pragma unroll
                for (int c = 0; c < 3; ++c) if (c < 2 * ai + wr) hp[n] = *(const LAS f32x4*)(CH + (c * 2 + 0) * 128 + chl0 + 4 * n) * hp[n] + *(const LAS f32x4*)(CH + (c * 2 + 1) * 128 + chl0 + 4 * n); }
            bf16_t* py = yab + (size_t)(row0 + ai * HALF) * 3072 + ch0; asm volatile("" : "+v"(py)); py = (bf16_t*)(__attribute__((address_space(1))) bf16_t*)(unsigned long long)py;
#pragma unroll
            for (int m = 0; m < 4; ++m) { const u32x4 gw = gw8[ai][m]; f32x4 g0, g1; unpack8(gw, g0, g1);
                *(u32x4*)py = pack8((Hf[ai][m][0] + Pf[ai][m][0] * hp[0]) * g0, (Hf[ai][m][1] + Pf[ai][m][1] * hp[1]) * g1); py += 16 * 3072; asm volatile("" ::: "memory"); }
        }
    }
};

struct EpiPool {
    static constexpr int PERM = 2; static constexpr bool AFTER_DRAIN = false, MIDK = false;
    const float* pb; const float* ps; bf16_t* yab; int midk_t;
    __device__ __forceinline__ void mid(Acc&, const Unit&, int, int, int, int) const {}
    __device__ __forceinline__ void operator()(const Acc& acc, const Unit& u, int ui, int wr, int wc, int fr, int fq) const {
        { int t_ = threadIdx.x; asm volatile("" : "+v"(t_)); fr = t_ & 15; fq = (t_ >> 4) & 3; }
        const int c0 = u.pn * BM + wc * 64 + 8 * fq; const bool lo = fr < 8; const int fr7 = fr & 7;
        f32x4 bv[2][2], sv[2][2];
#pragma unroll
        for (int bj = 0; bj < 2; ++bj)
#pragma unroll
            for (int n = 0; n < 2; ++n) { bv[bj][n] = *(const f32x4*)(pb + c0 + 32 * bj + 4 * n); sv[bj][n] = *(const f32x4*)(ps + c0 + 32 * bj + 4 * n); }
#pragma unroll
        for (int ai = 0; ai < 2; ++ai)
#pragma unroll
            for (int m = 0; m < 4; ++m) { bf16_t* p = yab + (size_t)(u.pm * BM + ai * HALF + wr * 64 + m * 16) * 3072 + 2048 + c0;
                st_lines16(p, 3072, lo, fr7, pack8((acc[ai][0][m][0] + bv[0][0]) * sv[0][0], (acc[ai][0][m][1] + bv[0][1]) * sv[0][1]), pack8((acc[ai][1][m][0] + bv[1][0]) * sv[1][0], (acc[ai][1][m][1] + bv[1][1]) * sv[1][1]));
                asm volatile("" ::: "memory"); }
    }
};

struct EpiWp {
    static constexpr int PERM = 0; static constexpr bool AFTER_DRAIN = false, MIDK = false;
    bf16_t* dst; int midk_t;
    __device__ __forceinline__ void mid(Acc&, const Unit&, int, int, int, int) const {}
    __device__ __forceinline__ void operator()(const Acc& acc, const Unit& u, int ui, int wr, int wc, int fr, int fq) const {
        { int t_ = threadIdx.x; asm volatile("" : "+v"(t_)); fr = t_ & 15; fq = (t_ >> 4) & 3; }
#pragma unroll
        for (int ai = 0; ai < 2; ++ai)
#pragma unroll
            for (int m = 0; m < 4; ++m) { const int k = ai * HALF + wr * 64 + m * 16 + fr;
#pragma unroll
                for (int bj = 0; bj < 2; ++bj)
#pragma unroll
                    for (int n = 0; n < 2; ++n)
#pragma unroll
                        for (int i = 0; i < 4; ++i) { const int c = 128 * bj + 32 * wc + 16 * n + 4 * fq + i;
                            dst[(size_t)(u.pn * BM + c) * 3072 + 256 * u.pm + k] = (bf16_t)(cvt_pk_bf16(acc[ai][bj][m][n][i], 0.f) & 0xffffu); }
                asm volatile("" ::: "memory"); }
    }
};

struct EpiMerge {
    static constexpr int PERM = 2; static constexpr bool AFTER_DRAIN = false, MIDK = true;
    const bf16_t* rg; bf16_t* merged; const LAS float* btab; int midk_t;
    __device__ __forceinline__ void mid(Acc& acc, const Unit& u, int wr, int wc, int fr, int fq) const {
        { int t_ = threadIdx.x; asm volatile("" : "+v"(t_)); fr = t_ & 15; fq = (t_ >> 4) & 3; }
        const int rc0 = 256 * (2 * u.pn + (wc >> 1)) + 128 * (wc & 1) + 8 * fq;
#pragma unroll
        for (int ai = 0; ai < 2; ++ai) { u32x4 h0[4], h1[4];
#pragma unroll
            for (int m = 0; m < 4; ++m) { const bf16_t* pr = rg + (size_t)(u.pm * BM + ai * HALF + wr * 64 + m * 16 + fr) * (2 * DM) + rc0; h0[m] = __builtin_nontemporal_load((const u32x4*)pr); h1[m] = __builtin_nontemporal_load((const u32x4*)(pr + 64)); }
#pragma unroll
            for (int m = 0; m < 4; ++m) {
                f32x4 a, b; unpack8(h0[m], a, b); acc[ai][0][m][0] *= a; acc[ai][0][m][1] *= b; unpack8(h1[m], a, b); acc[ai][1][m][0] *= a; acc[ai][1][m][1] *= b; }
            asm volatile("" ::: "memory"); }
    }
    __device__ __forceinline__ void operator()(const Acc& acc, const Unit& u, int ui, int wr, int wc, int fr, int fq) const {
        { int t_ = threadIdx.x; asm volatile("" : "+v"(t_)); fr = t_ & 15; fq = (t_ >> 4) & 3; }
        const int c0 = u.pn * BM + wc * 64 + 8 * fq; const bool lo = fr < 8; const int fr7 = fr & 7;
        const int rc0 = 256 * (2 * u.pn + (wc >> 1)) + 128 * (wc & 1) + 8 * fq + 32;
        f32x4 bv[2][2];
#pragma unroll
        for (int bj = 0; bj < 2; ++bj)
#pragma unroll
            for (int n = 0; n < 2; ++n) bv[bj][n] = *(const LAS f32x4*)(btab + wc * 64 + 32 * bj + 8 * fq + 4 * n);
#pragma unroll
        for (int ai = 0; ai < 2; ++ai) { u32x4 g0[4], g1[4];
#pragma unroll
            for (int m = 0; m < 4; ++m) { const bf16_t* pr = rg + (size_t)(u.pm * BM + ai * HALF + wr * 64 + m * 16 + fr) * (2 * DM) + rc0; g0[m] = __builtin_nontemporal_load((const u32x4*)pr); g1[m] = __builtin_nontemporal_load((const u32x4*)(pr + 64)); }
#pragma unroll
            for (int m = 0; m < 4; ++m) { const size_t goff = (size_t)(u.pm * BM + ai * HALF + wr * 64 + m * 16) * DM + c0;
                f32x4 a0, b0, a1, b1; unpack8(g0[m], a0, b0); unpack8(g1[m], a1, b1);
                st_lines16(merged + goff, DM, lo, fr7, pack8((acc[ai][0][m][0] + bv[0][0]) * a0, (acc[ai][0][m][1] + bv[0][1]) * b0), pack8((acc[ai][1][m][0] + bv[1][0]) * a1, (acc[ai][1][m][1] + bv[1][1]) * b1));
                asm volatile("" ::: "memory"); } }
    }
};

template <bool F32SRC>
struct EpiResid {
    static constexpr int PERM = 2; static constexpr bool AFTER_DRAIN = true, MIDK = false;
    const float* xsrc_f;
    const bf16_t* xsrc_b; const float* gsrc;
    bf16_t* xg; const float* gt; const float* gm; float* ss; int midk_t;
    __device__ __forceinline__ void mid(Acc&, const Unit&, int, int, int, int) const {}
    __device__ __forceinline__ void operator()(const Acc&, const Unit&, int, int, int, int, int) const {}
    __device__ __forceinline__ void fused(const Acc& acc, const Unit& u, int wr, int wc, int fr, int fq, LAS unsigned char* lds, int wid, int lane) const {
        { int t_ = threadIdx.x; asm volatile("" : "+v"(t_)); fr = t_ & 15; fq = (t_ >> 4) & 3; }
        const int b = u.pm >> 4, col0 = u.pn * BM + wc * 64 + 8 * fq;
        LAS float* P = (LAS float*)lds;
        const bool lo = fr < 8; const int fr7 = fr & 7;
        f32x4 gv[2][2], gmv[2][2], rgv[2][2];
#pragma unroll
        for (int bj = 0; bj < 2; ++bj)
#pragma unroll
            for (int n = 0; n < 2; ++n) { const size_t ci = (size_t)b * DM + col0 + 32 * bj + 4 * n; gv[bj][n] = *(const f32x4*)(gt + ci); gmv[bj][n] = *(const f32x4*)(gm + ci);
                if constexpr (!F32SRC) { const f32x4 gs = *(const f32x4*)(gsrc + ci); rgv[bj][n] = (f32x4){1.0f / gs[0], 1.0f / gs[1], 1.0f / gs[2], 1.0f / gs[3]}; } else rgv[bj][n] = (f32x4){1.f, 1.f, 1.f, 1.f}; }
#pragma unroll
        for (int ai = 0; ai < 2; ++ai) { f32x4 RA[4], RB[4];
            if constexpr (!F32SRC) {
#pragma unroll
                for (int m = 0; m < 4; ++m) ld_lines16_raw(xsrc_b + (size_t)(u.pm * BM + ai * HALF + wr * 64 + m * 16) * DM + col0, DM, lo, fr7, RA[m], RB[m]); }
#pragma unroll
            for (int m = 0; m < 4; ++m) { const size_t goff = (size_t)(u.pm * BM + ai * HALF + wr * 64 + m * 16) * DM + col0;
                float q = 0.f; u32x4 pk[2]; f32x4 x[2][2];
                if constexpr (F32SRC) {
#pragma unroll
                    for (int bj = 0; bj < 2; ++bj) ld_lines(xsrc_f + goff + 32 * bj, DM, lo, fr7, x[bj][0], x[bj][1], 4);
                } else { u32x4 h0, h1; lines16_fix(lo, RA[m], RB[m], h0, h1); unpack8(h0, x[0][0], x[0][1]); unpack8(h1, x[1][0], x[1][1]);
#pragma unroll
                    for (int bj = 0; bj < 2; ++bj) { x[bj][0] *= rgv[bj][0]; x[bj][1] *= rgv[bj][1]; } }
#pragma unroll
                for (int bj = 0; bj < 2; ++bj) { const f32x4 y0 = x[bj][0] + gv[bj][0] * acc[ai][bj][m][0], y1 = x[bj][1] + gv[bj][1] * acc[ai][bj][m][1];
                    q += ((y0[0] * y0[0] + y0[1] * y0[1]) + (y0[2] * y0[2] + y0[3] * y0[3])) + ((y1[0] * y1[0] + y1[1] * y1[1]) + (y1[2] * y1[2] + y1[3] * y1[3]));
                    pk[bj] = pack8(y0 * gmv[bj][0], y1 * gmv[bj][1]); }
                st_lines16(xg + goff, DM, lo, fr7, pk[0], pk[1]);
                q += __shfl_xor(q, 16); q += __shfl_xor(q, 32); if (fq == 0) P[(ai * HALF + wr * 64 + m * 16 + fr) * 4 + wc] = q;
                asm volatile("" ::: "memory"); } }
        asm volatile("s_waitcnt lgkmcnt(0)" ::: "memory"); __builtin_amdgcn_s_barrier(); asm volatile("" ::: "memory");
        const int t = wid * 64 + lane;
        if (t < 256) { const float s = (P[t * 4 + 0] + P[t * 4 + 1]) + (P[t * 4 + 2] + P[t * 4 + 3]); ss[(size_t)u.pn * M + u.pm * BM + t] = s; }
    }
};

struct EpiFinal {
    static constexpr int PERM = 2; static constexpr bool AFTER_DRAIN = true, MIDK = false;
    const bf16_t* xsrc_b; const float* gsrc; float* out; const float* gt; const float* fg; unsigned* fss; int midk_t;
    __device__ __forceinline__ void mid(Acc&, const Unit&, int, int, int, int) const {}
    __device__ __forceinline__ void operator()(const Acc&, const Unit&, int, int, int, int, int) const {}
    __device__ __forceinline__ void fused(const Acc& acc, const Unit& u, int wr, int wc, int fr, int fq, LAS unsigned char* lds, int wid, int lane) const {
        { int t_ = threadIdx.x; asm volatile("" : "+v"(t_)); fr = t_ & 15; fq = (t_ >> 4) & 3; }
        const int b = u.pm >> 4, col0 = u.pn * BM + wc * 64 + 8 * fq;
        LAS float* P = (LAS float*)lds;
        const bool lo = fr < 8; const int fr7 = fr & 7;
        f32x4 xn[2][2][4][2]; f32x4 gv[2][2], rgv[2][2];
#pragma unroll
        for (int bj = 0; bj < 2; ++bj)
#pragma unroll
            for (int n = 0; n < 2; ++n) { const size_t ci = (size_t)b * DM + col0 + 32 * bj + 4 * n; gv[bj][n] = *(const f32x4*)(gt + ci); const f32x4 gs = *(const f32x4*)(gsrc + ci); rgv[bj][n] = (f32x4){1.0f / gs[0], 1.0f / gs[1], 1.0f / gs[2], 1.0f / gs[3]}; }
#pragma unroll
        for (int ai = 0; ai < 2; ++ai) { f32x4 RA[4], RB[4];
#pragma unroll
            for (int m = 0; m < 4; ++m) ld_lines16_raw(xsrc_b + (size_t)(u.pm * BM + ai * HALF + wr * 64 + m * 16) * DM + col0, DM, lo, fr7, RA[m], RB[m]);
#pragma unroll
            for (int m = 0; m < 4; ++m) { float q = 0.f;
                u32x4 h0, h1; lines16_fix(lo, RA[m], RB[m], h0, h1); f32x4 xs[2][2]; unpack8(h0, xs[0][0], xs[0][1]); unpack8(h1, xs[1][0], xs[1][1]);
#pragma unroll
                for (int bj = 0; bj < 2; ++bj) { const f32x4 x0 = xs[bj][0] * rgv[bj][0], x1 = xs[bj][1] * rgv[bj][1];
                    const f32x4 v0 = x0 + gv[bj][0] * acc[ai][bj][m][0], v1 = x1 + gv[bj][1] * acc[ai][bj][m][1]; xn[ai][bj][m][0] = v0; xn[ai][bj][m][1] = v1;
                    q += ((v0[0] * v0[0] + v0[1] * v0[1]) + (v0[2] * v0[2] + v0[3] * v0[3])) + ((v1[0] * v1[0] + v1[1] * v1[1]) + (v1[2] * v1[2] + v1[3] * v1[3]));
                    asm volatile("" : "+v"(xn[ai][bj][m][0]), "+v"(xn[ai][bj][m][1]), "+v"(q) :: "memory"); }
                q += __shfl_xor(q, 16); q += __shfl_xor(q, 32); if (fq == 0) P[(ai * HALF + wr * 64 + m * 16 + fr) * 4 + wc] = q; } }
        asm volatile("s_waitcnt lgkmcnt(0)" ::: "memory"); __builtin_amdgcn_s_barrier(); asm volatile("" ::: "memory");
        const int t = wid * 64 + lane;
        if (t < 256) {
            const float s = (P[t * 4 + 0] + P[t * 4 + 1]) + (P[t * 4 + 2] + P[t * 4 + 3]);
            unsigned* w0 = fss + (size_t)u.pm * BM + t;
            __hip_atomic_store(w0 + (size_t)u.pn * M, __float_as_uint(-s), __ATOMIC_RELAXED, __HIP_MEMORY_SCOPE_AGENT);
            unsigned wv[8]; unsigned spins = 0;
            for (;;) { bool ok = true;
#pragma unroll
                for (int j = 0; j < 8; ++j) { wv[j] = __hip_atomic_load(w0 + (size_t)j * M, __ATOMIC_RELAXED, __HIP_MEMORY_SCOPE_AGENT); ok = ok && (wv[j] >> 31); }
                if (__all(ok) || ++spins > (1u << 20)) break;
                __builtin_amdgcn_s_sleep(4); }
            float tot = 0.f;
#pragma unroll
            for (int j = 0; j < 8; ++j) tot += -__uint_as_float(wv[j]);
            P[1024 + t] = __builtin_amdgcn_rsqf(tot * (1.0f / DM) + EPS);
        }
        asm volatile("s_waitcnt lgkmcnt(0)" ::: "memory"); __builtin_amdgcn_s_barrier(); asm volatile("" ::: "memory");
        f32x4 fv[2][2];
#pragma unroll
        for (int bj = 0; bj < 2; ++bj)
#pragma unroll
            for (int n = 0; n < 2; ++n) fv[bj][n] = *(const f32x4*)(fg + col0 + 32 * bj + 4 * n);
#pragma unroll
        for (int ai = 0; ai < 2; ++ai)
#pragma unroll
            for (int m = 0; m < 4; ++m) { const size_t goff = (size_t)(u.pm * BM + ai * HALF + wr * 64 + m * 16) * DM + col0; const float rs = P[1024 + ai * HALF + wr * 64 + m * 16 + fr];
#pragma unroll
                for (int bj = 0; bj < 2; ++bj) st_lines(out + goff + 32 * bj, DM, lo, fr7, xn[ai][bj][m][0] * rs * fv[bj][0], xn[ai][bj][m][1] * rs * fv[bj][1], 4);
                asm volatile("" ::: "memory"); }
    }
};

template <bool PREV> __device__ __forceinline__ f32x4 conv_taps(const f32x4 c, const f32x4 uu, const f32x4 pu, const f32x4 w1, const f32x4 w0) {
    float c0 = c[0], c1 = c[1], c2 = c[2], c3 = c[3];
    asm("s_nop 1\n\t"
        "v_fmac_f32_dpp %0, %4, %8 row_shr:1 row_mask:0xf bank_mask:0xf\n\t"
        "v_fmac_f32_dpp %1, %5, %9 row_shr:1 row_mask:0xf bank_mask:0xf\n\t"
        "v_fmac_f32_dpp %2, %6, %10 row_shr:1 row_mask:0xf bank_mask:0xf\n\t"
        "v_fmac_f32_dpp %3, %7, %11 row_shr:1 row_mask:0xf bank_mask:0xf\n\t"
        "v_fmac_f32_dpp %0, %4, %12 row_shr:2 row_mask:0xf bank_mask:0xf\n\t"
        "v_fmac_f32_dpp %1, %5, %13 row_shr:2 row_mask:0xf bank_mask:0xf\n\t"
        "v_fmac_f32_dpp %2, %6, %14 row_shr:2 row_mask:0xf bank_mask:0xf\n\t"
        "v_fmac_f32_dpp %3, %7, %15 row_shr:2 row_mask:0xf bank_mask:0xf"
        : "+v"(c0), "+v"(c1), "+v"(c2), "+v"(c3)
        : "v"(uu[0]), "v"(uu[1]), "v"(uu[2]), "v"(uu[3]), "v"(w1[0]), "v"(w1[1]), "v"(w1[2]), "v"(w1[3]), "v"(w0[0]), "v"(w0[1]), "v"(w0[2]), "v"(w0[3]));
    if constexpr (PREV) {
        asm("s_nop 1\n\t"
            "v_fmac_f32_dpp %0, %4, %8 row_shl:15 row_mask:0xf bank_mask:0xf\n\t"
            "v_fmac_f32_dpp %1, %5, %9 row_shl:15 row_mask:0xf bank_mask:0xf\n\t"
            "v_fmac_f32_dpp %2, %6, %10 row_shl:15 row_mask:0xf bank_mask:0xf\n\t"
            "v_fmac_f32_dpp %3, %7, %11 row_shl:15 row_mask:0xf bank_mask:0xf\n\t"
            "v_fmac_f32_dpp %0, %4, %12 row_shl:14 row_mask:0xf bank_mask:0xf\n\t"
            "v_fmac_f32_dpp %1, %5, %13 row_shl:14 row_mask:0xf bank_mask:0xf\n\t"
            "v_fmac_f32_dpp %2, %6, %14 row_shl:14 row_mask:0xf bank_mask:0xf\n\t"
            "v_fmac_f32_dpp %3, %7, %15 row_shl:14 row_mask:0xf bank_mask:0xf"
            : "+v"(c0), "+v"(c1), "+v"(c2), "+v"(c3)
            : "v"(pu[0]), "v"(pu[1]), "v"(pu[2]), "v"(pu[3]), "v"(w1[0]), "v"(w1[1]), "v"(w1[2]), "v"(w1[3]), "v"(w0[0]), "v"(w0[1]), "v"(w0[2]), "v"(w0[3]));
    }
    return (f32x4){c0, c1, c2, c3};
}
struct EpiUp {
    static constexpr int PERM = 1; static constexpr bool AFTER_DRAIN = false, MIDK = false;
    const LAS float* tab; const LAS float* btab; const float* cw; const float* cbias; bf16_t* act; float* uh; int midk_t;
    __device__ __forceinline__ void mid(Acc&, const Unit&, int, int, int, int) const {}
    __device__ __forceinline__ void operator()(const Acc& acc, const Unit& u, int ui, int wr, int wc, int fr, int fq) const {
        { int t_ = threadIdx.x; asm volatile("" : "+v"(t_)); fr = t_ & 15; fq = (t_ >> 4) & 3; }
        const int b = u.pm >> 4, lc0 = wc * 32 + 8 * fq;
        const LAS float* rtab = tab + ui * 256 + wr * 64 + fr;
        u32x2 keep[2][4];
#pragma unroll
        for (int n = 0; n < 2; ++n) {
            const int lc = lc0 + 4 * n, ca = u.pn * HALF + lc;
            f32x4 w0[2], w1[2], w2[2], cb[2], bv[2];
#pragma unroll
            for (int bj = 0; bj < 2; ++bj) { const int nc = bj * DFF + ca;
                w0[bj] = *(const f32x4*)(cw + nc); w1[bj] = *(const f32x4*)(cw + DUP + nc); w2[bj] = *(const f32x4*)(cw + 2 * DUP + nc); cb[bj] = *(const f32x4*)(cbias + nc);
                bv[bj] = *(const LAS f32x4*)(btab + ui * 256 + bj * HALF + lc); }
#pragma unroll
            for (int ai = 0; ai < 2; ++ai) {
                const int rbase = u.pm * BM + ai * HALF + wr * 64, sb = rbase >> 6;
                f32x4 pu[2] = {(f32x4){0.f, 0.f, 0.f, 0.f}, (f32x4){0.f, 0.f, 0.f, 0.f}};
#pragma unroll
                for (int m = 0; m < 4; ++m) { const int row = rbase + m * 16 + fr; const float rs = rtab[ai * HALF + m * 16];
                    f32x4 cv[2];
#pragma unroll
                    for (int bj = 0; bj < 2; ++bj) { const f32x4 uu = acc[ai][bj][m][n] * rs + bv[bj];
                        if (m == 0 && fr < 2) *(f32x4*)(uh + ((size_t)sb * 4 + fr) * DUP + u.pn * BM + bj * HALF + lc) = uu;
                        if (m == 3 && fr >= 14) *(f32x4*)(uh + ((size_t)sb * 4 + 2 + (fr - 14)) * DUP + u.pn * BM + bj * HALF + lc) = uu;
                        const f32x4 c = cb[bj] + w2[bj] * uu;
                        cv[bj] = m == 0 ? conv_taps<false>(c, uu, uu, w1[bj], w0[bj]) : conv_taps<true>(c, uu, pu[bj], w1[bj], w0[bj]); pu[bj] = uu; }
                    f32x4 o;
#pragma unroll
                    for (int i = 0; i < 4; ++i) o[i] = cv[0][i] * sigmoid_f(cv[0][i]) * cv[1][i];
                    { u32x2 w; w.x = cvt_pk_bf16(o[0], o[1]); w.y = cvt_pk_bf16(o[2], o[3]);
                      if (n == 0) keep[ai][m] = w; else if (!(m == 0 && fr < 2)) { u32x4 w4; w4.x = keep[ai][m].x; w4.y = keep[ai][m].y; w4.z = w.x; w4.w = w.y; *(u32x4*)(act + (size_t)(rbase + m * 16 + (fr & 7) + 8 * (wc & 1)) * DFF + u.pn * HALF + 64 * (wc >> 1) + 32 * (fr >> 3) + 8 * fq) = w4; } }
                    asm volatile("" ::: "memory"); }
            }
        }
    }
};
}

constexpr int PTR_OFF = RING_BYTES + 512;
__device__ __forceinline__ unsigned long long lds_ptr(LAS unsigned char* lds, int i) {
    const volatile LAS unsigned* p = (const volatile LAS unsigned*)(lds + PTR_OFF) + 2 * i;
    const unsigned lo = __builtin_amdgcn_readfirstlane(p[0]), hi = __builtin_amdgcn_readfirstlane(p[1]);
    return ((unsigned long long)hi << 32) | lo;
}

#define XB_TMO      128
#define XB_XCNT(j)  (256  + 64 * (j))
#define XB_XSUB(j)  (1280 + 64 * (j))
#define XB_XGEN(j)  (2304 + 64 * (j))
#define XB_TOP      3328
#define XB_TOPGEN   3392
#define XCD_BAR_WORDS 3456
#define XB_SPIN_CAP (1u << 18)
__device__ __forceinline__ unsigned xb_ld(unsigned* p)              { return __hip_atomic_load(p, __ATOMIC_RELAXED, __HIP_MEMORY_SCOPE_AGENT); }
__device__ __forceinline__ unsigned xb_add(unsigned* p, unsigned v) { return __hip_atomic_fetch_add(p, v, __ATOMIC_RELAXED, __HIP_MEMORY_SCOPE_AGENT); }
__device__ __forceinline__ unsigned xb_xcc_id() { return (unsigned)__builtin_amdgcn_s_getreg((3 << 11) | 20) & 0xFu; }
#define XB_SPIN(cond, bar) do { unsigned _sp = 0; while (cond) { __builtin_amdgcn_s_sleep(1); \
    if ((++_sp & 255u) == 0u) { if (xb_ld(&(bar)[XB_TMO])) break; if (_sp > XB_SPIN_CAP) { atomicAdd(&(bar)[XB_TMO], 1u); break; } } } } while (0)
struct XcdBarrier { unsigned* bar; unsigned x; volatile LAS unsigned* st; };
__device__ __forceinline__ XcdBarrier xcd_barrier_post(unsigned* bar, volatile LAS unsigned* st) {
    XcdBarrier b; b.bar = bar; b.x = xb_xcc_id(); b.st = st;
    if (threadIdx.x == 0) (void)xb_add(&bar[XB_XCNT(b.x)], 1u);
    return b;
}
__device__ __forceinline__ void xcd_barrier_complete(unsigned* bar, unsigned x, unsigned& nloc, unsigned& nx) {
    const unsigned G = gridDim.x * gridDim.y * gridDim.z;
    unsigned sum, cnt, mine, sp = 0u;
    for (;;) {
        sum = 0u; cnt = 0u; mine = 0u;
#pragma unroll
        for (unsigned j = 0; j < 16; ++j) { const unsigned c = xb_ld(&bar[XB_XCNT(j)]); sum += c; cnt += (c > 0u) ? 1u : 0u; mine = (j == x) ? c : mine; }
        if (sum == G) break;
        __builtin_amdgcn_s_sleep(1);
        if ((++sp & 255u) == 0u) { if (xb_ld(&bar[XB_TMO])) break; if (sp > XB_SPIN_CAP) { atomicAdd(&bar[XB_TMO], 1u); break; } }
    }
    nloc = mine > 0u ? mine : 1u; nx = cnt > 0u ? cnt : 1u;
}
__device__ __forceinline__ void xcd_barrier(LAS unsigned char* lds) {
    asm volatile("s_waitcnt vmcnt(0)" ::: "memory");
    __syncthreads();
    if (threadIdx.x == 0) {
        XcdBarrier b; b.bar = (unsigned*)(lds_ptr(lds, 27) + WS_CTL) + CW_BAR; b.x = xb_xcc_id(); b.st = (volatile LAS unsigned*)(lds + MISC_OFF) + 8;
        unsigned* bar = b.bar; unsigned bx_ = b.x;
        asm volatile("" : "+v"(bar), "+s"(bx_));
        __builtin_amdgcn_s_waitcnt(0);
        unsigned nloc = b.st[0], nx = b.st[1];
        if (nloc == 0u) { xcd_barrier_complete(bar, bx_, nloc, nx); b.st[0] = nloc; b.st[1] = nx; }
        const unsigned old = xb_add(&bar[XB_XSUB(bx_)], 1u);
        const unsigned gen = old / nloc;
        if (old + 1u == (gen + 1u) * nloc) {
            __builtin_amdgcn_fence(__ATOMIC_RELEASE, "agent");
            asm volatile("s_waitcnt vmcnt(0)" ::: "memory");
            const unsigned og = xb_add(&bar[XB_TOP], 1u);
            const unsigned tg = og / nx;
            if (og + 1u == (tg + 1u) * nx) xb_add(&bar[XB_TOPGEN], 1u);
            else XB_SPIN(xb_ld(&bar[XB_TOPGEN]) == tg, bar);
            __builtin_amdgcn_fence(__ATOMIC_ACQUIRE, "agent");
            xb_add(&bar[XB_XGEN(bx_)], 1u);
            asm volatile("s_waitcnt vmcnt(0)" ::: "memory");
        } else {
            XB_SPIN(xb_ld(&bar[XB_XGEN(bx_)]) == gen, bar);
            __builtin_amdgcn_fence(__ATOMIC_ACQUIRE, "agent");
            asm volatile("s_waitcnt vmcnt(0)" ::: "memory");
        }
    }
    __syncthreads();
}

struct Args { const float* in[26]; float* out; unsigned char* ws; int ph_lo, ph_hi; };
enum { I_X = 0, I_C, I_ADAW, I_ADAB, I_NMG, I_WIN, I_BIN, I_CONVW, I_CONVB, I_WA, I_BA, I_WX, I_BX, I_LAM, I_POOLW, I_POOLB, I_POOLS, I_PROJA, I_PROJB, I_WOUT, I_NFG, I_WUP, I_FCW, I_FCB, I_WDOWN, I_FING };

template <bool BIAS>
__device__ __forceinline__ void cvt_item(const float* src, int N, bf16_t* dst, int dpitch, int k0, int n0, int drow0, int dcol, int lane,
                                         const float* sh0 = nullptr, const float* sh1 = nullptr, float* bias0 = nullptr, float* bias1 = nullptr, const float* binit = nullptr, int dstep = 32, const float* shm = nullptr) {
    const int r = lane >> 3, q = lane & 7;
    f32x4 s0 = (f32x4){0.f, 0.f, 0.f, 0.f}, s1 = s0, t0 = s0, t1 = s0;
    f32x4 vv[2][8];
#pragma unroll
    for (int c = 0; c < 2; ++c)
#pragma unroll
        for (int j = 0; j < 8; ++j) vv[c][j] = __builtin_nontemporal_load((const f32x4*)(src + (size_t)(k0 + 8 * r + j) * N + n0 + 32 * c + 4 * q));
    if constexpr (BIAS) {
        const int kk = k0 + 8 * r; f32x4 a0 = *(const f32x4*)(sh0 + kk), a1 = *(const f32x4*)(sh0 + kk + 4), b0 = *(const f32x4*)(sh1 + kk), b1 = *(const f32x4*)(sh1 + kk + 4);
        if (shm) { const f32x4 m0 = *(const f32x4*)(shm + kk), m1 = *(const f32x4*)(shm + kk + 4); a0 *= m0; a1 *= m1; b0 *= m0; b1 *= m1; }
#pragma unroll
        for (int j = 0; j < 4; ++j) { s0 += a0[j] * vv[0][j] + a1[j] * vv[0][4 + j]; s1 += b0[j] * vv[0][j] + b1[j] * vv[0][4 + j]; t0 += a0[j] * vv[1][j] + a1[j] * vv[1][4 + j]; t1 += b0[j] * vv[1][j] + b1[j] * vv[1][4 + j]; }
    }
#pragma unroll
    for (int c = 0; c < 2; ++c) {
        const f32x4 (&v)[8] = vv[c];
#pragma unroll
        for (int i = 0; i < 4; ++i) { u32x4 w; w.x = cvt_pk_bf16(v[0][i], v[1][i]); w.y = cvt_pk_bf16(v[2][i], v[3][i]); w.z = cvt_pk_bf16(v[4][i], v[5][i]); w.w = cvt_pk_bf16(v[6][i], v[7][i]);
            *(u32x4*)(dst + (size_t)(drow0 + dstep * c + 4 * q + i) * dpitch + dcol + k0 + 8 * r) = w; }
    }
    if constexpr (BIAS) {
        const int ii = r & 3, cc = r >> 2, col = 32 * cc + 4 * q + ii;
        f32x4 k0 = cc ? t0 : s0, x0 = cc ? s0 : t0, k1 = cc ? t1 : s1, x1 = cc ? s1 : t1;
#pragma unroll
        for (int i = 0; i < 4; ++i) { k0[i] += __shfl_xor(x0[i], 32); k1[i] += __shfl_xor(x1[i], 32); }
        const bool h1 = (r & 2) != 0, h0 = (r & 1) != 0;
        float a0 = h1 ? k0[2] : k0[0], a1 = h1 ? k0[3] : k0[1], b0 = h1 ? k1[2] : k1[0], b1 = h1 ? k1[3] : k1[1];
        const float xa0 = h1 ? k0[0] : k0[2], xa1 = h1 ? k0[1] : k0[3], xb0 = h1 ? k1[0] : k1[2], xb1 = h1 ? k1[1] : k1[3];
        a0 += __shfl_xor(xa0, 16); a1 += __shfl_xor(xa1, 16); b0 += __shfl_xor(xb0, 16); b1 += __shfl_xor(xb1, 16);
        float v0 = h0 ? a1 : a0, v1 = h0 ? b1 : b0;
        v0 += __shfl_xor(h0 ? a0 : a1, 8); v1 += __shfl_xor(h0 ? b0 : b1, 8);
        if (binit) { const float bi = binit[n0 + col]; v0 += bi; v1 += bi; }
        const int brow = drow0 + dstep * cc + 4 * q + ii;
        bias0[brow] = v0; bias1[brow] = v1;
    }
}
constexpr int IT_WIN = (DM / 64) * (DIN / 64), IT_LRU = 16 * 16, IT_POOL = 4 * 16, IT_PA = 32 * 32, IT_PB = 16 * 32, IT_WO = 32 * 32, IT_WUP = 32 * (DUP / 64), IT_WD = (DFF / 64) * 32;
constexpr int IT_LAYER = IT_WIN + IT_PB + IT_LRU + IT_PA + IT_WO + IT_WUP + IT_WD;
__device__ __forceinline__ void cvt_one(const Args& a, int it, int lane) {
    const float* mod = (const float*)(a.ws + WS_MOD);
    {
        const int l = it / IT_LAYER; int r = it % IT_LAYER;
        bf16_t* wl = (bf16_t*)(a.ws + WS_W + (size_t)l * W_LAYER);
        const float* sh = mod + (size_t)l * NB * NADA;
        if (r < IT_WIN) { const int kb = r / (DIN / 64), nb = r % (DIN / 64), n0 = 64 * nb; int drow = n0;
            int dstep = 32;
            if (n0 >= 5120) { const int gsel = n0 - 5120, isb = gsel / 2048, ch = gsel % 2048; drow = 5120 + 256 * (ch / 128) + 64 * ((ch % 128) / 32) + 32 * isb; dstep = 64; }
            float* bo = (float*)(a.ws + WS_PB1) + ((size_t)(l * NB) * 32 + kb) * DIN;
            cvt_item<true>(a.in[I_WIN] + (size_t)l * DM * DIN, DIN, wl + W_BT1 / 2, DM, 64 * kb, n0, drow, 0, lane, sh, sh + NADA, bo, bo + (size_t)32 * DIN, kb == 0 ? a.in[I_BIN] + (size_t)l * DIN : nullptr, dstep); return; } r -= IT_WIN;
        if (r < IT_PB) { const int kb = r / 32, nb = r % 32;
            float* bo = (float*)(a.ws + WS_PB3) + ((size_t)(l * 2) * 16 + kb) * DM;
            cvt_item<true>(a.in[I_PROJB] + (size_t)l * DPOOL * DM, DM, wl + W_BT3 / 2, 3072, 64 * kb, 64 * nb, 64 * nb, 2048, lane, a.in[I_POOLB] + (size_t)l * DPOOL, a.in[I_POOLB] + (size_t)l * DPOOL, bo, bo + (size_t)16 * DM, nullptr, 32, a.in[I_POOLS] + (size_t)l * DPOOL); return; } r -= IT_PB;
        if (r < IT_LRU) { const int mat = r / 16, idx = r % 16, isx = mat / 8, h = mat % 8, kb = idx / 4, nb = idx % 4, n0 = 64 * nb;
            const float* src = a.in[isx ? I_WX : I_WA] + ((size_t)l * 8 + h) * 256 * 256;
            cvt_item<false>(src, 256, wl + W_BTG / 2, 256, 64 * kb, n0, 512 * h + 256 * (n0 / 128) + 64 * ((n0 % 128) / 32) + 32 * isx, 0, lane, nullptr, nullptr, nullptr, nullptr, nullptr, 64); return; } r -= IT_LRU;
        if (r < IT_PA) { const int kb = r / 32, nb = r % 32; cvt_item<false>(a.in[I_PROJA] + (size_t)l * DRNN * DM, DM, wl + W_BT3 / 2, 3072, 64 * kb, 64 * nb, 64 * nb, 0, lane); return; } r -= IT_PA;
        if (r < IT_WO) { const int kb = r / 32, nb = r % 32; cvt_item<false>(a.in[I_WOUT] + (size_t)l * DM * DM, DM, wl + W_BT4 / 2, DM, 64 * kb, 64 * nb, 64 * nb, 0, lane); return; } r -= IT_WO;
        if (r < IT_WUP) { const int kb = r / (DUP / 64), nb = r % (DUP / 64), n0 = 64 * nb, isl = n0 / DFF, ch = n0 % DFF;
            float* bo = (float*)(a.ws + WS_PB2) + ((size_t)(l * NB) * 32 + kb) * DUP;
            cvt_item<true>(a.in[I_WUP] + (size_t)l * DM * DUP, DUP, wl + W_BT5 / 2, DM, 64 * kb, n0, 256 * (ch / 128) + 128 * isl + (ch % 128), 0, lane, sh + 3 * DM, sh + NADA + 3 * DM, bo, bo + (size_t)32 * DUP, nullptr); return; } r -= IT_WUP;
        { const int kb = r / 32, nb = r % 32; cvt_item<false>(a.in[I_WDOWN] + (size_t)l * DFF * DM, DM, wl + W_BT6 / 2, DFF, 64 * kb, 64 * nb, 64 * nb, 0, lane); }
    }
}
__device__ __forceinline__ void p0_convert(const Args& a, int lo, int hi, int widx, int nw, int lane, unsigned* cnt = nullptr, int shard = 0) {
    if (cnt == nullptr) { for (int it = lo + widx; it < hi; it += nw) cvt_one(a, it, lane); return; }
    const int per = (hi - lo + 7) / 8, slo = lo + shard * per, shi = (slo + per < hi) ? slo + per : hi;
    unsigned base = 0; if (lane == 0) base = atomicAdd(cnt + 64 * shard, 2u);
    for (;;) {
        const int it0 = slo + (int)__builtin_amdgcn_readfirstlane(base);
        if (it0 >= shi) break;
        unsigned nbase = 0; if (lane == 0) nbase = atomicAdd(cnt + 64 * shard, 2u);
        cvt_one(a, it0, lane); if (it0 + 1 < shi) cvt_one(a, it0 + 1, lane);
        base = nbase;
    }
}
constexpr int CVT_A_LO = 0, CVT_A_HI = IT_WIN + IT_PB;
__host__ __device__ constexpr int cvt_b_lo(int l) { return l * IT_LAYER + IT_WIN + IT_PB; }
__host__ __device__ constexpr int cvt_b_hi(int l) { return (l + 1) * IT_LAYER - IT_WD; }
__host__ __device__ constexpr int cvt_c_lo(int l) { return (l + 1) * IT_LAYER - IT_WD; }
__host__ __device__ constexpr int cvt_c_hi(int l) { return l + 1 < NL ? (l + 1) * IT_LAYER + IT_WIN : (l + 1) * IT_LAYER; }
__device__ __forceinline__ void p0_ada(const Args& a, LAS unsigned char* lds, int G, int tid, int bx) {
    const int wave = tid >> 6, lane = tid & 63;
    LAS float* cact = (LAS float*)lds;
    LAS float* red = (LAS float*)(lds + 16384);
    for (int i = tid; i < NB * DM; i += 512) { const float v = a.in[I_C][i]; cact[i] = v * sigmoid_f(v); }
    __syncthreads();
    float* mod = (float*)(a.ws + WS_MOD);
    for (int un = bx; un < NL * (NADA / 32); un += G) {
        const int l = un / (NADA / 32), nb = un % (NADA / 32);
        const float* wsrc = a.in[I_ADAW] + (size_t)l * DM * NADA + nb * 32 + 4 * (lane & 7);
        f32x4 s0 = (f32x4){0.f, 0.f, 0.f, 0.f}, s1 = s0;
#pragma unroll 16
        for (int rg = wave; rg < 256; rg += 8) { const int k = rg * 8 + (lane >> 3); const f32x4 wv = __builtin_nontemporal_load((const f32x4*)(wsrc + (size_t)k * NADA)); s0 += cact[k] * wv; s1 += cact[DM + k] * wv; }
#pragma unroll
        for (int i = 0; i < 4; ++i) {
#pragma unroll
            for (int o = 8; o < 64; o <<= 1) { s0[i] += __shfl_xor(s0[i], o); s1[i] += __shfl_xor(s1[i], o); } }
        if (lane < 8) {
#pragma unroll
            for (int i = 0; i < 4; ++i) { red[(wave * 2 + 0) * 32 + 4 * lane + i] = s0[i]; red[(wave * 2 + 1) * 32 + 4 * lane + i] = s1[i]; } }
        __syncthreads();
        if (tid < 64) { const int b = tid >> 5, c = tid & 31; float s = 0.f;
#pragma unroll
            for (int w = 0; w < 8; ++w) s += red[(w * 2 + b) * 32 + c];
            mod[((size_t)l * NB + b) * NADA + nb * 32 + c] = s + a.in[I_ADAB][(size_t)l * NADA + nb * 32 + c]; }
        __syncthreads();
    }
}

__device__ __forceinline__ void p0b(const Args& a, int gw, int ngw, int lane, int gtid, int ngt) {
    const float* mod = (const float*)(a.ws + WS_MOD);
    for (int i = gtid; i < NL * NB * DM; i += ngt) { const int l = i / (NB * DM), b = (i / DM) % NB, c = i % DM; const float* mm = mod + ((size_t)l * NB + b) * NADA;
        ((float*)(a.ws + WS_GM1))[i] = a.in[I_NMG][l * DM + c] * (1.f + mm[DM + c]);
        ((float*)(a.ws + WS_GT1))[i] = mm[2 * DM + c];
        ((float*)(a.ws + WS_GM2))[i] = a.in[I_NFG][l * DM + c] * (1.f + mm[4 * DM + c]);
        ((float*)(a.ws + WS_GT2))[i] = mm[5 * DM + c]; }
    for (int i = gtid; i < NL * DRNN; i += ngt) { const float lam = a.in[I_LAM][i]; ((float*)(a.ws + WS_LRUK))[i] = -8.0f * log1pf(expf(-lam)); }
    p0_convert(a, CVT_A_LO, CVT_A_HI, gw, ngw, lane);
    for (int l = 1; l < NL; ++l) p0_convert(a, l * IT_LAYER + IT_WIN, l * IT_LAYER + IT_WIN + IT_PB, gw, ngw, lane);
    for (int i = gtid; i < NL * 4 * 256 * 256 / 4; i += ngt) { const int e = 4 * i, l = e / (4 * 65536), g = (e >> 16) & 3, j = e & 255;
        const f32x4 w = *(const f32x4*)(a.in[I_POOLW] + e) * *(const f32x4*)(a.in[I_POOLS] + (size_t)l * DPOOL + g * 256 + j);
        u32x2 pk; pk.x = cvt_pk_bf16(w[0], w[1]); pk.y = cvt_pk_bf16(w[2], w[3]);
        *(u32x2*)((bf16_t*)(a.ws + WS_W + (size_t)l * W_LAYER + W_BTP) + (e & (4 * 65536 - 1))) = pk; }
    float* ss = (float*)(a.ws + WS_SS); bf16_t* xg = (bf16_t*)(a.ws + WS_XG);
    for (int row = gw; row < M; row += ngw) { const int b = row / SEQ; const float* xr = a.in[I_X] + (size_t)row * DM; const float* mm = mod + (size_t)b * NADA + DM; float s = 0.f;
#pragma unroll
        for (int j = 0; j < 8; ++j) { const int c = (j * 64 + lane) * 4; const f32x4 xv = __builtin_nontemporal_load((const f32x4*)(xr + c)), gv = *(const f32x4*)(a.in[I_NMG] + c), sc = *(const f32x4*)(mm + c);
            s += (xv[0] * xv[0] + xv[1] * xv[1]) + (xv[2] * xv[2] + xv[3] * xv[3]); const f32x4 y = xv * (gv * (1.f + sc));
            u32x2 w; w.x = cvt_pk_bf16(y[0], y[1]); w.y = cvt_pk_bf16(y[2], y[3]); *(u32x2*)(xg + (size_t)row * DM + c) = w; }
        s = wave_sum(s);
        if (lane < 8) ss[(size_t)lane * M + row] = lane == 0 ? s : 0.f; }
}

__device__ __forceinline__ void build_xr_tile(const Args& a, int l, int pm, int head, int tid) {
    const int strip = tid >> 5, c = head * 256 + (tid & 31) * 8, row0 = pm * 256 + strip * 16, t0 = row0 % SEQ;
    const float* cw = a.in[I_CONVW] + (size_t)l * 4 * DRNN + c; const float* cb = a.in[I_CONVB] + (size_t)l * DRNN + c;
    f32x4 w0[4], w1[4];
#pragma unroll
    for (int k = 0; k < 4; ++k) { w0[k] = *(const f32x4*)(cw + (size_t)k * DRNN); w1[k] = *(const f32x4*)(cw + (size_t)k * DRNN + 4); }
    const f32x4 b0 = *(const f32x4*)cb, b1 = *(const f32x4*)(cb + 4);
    const bf16_t* src = (const bf16_t*)(a.ws + WS_XRNN) + (size_t)row0 * DRNN + c; bf16_t* dst = (bf16_t*)(a.ws + WS_XR) + (size_t)row0 * DRNN + c;
    u32x4 wr_[19];
#pragma unroll
    for (int d = 0; d < 3; ++d) { wr_[d] = (u32x4){0u, 0u, 0u, 0u}; if (t0 >= 3 - d) wr_[d] = *(const u32x4*)(src - (size_t)(3 - d) * DRNN); }
#pragma unroll
    for (int j = 0; j < 16; ++j) wr_[3 + j] = *(const u32x4*)(src + (size_t)j * DRNN);
    f32x4 h0[3], h1[3];
#pragma unroll
    for (int d = 0; d < 3; ++d) pg8::unpack8(wr_[d], h0[d], h1[d]);
#pragma unroll
    for (int j = 0; j < 16; ++j) { const u32x4 w = wr_[3 + j]; f32x4 x0, x1; pg8::unpack8(w, x0, x1);
        const f32x4 o0 = b0 + w0[0] * h0[0] + w0[1] * h0[1] + w0[2] * h0[2] + w0[3] * x0, o1 = b1 + w1[0] * h1[0] + w1[1] * h1[1] + w1[2] * h1[2] + w1[3] * x1;
        *(u32x4*)(dst + (size_t)j * DRNN) = pg8::pack8(o0, o1);
        h0[0] = h0[1]; h0[1] = h0[2]; h0[2] = x0; h1[0] = h1[1]; h1[1] = h1[2]; h1[2] = x1; }
}
template <int WIN>
__device__ __forceinline__ void build_pp_rows(const bf16_t* src, bf16_t* dst, int t0) {
    u32x4 w[15 + WIN];
#pragma unroll
    for (int d = 0; d < WIN - 1; ++d) { w[d] = (u32x4){0u, 0u, 0u, 0u}; if (t0 >= WIN - 1 - d) w[d] = *(const u32x4*)(src - (size_t)(WIN - 1 - d) * DPOOL); }
#pragma unroll
    for (int j = 0; j < 16; ++j) w[WIN - 1 + j] = *(const u32x4*)(src + (size_t)j * DPOOL);
    f32x4 s0 = (f32x4){0.f, 0.f, 0.f, 0.f}, s1 = s0;
#pragma unroll
    for (int d = WIN - 2; d >= 0; --d) { f32x4 y0, y1; pg8::unpack8(w[d], y0, y1); s0 += y0; s1 += y1; }
#pragma unroll
    for (int j = 0; j < 16; ++j) { const int t = t0 + j; f32x4 x0, x1; pg8::unpack8(w[WIN - 1 + j], x0, x1); s0 += x0; s1 += x1;
        const float inv = 1.0f / (float)((t + 1 < WIN) ? t + 1 : WIN);
        *(u32x4*)(dst + (size_t)j * 3072) = pg8::pack8(s0 * inv - x0, s1 * inv - x1);
        { f32x4 y0, y1; pg8::unpack8(w[j], y0, y1); s0 -= y0; s1 -= y1; } }
}
__device__ __forceinline__ void build_pp_tile(const Args& a, int pm, int g, int tid) {
    const int strip = tid >> 5, c = g * 256 + (tid & 31) * 8, row0 = pm * 256 + strip * 16, t0 = row0 % SEQ;
    const bf16_t* src = (const bf16_t*)(a.ws + WS_XPOOL) + (size_t)row0 * DPOOL + c; bf16_t* dst = (bf16_t*)(a.ws + WS_YAB) + (size_t)row0 * 3072 + 2048 + c;
    if (g == 0) build_pp_rows<2>(src, dst, t0); else if (g == 1) build_pp_rows<4>(src, dst, t0); else if (g == 2) build_pp_rows<8>(src, dst, t0); else build_pp_rows<16>(src, dst, t0);
}

__device__ __forceinline__ void p5_fixup(const Args& a, int l, int gtid, int ngt) {
    const float* uh = (const float*)(a.ws + WS_UH); bf16_t* act = (bf16_t*)(a.ws + WS_ACT);
    const float* cw = a.in[I_FCW] + (size_t)l * 3 * DUP; const float* cb = a.in[I_FCB] + (size_t)l * DUP;
    constexpr int NQ = DFF / 4;
    for (int it = gtid; it < 128 * 2 * NQ; it += ngt) { const int ch = 4 * (it % NQ), r = (it / NQ) & 1, sb = it / (2 * NQ), row = 64 * sb + r;
        const int j = ch / 128, w = ch % 128; const bool edge = (sb % 64) == 0; f32x4 cv[2]; const f32x4 z4 = (f32x4){0.f, 0.f, 0.f, 0.f};
#pragma unroll
        for (int bj = 0; bj < 2; ++bj) { const int tc = 256 * j + 128 * bj + w, nc = bj * DFF + ch;
            const f32x4 u0 = *(const f32x4*)(uh + ((size_t)sb * 4 + r) * DUP + tc);
            f32x4 u1 = z4, u2 = z4;
            if (r == 1) { u1 = *(const f32x4*)(uh + ((size_t)sb * 4 + 0) * DUP + tc); if (!edge) u2 = *(const f32x4*)(uh + ((size_t)(sb - 1) * 4 + 3) * DUP + tc); }
            else if (!edge) { u1 = *(const f32x4*)(uh + ((size_t)(sb - 1) * 4 + 3) * DUP + tc); u2 = *(const f32x4*)(uh + ((size_t)(sb - 1) * 4 + 2) * DUP + tc); }
            cv[bj] = *(const f32x4*)(cb + nc) + *(const f32x4*)(cw + 2 * DUP + nc) * u0 + *(const f32x4*)(cw + DUP + nc) * u1 + *(const f32x4*)(cw + nc) * u2; }
        f32x4 o;
#pragma unroll
        for (int i = 0; i < 4; ++i) o[i] = cv[0][i] * sigmoid_f(cv[0][i]) * cv[1][i];
        u32x2 pk; pk.x = cvt_pk_bf16(o[0], o[1]); pk.y = cvt_pk_bf16(o[2], o[3]);
        *(u32x2*)(act + (size_t)(row + 8 * ((ch >> 5) & 1)) * DFF + (ch & ~32)) = pk; }
}

__device__ __forceinline__ void p_final(const Args& a, int gw, int ngw, int lane) {
    const float* X = (const float*)(a.ws + WS_X); const float* ss = (const float*)(a.ws + WS_SS);
    for (int row = gw; row < M; row += ngw) { const float rs = pg8::row_rstd(ss, row);
#pragma unroll
        for (int j = 0; j < 8; ++j) { const int c = (j * 64 + lane) * 4; *(f32x4*)(a.out + (size_t)row * DM + c) = *(const f32x4*)(X + (size_t)row * DM + c) * rs * *(const f32x4*)(a.in[I_FING] + c); } }
}

constexpr int PH_P0A = 0, PH_P0B = 1, PH_LAYER0 = 2, PH_PER_LAYER = 7, PH_FINAL = -1000, N_PHASES = PH_LAYER0 + NL * PH_PER_LAYER;
__host__ __device__ constexpr int phase_kind(int ph) {
    if (ph == PH_P0A) return 0; if (ph == PH_P0B) return 1; if (ph == PH_FINAL) return 11;
    const int sub = (ph - PH_LAYER0) % PH_PER_LAYER;
    return sub == 0 ? 2 : sub == 1 ? 4 : 4 + sub;
}
template <int KIND, bool DUMMY = false>
__device__ __forceinline__ void run_kind(int ph, LAS unsigned char* lds) {
    int tid = threadIdx.x, bx = blockIdx.x, G = gridDim.x; asm volatile("" : "+v"(tid), "+s"(bx), "+s"(G));
    const int lane = tid & 63, wave = __builtin_amdgcn_readfirstlane(tid >> 6);
    const int vcu = (G % 8 == 0) ? (bx % 8) * (G / 8) + bx / 8 : bx;
    const int gw = vcu * NWAVES + wave, ngw = G * NWAVES, gtid = bx * 512 + tid, ngt = G * 512;
    Args a;
#pragma unroll
    for (int i = 0; i < 26; ++i) a.in[i] = (const float*)(const __attribute__((address_space(1))) float*)lds_ptr(lds, i);
    a.out = (float*)(__attribute__((address_space(1))) float*)lds_ptr(lds, 26); a.ws = (unsigned char*)(__attribute__((address_space(1))) unsigned char*)lds_ptr(lds, 27);
    asm volatile("" : "+s"(ph));
    const int l = (ph - PH_LAYER0) / PH_PER_LAYER;
    const bf16_t* wl = (const bf16_t*)(a.ws + WS_W + (size_t)l * W_LAYER);
    const float* ss = (const float*)(a.ws + WS_SS);
    pg8::StaticOrder S;
    if constexpr (KIND == 0) { p0_ada(a, lds, G, tid, bx); }
    else if constexpr (KIND == 1) { p0b(a, gw, ngw, lane, gtid, ngt); }
    else if constexpr (KIND == 11) { p_final(a, gw, ngw, lane); }
    else if constexpr (KIND == 2) {
        const int GGm = (G == 256 && !DUMMY) ? P1_GEMM_WGS : G;
        pg8::Gemm g{(const bf16_t*)(a.ws + WS_XG), wl + W_BT1 / 2, DM, DM, DM / 64, M / 256, DIN / 256, 31, 0}; S.init(g.nM, g.nN, GGm, bx);
        if (bx < GGm) {
        pg8::fill_tabs(lds, S, ss, (const float*)(a.ws + WS_PB1) + (size_t)(l * NB) * 32 * DIN, DIN, tid);
        pg8::EpiZ E{(const LAS float*)(lds + pg8::TAB_OFF), (const LAS float*)(lds + pg8::BTAB_OFF), (bf16_t*)(a.ws + WS_XRNN), (bf16_t*)(a.ws + WS_GG), (bf16_t*)(a.ws + WS_XPOOL), (bf16_t*)(a.ws + WS_RATIO), -1};
        pg8::gemm_phase<pg8::EpiZ, true>(lds, g, S, E);
        }
        if (!DUMMY && l == 0 && bx >= GGm) {
            for (int ll = 0; ll < NL; ++ll) { const bf16_t* wll = (const bf16_t*)(a.ws + WS_W + (size_t)ll * W_LAYER);
                pg8::Gemm gw_{wll + W_BTP / 2, wll + W_BT3 / 2 + 2048, 256, 3072, 4, 4, 8, 31, 0}; gw_.b_pm = 512;
                pg8::StaticOrder Sw; Sw.init(gw_.nM, gw_.nN, G - GGm, bx - GGm);
                pg8::EpiWp Ew{(bf16_t*)(a.ws + WS_W + (size_t)ll * W_LAYER + W_BT3) + 2048, -1};
                pg8::gemm_phase<pg8::EpiWp, true>(lds, gw_, Sw, Ew); } }
        if (!DUMMY) p0_convert(a, cvt_b_lo(l), cvt_b_hi(l), gw, ngw, lane, (unsigned*)(a.ws + WS_CTL) + CW_CVT + 512 * (2 * l), bx & 7);
    } else if constexpr (KIND == 4) {
        { pg8::Gemm g{(const bf16_t*)(a.ws + WS_XR), wl + W_BTG / 2, DRNN, 256, 4, M / 256, 16, 1, 256}; pg8::GateOrder GO{bx};
          { pg8::Unit u; for (int i = 0; i < 2 && GO.next(i, u); ++i) build_xr_tile(a, l, u.pm, u.pn >> 1, tid); }
          asm volatile("s_waitcnt vmcnt(0)" ::: "memory"); __syncthreads();
          pg8::EpiGates E{a.in[I_BA] + (size_t)l * DRNN, a.in[I_BX] + (size_t)l * DRNN, (const float*)(a.ws + WS_LRUK) + (size_t)l * DRNN, (const bf16_t*)(a.ws + WS_XR), (const bf16_t*)(a.ws + WS_GG), (bf16_t*)(a.ws + WS_YAB),
                          (unsigned long long*)(a.ws + WS_AGG) + (size_t)l * NB * 16 * DRNN, lds, -1};
          pg8::gemm_phase<pg8::EpiGates, true, pg8::GateOrder>(lds, g, GO, E); }
    } else if constexpr (KIND == 12) {
        { S.init(M / 256, 4, G, bx); pg8::Unit u; for (int i = 0; i < 8 && S.next(i, u); ++i) build_pp_tile(a, u.pm, u.pn, tid); }
    } else if constexpr (KIND == 6) {
        pg8::Gemm g{(const bf16_t*)(a.ws + WS_YAB), wl + W_BT3 / 2, 3072, 3072, 48, M / 256, DM / 256, 31, 0}; S.init(g.nM, g.nN, G, bx);
        { pg8::Unit u0;
          if (S.next(0, u0) && tid < 256) { const float* p = (const float*)(a.ws + WS_PB3) + (size_t)(l * 2) * 16 * DM + u0.pn * 256 + tid; float s = 0.f;
#pragma unroll
              for (int kb = 0; kb < 16; ++kb) s += p[(size_t)kb * DM];
              ((LAS float*)(lds + pg8::TAB_OFF))[tid] = s; }
          __syncthreads(); }
        pg8::EpiMerge E{(const bf16_t*)(a.ws + WS_RATIO), (bf16_t*)(a.ws + WS_MERGED), (const LAS float*)(lds + pg8::TAB_OFF), 32};
        pg8::gemm_phase<pg8::EpiMerge, false>(lds, g, S, E);
    } else if constexpr (KIND == 7) {
        pg8::Gemm g{(const bf16_t*)(a.ws + WS_MERGED), wl + W_BT4 / 2, DM, DM, DM / 64, M / 256, DM / 256, 31, 0}; S.init(g.nM, g.nN, G, bx);
        const float* gt1 = (const float*)(a.ws + WS_GT1) + (size_t)l * NB * DM; const float* gm2 = (const float*)(a.ws + WS_GM2) + (size_t)l * NB * DM;
        if (l == 0) { pg8::EpiResid<true> E{a.in[I_X], nullptr, nullptr, (bf16_t*)(a.ws + WS_XG), gt1, gm2, (float*)(a.ws + WS_SS), -1}; pg8::gemm_phase<pg8::EpiResid<true>, false>(lds, g, S, E); }
        else { pg8::EpiResid<false> E{nullptr, (const bf16_t*)(a.ws + WS_XG), (const float*)(a.ws + WS_GM1) + (size_t)l * NB * DM, (bf16_t*)(a.ws + WS_XG), gt1, gm2, (float*)(a.ws + WS_SS), -1}; pg8::gemm_phase<pg8::EpiResid<false>, false>(lds, g, S, E); }
    } else if constexpr (KIND == 8) {
        const int GGm = (G == 256 && !DUMMY) ? P5_GEMM_WGS : G;
        pg8::Gemm g{(const bf16_t*)(a.ws + WS_XG), wl + W_BT5 / 2, DM, DM, DM / 64, M / 256, DUP / 256, 31, 0}; S.init(g.nM, g.nN, GGm, bx);
        if (bx < GGm) {
        pg8::fill_tabs(lds, S, ss, (const float*)(a.ws + WS_PB2) + (size_t)(l * NB) * 32 * DUP, DUP, tid);
        pg8::EpiUp E{(const LAS float*)(lds + pg8::TAB_OFF), (const LAS float*)(lds + pg8::BTAB_OFF), a.in[I_FCW] + (size_t)l * 3 * DUP, a.in[I_FCB] + (size_t)l * DUP, (bf16_t*)(a.ws + WS_ACT), (float*)(a.ws + WS_UH), -1};
        pg8::gemm_phase<pg8::EpiUp, true>(lds, g, S, E);
        }
        if (!DUMMY) p0_convert(a, cvt_c_lo(l), cvt_c_hi(l), gw, ngw, lane, (unsigned*)(a.ws + WS_CTL) + CW_CVT + 512 * (2 * l + 1), bx & 7);
    } else if constexpr (KIND == 9) { p5_fixup(a, l, gtid, ngt);
    } else {
        pg8::Gemm g{(const bf16_t*)(a.ws + WS_ACT), wl + W_BT6 / 2, DFF, DFF, DFF / 64, M / 256, DM / 256, 31, 0, 1}; S.init(g.nM, g.nN, G, bx);
        if (l == NL - 1 && !DUMMY) {
            pg8::EpiFinal E{(const bf16_t*)(a.ws + WS_XG), (const float*)(a.ws + WS_GM2) + (size_t)l * NB * DM, a.out, (const float*)(a.ws + WS_GT2) + (size_t)l * NB * DM, a.in[I_FING], (unsigned*)(a.ws + WS_FSS), -1};
            pg8::gemm_phase<pg8::EpiFinal, false>(lds, g, S, E);
        } else {
        pg8::EpiResid<false> E{nullptr, (const bf16_t*)(a.ws + WS_XG), (const float*)(a.ws + WS_GM2) + (size_t)l * NB * DM, (bf16_t*)(a.ws + (DUMMY ? WS_RATIO : WS_XG)), (const float*)(a.ws + WS_GT2) + (size_t)l * NB * DM,
                        (const float*)(a.ws + WS_GM1) + (size_t)(l + 1 < NL ? l + 1 : l) * NB * DM, (float*)(a.ws + (DUMMY ? WS_AGG : WS_SS)), -1};
        pg8::gemm_phase<pg8::EpiResid<false>, false>(lds, g, S, E);
        }
    }
}
#define MK_PROLOGUE \
    extern __shared__ __attribute__((aligned(16))) unsigned char lds_raw[]; \
    LAS unsigned char* lds = (LAS unsigned char*)lds_raw; \
    const int tid = threadIdx.x; \
    volatile LAS unsigned* MISC = (volatile LAS unsigned*)(lds + MISC_OFF); \
    for (int u = tid; u < (LDS_BYTES - RING_BYTES) / 4; u += 512) ((LAS unsigned*)(lds + RING_BYTES))[u] = 0u; \
    __syncthreads(); \
    if (tid == 0) { LAS unsigned long long* pt = (LAS unsigned long long*)(lds + PTR_OFF); \
        _Pragma("unroll") for (int i = 0; i < 26; ++i) pt[i] = (unsigned long long)a.in[i]; \
        pt[26] = (unsigned long long)a.out; pt[27] = (unsigned long long)a.ws; } \
    __syncthreads();

#if MK_ONE_LAUNCH
template <int PH> __device__ __forceinline__ void run_from(LAS unsigned char* lds) {
    if constexpr (PH < N_PHASES) {
        if constexpr (PH == PROBE_PH) { run_kind<phase_kind(PH), true>(PH, lds); if constexpr (phase_kind(PH) == 4) run_kind<12, true>(PH, lds); xcd_barrier(lds); }
        run_kind<phase_kind(PH)>(PH, lds);
        if constexpr (phase_kind(PH) == 4) run_kind<12>(PH, lds);
        if constexpr (PH + 1 < N_PHASES) xcd_barrier(lds);
        run_from<PH + 1>(lds);
    }
}
__global__ void __launch_bounds__(NWAVES * 64, 2) mk_fwd(Args a) {
    MK_PROLOGUE
    (void)xcd_barrier_post((unsigned*)(a.ws + WS_CTL) + CW_BAR, MISC + 8);
    run_from<0>(lds);
}
#else
template <int KIND>
__global__ void __launch_bounds__(NWAVES * 64, 2) mk_phase(Args a) {
    MK_PROLOGUE
    (void)MISC;
    run_kind<KIND>(a.ph_lo, lds);
}
#endif

#if !MK_ONE_LAUNCH
template <int KIND> static void launch_kind(int grid, hipStream_t stream, const Args& a) {
    static bool attr = false;
    if (!attr) { (void)hipFuncSetAttribute((const void*)mk_phase<KIND>, hipFuncAttributeMaxDynamicSharedMemorySize, LDS_BYTES); attr = true; }
    hipLaunchKernelGGL(mk_phase<KIND>, dim3(grid), dim3(NWAVES * 64), LDS_BYTES, stream, a);
}
#endif
extern "C" void kernel_launch(void* const* d_in, const int* in_sizes, int n_in, void* d_out, int out_size, void* d_ws, size_t ws_size, hipStream_t stream) {
    static int grid = 0;
    if (grid == 0) {
        if (n_in != 26 || out_size != M * DM || ws_size < WS_END) { fprintf(stderr, "kernel_launch: unexpected problem (n_in %d out %d ws %zu need %zu)\n", n_in, out_size, ws_size, (size_t)WS_END); grid = -1; return; }
        int dev = 0, cus = 0;
        if (hipGetDevice(&dev) != hipSuccess || hipDeviceGetAttribute(&cus, hipDeviceAttributeMultiprocessorCount, dev) != hipSuccess) { grid = -1; return; }
#if MK_ONE_LAUNCH
        if (hipFuncSetAttribute((const void*)mk_fwd, hipFuncAttributeMaxDynamicSharedMemorySize, LDS_BYTES) != hipSuccess) { fprintf(stderr, "kernel_launch: hipFuncSetAttribute failed\n"); grid = -1; return; }
#endif
        (void)hipGetLastError();
        grid = cus;
        if (grid != 256) fprintf(stderr, "kernel_launch: %d CUs; the residual GEMM phases need exactly 256 workgroups\n", grid);
    }
    if (grid < 0) return;
    (void)hipMemsetAsync((char*)d_ws + WS_CTL, 0, CTL_ZERO_BYTES, stream);
    Args a{};
    for (int i = 0; i < 26; ++i) a.in[i] = (const float*)d_in[i];
    a.out = (float*)d_out; a.ws = (unsigned char*)d_ws;
#if MK_ONE_LAUNCH
    a.ph_lo = 0; a.ph_hi = N_PHASES;
    hipLaunchKernelGGL(mk_fwd, dim3(grid), dim3(NWAVES * 64), LDS_BYTES, stream, a);
#else
    for (int ph = 0; ph < N_PHASES; ++ph) { a.ph_lo = ph; a.ph_hi = ph + 1;
        switch (phase_kind(ph)) {
            case 0: launch_kind<0>(grid, stream, a); break;  case 1: launch_kind<1>(grid, stream, a); break;  case 2: launch_kind<2>(grid, stream, a); break;
            case 4: launch_kind<4>(grid, stream, a); launch_kind<12>(grid, stream, a); break;
            case 6: launch_kind<6>(grid, stream, a); break;  case 7: launch_kind<7>(grid, stream, a); break;  case 8: launch_kind<8>(grid, stream, a); break;
            case 9: launch_kind<9>(grid, stream, a); break;  case 10: launch_kind<10>(grid, stream, a); break; default: launch_kind<11>(grid, stream, a); break;
        } }
#endif
}
```

```cpp
#include <hip/hip_runtime.h>
#include <cstdio>
#include <cstdint>

#ifndef PROBE_PH
#define PROBE_PH -1
#endif
#ifndef P1_GEMM_WGS
#define P1_GEMM_WGS 232
#endif
#ifndef P5_GEMM_WGS
#define P5_GEMM_WGS 240
#endif
#ifndef MK_ONE_LAUNCH
#define MK_ONE_LAUNCH 1
#endif

#define GAS __attribute__((address_space(1)))
#define LAS __attribute__((address_space(3)))
typedef unsigned short bf16_t;
typedef short bf16x8 __attribute__((ext_vector_type(8)));
typedef float f32x4 __attribute__((ext_vector_type(4)));
typedef float f32x2 __attribute__((ext_vector_type(2)));
typedef unsigned u32x4 __attribute__((ext_vector_type(4)));
typedef unsigned u32x2 __attribute__((ext_vector_type(2)));

constexpr int NB = 2, SEQ = 4096, DM = 2048, M = NB * SEQ, DRNN = 2048, DPOOL = 1024, DIN = 9216, DFF = 5632, DUP = 11264, NADA = 12288, NL = 2;
constexpr float EPS = 1e-6f;
constexpr int NWAVES = 8;
constexpr int LDS_BYTES = 147456;
constexpr int RING_BYTES = 131072;
constexpr int MISC_OFF = RING_BYTES + 320;

constexpr size_t MiB = 1u << 20;
constexpr size_t WS_CTL = 0, CTL_ZERO_BYTES = 4 * MiB;
constexpr size_t WS_MOD = 1 * MiB;
constexpr size_t WS_GM1 = WS_MOD + (size_t)NL * NB * NADA * 4;
constexpr size_t WS_GT1 = WS_GM1 + (size_t)NL * NB * DM * 4;
constexpr size_t WS_GM2 = WS_GT1 + (size_t)NL * NB * DM * 4;
constexpr size_t WS_GT2 = WS_GM2 + (size_t)NL * NB * DM * 4;
constexpr size_t WS_LRUK = WS_GT2 + (size_t)NL * NB * DM * 4;
constexpr size_t WS_BIAS1 = WS_LRUK + (size_t)NL * DRNN * 4;
constexpr size_t WS_BIAS2 = WS_BIAS1 + (size_t)NL * NB * DIN * 4;
constexpr size_t WS_SS = WS_BIAS2 + (size_t)NL * NB * DUP * 4;
static_assert(WS_SS + 8 * (size_t)M * 4 <= 2 * MiB, "small region");
constexpr size_t WS_AGG = 2 * MiB;
constexpr size_t WS_FSS = 3 * MiB;
constexpr size_t WS_W = 4 * MiB;
constexpr size_t W_BT1 = 0, W_BTG = 36 * MiB, W_BTP = 38 * MiB, W_BT3 = 39 * MiB, W_BT4 = 51 * MiB, W_BT5 = 59 * MiB, W_BT6 = 103 * MiB, W_LAYER = 125 * MiB;
static_assert((size_t)DIN * DM * 2 == 36 * MiB && (size_t)DUP * DM * 2 == 44 * MiB && (size_t)DM * DFF * 2 == 22 * MiB, "weight sizes");
constexpr size_t WS_X = WS_W + 2 * W_LAYER;
constexpr size_t WS_PB1 = WS_X;
constexpr size_t WS_PB2 = WS_X + 16 * MiB;
static_assert((size_t)NL * NB * 32 * DIN * 4 <= 16 * MiB && (size_t)NL * NB * 32 * DUP * 4 <= 16 * MiB, "partial bias rows");
constexpr size_t WS_PB3 = WS_X + 32 * MiB;
constexpr size_t WS_XG = WS_X + 64 * MiB;
constexpr size_t WS_XRNN = WS_XG + 32 * MiB;
constexpr size_t WS_GG = WS_XRNN + 32 * MiB;
constexpr size_t WS_XPOOL = WS_GG + 32 * MiB;
constexpr size_t WS_RATIO = WS_XPOOL + 16 * MiB;
constexpr size_t WS_GB = WS_RATIO + 32 * MiB;
constexpr size_t WS_XR = WS_GB + 32 * MiB;
constexpr size_t WS_MERGED = WS_XR;
constexpr size_t WS_PP = WS_XR + 32 * MiB;
constexpr size_t WS_YAB = WS_PP + 16 * MiB;
constexpr size_t WS_AA = WS_YAB + 48 * MiB;
constexpr size_t WS_BB = WS_AA + 64 * MiB;
constexpr size_t WS_ACT = WS_AA;
constexpr size_t WS_UH = WS_ACT + 88 * MiB;
constexpr size_t WS_END = WS_BB + 64 * MiB;
static_assert(WS_UH + (size_t)128 * 4 * DUP * 4 <= WS_END, "ws map");
constexpr int CW_BAR = 4096;
constexpr int CW_CVT = 8192;

__device__ __forceinline__ unsigned cvt_pk_bf16(float lo, float hi) { unsigned r; asm("v_cvt_pk_bf16_f32 %0, %1, %2" : "=v"(r) : "v"(lo), "v"(hi)); return r; }
__device__ __forceinline__ float bf_lo(unsigned w) { return __uint_as_float(w << 16); }
__device__ __forceinline__ float bf_hi(unsigned w) { return __uint_as_float(w & 0xffff0000u); }
__device__ __forceinline__ float bf1(bf16_t h) { return __uint_as_float((unsigned)h << 16); }
__device__ __forceinline__ float fexp2(float x) { return __builtin_amdgcn_exp2f(x); }
__device__ __forceinline__ float frcp(float x) { return __builtin_amdgcn_rcpf(x); }
__device__ __forceinline__ float sigmoid_f(float x) { return frcp(1.f + fexp2(-1.4426950409f * x)); }
__device__ __forceinline__ float gelu_tanh_f(float x) { const float t = x + 0.044715f * x * x * x; return x * frcp(1.f + fexp2(-2.3022082f * t)); }
__device__ __forceinline__ float wave_sum(float v) {
#pragma unroll
    for (int o = 1; o < 64; o <<= 1) v += __shfl_xor(v, o);
    return v;
}
template <int CTRL> __device__ __forceinline__ float dpp0(float x) { return __builtin_bit_cast(float, __builtin_amdgcn_update_dpp(0, __builtin_bit_cast(int, x), CTRL, 0xf, 0xf, true)); }

namespace pg8 {
constexpr int BM = 256, BK = 64, HALF = 128, HTB = HALF * BK * 2, STAGE_BYTES = 8 * HTB, NXCD = 8, WGM = 4;
__host__ __device__ __forceinline__ int lds_byte(int r, int c) { const int st = (r >> 4) * 2 + (c >> 5), rr = r & 15, cc = c & 31, ob = rr * 64 + cc * 2; return st * 1024 + (ob ^ (((ob >> 9) & 1) << 5)); }
__host__ __device__ __forceinline__ void stage_rc(int b, int& R, int& C) { const int st = b / 1024, sb = b % 1024, swz = sb ^ (((sb >> 9) & 1) << 5); R = (st >> 1) * 16 + swz / 64; C = (st & 1) * 32 + (swz % 64) / 2; }
__host__ __device__ __forceinline__ int perm32(int rho) { const int n = rho >> 4, i = rho & 15; return 8 * (i >> 2) + 4 * n + (i & 3); }

struct Unit { int pm, pn; };
struct Gemm { const bf16_t* A; const bf16_t* Bt; int lda, ldb, nt, nM, nN, a_sh, a_mul, a_swz = 0, b_pm = 0; };

struct StaticOrder {
    int nM, nN, nwg, G, c;
    __device__ void init(int nM_, int nN_, int G_, int c_) { nM = nM_; nN = nN_; nwg = nM * nN; G = G_; c = c_; }
    __device__ bool next(int i, Unit& u) const {
        const long L = (long)i * G + c; if (L >= nwg) return false;
        int wgid = (int)L; { const int q = nwg / NXCD, r = nwg % NXCD, xcd = wgid % NXCD, off = wgid / NXCD; wgid = (xcd < r ? xcd * (q + 1) : r * (q + 1) + (xcd - r) * q) + off; }
        const int nig = WGM * nN, gid = wgid / nig, fm = gid * WGM, gsz = (nM - fm) < WGM ? (nM - fm) : WGM;
        u.pm = fm + ((wgid % nig) % gsz); u.pn = (wgid % nig) / gsz; return true;
    }
};

template <class Epi, bool ALIGN_EPI, class Sched = StaticOrder>
__device__ __forceinline__ void gemm_phase(LAS unsigned char* lds, const Gemm g, const Sched& S, const Epi& E) {
    int tid = threadIdx.x; asm volatile("" : "+v"(tid)); tid &= 511;
    const int wid = __builtin_amdgcn_readfirstlane(tid >> 6), lane = tid & 63, wr = wid >> 2, wc = wid & 3, fr = lane & 15, fq = lane >> 4;
    const int nt = g.nt;
    unsigned voffA[2], voffB[2];
#pragma unroll
    for (int i = 0; i < 2; ++i) { int R, C; stage_rc(tid * 16 + i * 8192, R, C); const int Rb = Epi::PERM == 2 ? ((R >> 5) * 64 + perm32(R & 31)) : Epi::PERM == 1 ? ((R & ~31) + perm32(R & 31)) : R;
        const int Ra = g.a_swz ? ((R & ~8) | (((C >> 5) & 1) << 3)) : R, Ca = g.a_swz ? ((C & ~32) | (((R >> 3) & 1) << 5)) : C;
        voffA[i] = (unsigned)(Ra * g.lda + Ca) * 2u; voffB[i] = (unsigned)(Rb * g.ldb + C) * 2u; }
    const size_t kstep = (size_t)(BK * 2);
    const size_t hstepA = (size_t)HALF * g.lda * 2, hstepB = (size_t)(Epi::PERM == 2 ? 32 : HALF) * g.ldb * 2;
    const size_t tstepA = 2 * hstepA, tstepB = (size_t)BM * g.ldb * 2;
    const unsigned ldsw = (unsigned)wid * 1024u;
    const int aoff = lds_byte(wr * 64 + fr, fq * 8), boff = lds_byte(wc * 32 + fr, fq * 8);
#define PG8_SA(b, h) (((b) * 2 + (h)) * HTB)
#define PG8_SB(b, h) ((4 + (b) * 2 + (h)) * HTB)
#define PG8_STAGE(bufoff, gbase, voff) do { _Pragma("unroll") for (int _i = 0; _i < 2; ++_i) \
        __builtin_amdgcn_global_load_lds((const unsigned*)((const char*)(gbase) + (voff)[_i]), (LAS unsigned*)(lds + (bufoff) + ldsw + _i * 8192), 16, 0, 0); } while (0)
#define PG8_LDA(dst, b, h) do { _Pragma("unroll") for (int m = 0; m < 4; ++m) _Pragma("unroll") for (int k = 0; k < 2; ++k) dst[m][k] = *(const LAS bf16x8*)(lds + PG8_SA(b, h) + aoff + m * 2048 + k * 1024); } while (0)
#define PG8_LDB(dst, b, h) do { _Pragma("unroll") for (int n = 0; n < 2; ++n) _Pragma("unroll") for (int k = 0; k < 2; ++k) dst[n][k] = *(const LAS bf16x8*)(lds + PG8_SB(b, h) + boff + n * 2048 + k * 1024); } while (0)
#define PG8_MMA(ai, bj, At, Bt) do { __builtin_amdgcn_s_setprio(1); _Pragma("unroll") for (int m = 0; m < 4; ++m) _Pragma("unroll") for (int n = 0; n < 2; ++n) _Pragma("unroll") for (int k = 0; k < 2; ++k) \
        acc[ai][bj][m][n] = __builtin_amdgcn_mfma_f32_16x16x32_bf16(Bt[n][k], At[m][k], acc[ai][bj][m][n], 0, 0, 0); __builtin_amdgcn_s_setprio(0); } while (0)
#define PG8_WAIT_V(n) asm volatile("s_waitcnt vmcnt(" #n ")" ::: "memory")
#define PG8_WAIT_L(n) asm volatile("s_waitcnt lgkmcnt(" #n ")" ::: "memory")
#define PG8_BAR __builtin_amdgcn_s_barrier()
#define PG8_SCHED __builtin_amdgcn_sched_barrier(0)
#define PG8_ABASE(u) ((const char*)g.A + (size_t)(u).pm * tstepA + (size_t)(((u).pn >> g.a_sh) * g.a_mul) * 2)
#define PG8_BBASE(u) ((const char*)g.Bt + (size_t)(u).pn * tstepB + (size_t)((u).pm * g.b_pm))
    Unit cur, nxt; int ui = 0;
    if (!S.next(0, cur)) return;
    f32x4 acc[2][2][4][2];
#pragma unroll
    for (int a = 0; a < 2; ++a)
#pragma unroll
        for (int b = 0; b < 2; ++b)
#pragma unroll
            for (int m = 0; m < 4; ++m)
#pragma unroll
                for (int n = 0; n < 2; ++n) acc[a][b][m][n] = (f32x4){0.f, 0.f, 0.f, 0.f};
    bf16x8 At[4][2], B0[2][2], B1[2][2];
    const char* cA = PG8_ABASE(cur); const char* cB = PG8_BBASE(cur);
    PG8_STAGE(PG8_SB(0, 0), cB, voffB); PG8_STAGE(PG8_SB(0, 1), cB + hstepB, voffB); PG8_STAGE(PG8_SA(0, 0), cA, voffA); PG8_STAGE(PG8_SA(0, 1), cA + hstepA, voffA);
    if (wr == 1) PG8_BAR;
    PG8_WAIT_V(2); PG8_BAR;
    PG8_STAGE(PG8_SB(1, 0), cB + kstep, voffB); PG8_STAGE(PG8_SA(1, 0), cA + kstep, voffA); PG8_STAGE(PG8_SB(1, 1), cB + hstepB + kstep, voffB);
    PG8_WAIT_V(6); PG8_BAR;
    for (;;) {
        const bool has_next = S.next(ui + 1, nxt);
        const char* nA = has_next ? PG8_ABASE(nxt) : cA; const char* nB = has_next ? PG8_BBASE(nxt) : cB;
#pragma unroll 1
        for (int t = 0; t < nt; t += 2) {
            const bool last = (t == nt - 2);
            if constexpr (Epi::MIDK) { if (t == E.midk_t) E.mid(acc, cur, wr, wc, fr, fq); }
            const char* a1 = cA + (size_t)(t + 1) * kstep;
            const char* a2 = last ? nA : cA + (size_t)(t + 2) * kstep; const char* b2 = last ? nB : cB + (size_t)(t + 2) * kstep;
            const char* a3 = a2 + kstep; const char* b3 = b2 + kstep;
            PG8_LDB(B0, 0, 0); PG8_LDB(B1, 0, 1); PG8_SCHED; PG8_LDA(At, 0, 0); PG8_STAGE(PG8_SA(1, 1), a1 + hstepA, voffA);
            PG8_WAIT_V(8); PG8_WAIT_L(0); PG8_BAR; PG8_MMA(0, 0, At, B0); PG8_MMA(0, 1, At, B1); PG8_BAR; PG8_SCHED;
            PG8_LDA(At, 0, 1); PG8_STAGE(PG8_SB(0, 0), b2, voffB); PG8_STAGE(PG8_SB(0, 1), b2 + hstepB, voffB); PG8_STAGE(PG8_SA(0, 0), a2, voffA);
            PG8_WAIT_V(8); PG8_WAIT_L(0); PG8_BAR; PG8_MMA(1, 0, At, B0); PG8_MMA(1, 1, At, B1); PG8_BAR; PG8_SCHED;
            PG8_LDB(B0, 1, 0); PG8_LDB(B1, 1, 1); PG8_SCHED; PG8_LDA(At, 1, 0); PG8_STAGE(PG8_SA(0, 1), a2 + hstepA, voffA);
            PG8_WAIT_V(8); PG8_WAIT_L(0); PG8_BAR; PG8_MMA(0, 0, At, B0); PG8_MMA(0, 1, At, B1); PG8_BAR; PG8_SCHED;
            PG8_LDA(At, 1, 1); PG8_STAGE(PG8_SB(1, 0), b3, voffB); PG8_STAGE(PG8_SB(1, 1), b3 + hstepB, voffB); PG8_STAGE(PG8_SA(1, 0), a3, voffA);
            PG8_WAIT_V(8); PG8_WAIT_L(0); PG8_BAR; PG8_MMA(1, 0, At, B0); PG8_MMA(1, 1, At, B1); PG8_BAR; PG8_SCHED;
        }
        if constexpr (ALIGN_EPI) { if (wr == 0) PG8_BAR; }
        if constexpr (!Epi::AFTER_DRAIN) { E(acc, cur, ui, wr, wc, fr, fq); }
        if (!has_next) break;
#pragma unroll
        for (int a = 0; a < 2; ++a)
#pragma unroll
            for (int b = 0; b < 2; ++b)
#pragma unroll
                for (int m = 0; m < 4; ++m)
#pragma unroll
                    for (int n = 0; n < 2; ++n) acc[a][b][m][n] = (f32x4){0.f, 0.f, 0.f, 0.f};
        cur = nxt; cA = nA; cB = nB; ++ui;
        if constexpr (ALIGN_EPI) { if (wr == 1) PG8_BAR; }
    }
    PG8_WAIT_V(0);
    if constexpr (!ALIGN_EPI) { if (wr == 0) PG8_BAR; }
    PG8_BAR;
    if constexpr (Epi::AFTER_DRAIN) { E.fused(acc, cur, wr, wc, fr, fq, lds, wid, lane); }
#undef PG8_SA
#undef PG8_SB
#undef PG8_STAGE
#undef PG8_LDA
#undef PG8_LDB
#undef PG8_MMA
#undef PG8_WAIT_V
#undef PG8_WAIT_L
#undef PG8_BAR
#undef PG8_SCHED
#undef PG8_ABASE
#undef PG8_BBASE
}

typedef f32x4 Acc[2][2][4][2];
__device__ __forceinline__ float ror8_1(float x) { float r; asm volatile("s_nop 1\n\tv_mov_b32_dpp %0, %1 row_ror:8 row_mask:0xf bank_mask:0xf" : "=v"(r) : "v"(x)); return r; }
__device__ __forceinline__ f32x4 ror8(const f32x4 v) { f32x4 r; r[0] = ror8_1(v[0]); r[1] = ror8_1(v[1]); r[2] = ror8_1(v[2]); r[3] = ror8_1(v[3]); return r; }
__device__ __forceinline__ f32x4 sel4(bool c, const f32x4 a, const f32x4 b) { f32x4 r;
#pragma unroll
    for (int i = 0; i < 4; ++i) r[i] = c ? a[i] : b[i]; return r; }
__device__ __forceinline__ void ld_lines(const float* p, int ldf, bool lo, int fr7, f32x4& n0, f32x4& n1, int hoff = 16) {
    const float* q = p + (size_t)fr7 * ldf + (lo ? 0 : hoff); const f32x4 A = __builtin_nontemporal_load((const f32x4*)q), B = __builtin_nontemporal_load((const f32x4*)(q + (size_t)8 * ldf));
    n0 = sel4(lo, A, ror8(B)); n1 = sel4(lo, ror8(A), B); }
__device__ __forceinline__ void st_lines(float* p, int ldf, bool lo, int fr7, const f32x4 n0, const f32x4 n1, int hoff = 16) {
    float* q = p + (size_t)fr7 * ldf + (lo ? 0 : hoff); *(f32x4*)q = sel4(lo, n0, ror8(n1)); *(f32x4*)(q + (size_t)8 * ldf) = sel4(lo, ror8(n0), n1); }
__device__ __forceinline__ u32x4 asu(const f32x4 v) { return __builtin_bit_cast(u32x4, v); }
__device__ __forceinline__ f32x4 asf(const u32x4 v) { return __builtin_bit_cast(f32x4, v); }
__device__ __forceinline__ void st_lines16(bf16_t* p, int ld, bool lo, int fr7, const u32x4 h0, const u32x4 h1) {
    bf16_t* q = p + (size_t)fr7 * ld + (lo ? 0 : 32); *(u32x4*)q = asu(sel4(lo, asf(h0), ror8(asf(h1)))); *(u32x4*)(q + (size_t)8 * ld) = asu(sel4(lo, ror8(asf(h0)), asf(h1))); }
__device__ __forceinline__ void ld_lines16_raw(const bf16_t* p, int ld, bool lo, int fr7, f32x4& A, f32x4& B) { const bf16_t* q = p + (size_t)fr7 * ld + (lo ? 0 : 32); A = asf(*(const u32x4*)q); B = asf(*(const u32x4*)(q + (size_t)8 * ld)); }
__device__ __forceinline__ void lines16_fix(bool lo, const f32x4 A, const f32x4 B, u32x4& h0, u32x4& h1) { h0 = asu(sel4(lo, A, ror8(B))); h1 = asu(sel4(lo, ror8(A), B)); }
__device__ __forceinline__ void ld_lines16(const bf16_t* p, int ld, bool lo, int fr7, u32x4& h0, u32x4& h1) {
    const bf16_t* q = p + (size_t)fr7 * ld + (lo ? 0 : 32); const f32x4 A = asf(*(const u32x4*)q), B = asf(*(const u32x4*)(q + (size_t)8 * ld));
    h0 = asu(sel4(lo, A, ror8(B))); h1 = asu(sel4(lo, ror8(A), B)); }

constexpr int TAB_OFF = RING_BYTES + 1024;

__device__ __forceinline__ float row_rstd(const float* ss, int row) {
    float s = 0.f;
#pragma unroll
    for (int j = 0; j < 8; ++j) s += ss[(size_t)j * M + row];
    return __builtin_amdgcn_rsqf(s * (1.0f / DM) + EPS);
}
__device__ __forceinline__ u32x4 pack8(const f32x4 a, const f32x4 b) { u32x4 w; w.x = cvt_pk_bf16(a[0], a[1]); w.y = cvt_pk_bf16(a[2], a[3]); w.z = cvt_pk_bf16(b[0], b[1]); w.w = cvt_pk_bf16(b[2], b[3]); return w; }
__device__ __forceinline__ void unpack8(const u32x4 w, f32x4& a, f32x4& b) { a = (f32x4){bf_lo(w.x), bf_hi(w.x), bf_lo(w.y), bf_hi(w.y)}; b = (f32x4){bf_lo(w.z), bf_hi(w.z), bf_lo(w.w), bf_hi(w.w)}; }

__device__ __forceinline__ void fill_rstd_tab(LAS unsigned char* lds, const StaticOrder& S, const float* ss, int tid) {
    LAS float* tab = (LAS float*)(lds + TAB_OFF); Unit u;
    for (int i = 0; i < 8 && S.next(i, u); ++i) if (tid < 256) tab[i * 256 + tid] = row_rstd(ss, u.pm * BM + tid);
    __syncthreads();
}
constexpr int BTAB_OFF = RING_BYTES + 9216;
__device__ __forceinline__ void fill_tabs(LAS unsigned char* lds, const StaticOrder& S, const float* ss, const float* pb, int ncols, int tid) {
    LAS float* tab = (LAS float*)(lds + TAB_OFF); LAS float* bt = (LAS float*)(lds + BTAB_OFF); LAS float* bh = (LAS float*)lds;
    const int c = tid & 255, h = tid >> 8;
    Unit u0; S.next(0, u0);
    float sb[6], sr[3];
#pragma unroll
    for (int i = 0; i < 6; ++i) { Unit u; if (!S.next(i, u)) u = u0; const float* p = pb + (size_t)((u.pm >> 4) * 32 + 16 * h) * ncols + u.pn * BM + c; float s = 0.f;
#pragma unroll
        for (int kb = 0; kb < 16; ++kb) s += p[(size_t)kb * ncols];
        sb[i] = s; }
#pragma unroll
    for (int j = 0; j < 3; ++j) { Unit u; if (!S.next(2 * j + h, u)) u = u0; sr[j] = row_rstd(ss, u.pm * BM + c); }
#pragma unroll
    for (int j = 0; j < 3; ++j) tab[(2 * j + h) * 256 + c] = sr[j];
    if (h) {
#pragma unroll
        for (int i = 0; i < 6; ++i) bh[i * 256 + c] = sb[i]; }
    __syncthreads();
    if (!h) {
#pragma unroll
        for (int i = 0; i < 6; ++i) bt[i * 256 + c] = sb[i] + bh[i * 256 + c]; }
    __syncthreads();
}
struct EpiZ {
    static constexpr int PERM = 2; static constexpr bool AFTER_DRAIN = false, MIDK = false;
    const LAS float* tab; const LAS float* btab; bf16_t* xrnn; bf16_t* gg; bf16_t* xpool; bf16_t* rg; int midk_t;
    __device__ __forceinline__ void mid(Acc&, const Unit&, int, int, int, int) const {}
    __device__ __forceinline__ void operator()(const Acc& acc, const Unit& u, int ui, int wr, int wc, int fr, int fq) const {
        { int t_ = threadIdx.x; asm volatile("" : "+v"(t_)); fr = t_ & 15; fq = (t_ >> 4) & 3; }
        const int row0 = u.pm * BM + wr * 64, b = u.pm >> 4, lc0 = wc * 64 + 8 * fq; const bool lo = fr < 8; const int fr7 = fr & 7;
        const LAS float* rtab = tab + ui * 256 + wr * 64 + fr;
        const LAS float* bp = btab + ui * 256 + lc0;
        f32x4 bv[2][2];
#pragma unroll
        for (int bj = 0; bj < 2; ++bj)
#pragma unroll
            for (int n = 0; n < 2; ++n) bv[bj][n] = *(const LAS f32x4*)(bp + 32 * bj + 4 * n);
        bf16_t* d0; int ld, mode = 0;
        if (u.pn < 8) { d0 = xrnn + u.pn * BM + lc0; ld = DRNN; }
        else if (u.pn < 16) { d0 = gg + (u.pn - 8) * BM + lc0; ld = DRNN; mode = 1; }
        else if (u.pn < 20) { d0 = xpool + (u.pn - 16) * BM + lc0; ld = DPOOL; }
        else { d0 = rg + (u.pn - 20) * BM + lc0; ld = 2 * DM; mode = 2; }
#pragma unroll
        for (int ai = 0; ai < 2; ++ai)
#pragma unroll
            for (int m = 0; m < 4; ++m) { const int rowg = row0 + ai * HALF + m * 16; const float rs = rtab[ai * HALF + m * 16];
                f32x4 z[2][2];
#pragma unroll
                for (int bj = 0; bj < 2; ++bj)
#pragma unroll
                    for (int n = 0; n < 2; ++n) z[bj][n] = acc[ai][bj][m][n] * rs + bv[bj][n];
                if (mode == 1) {
#pragma unroll
                    for (int bj = 0; bj < 2; ++bj)
#pragma unroll
                        for (int n = 0; n < 2; ++n)
#pragma unroll
                            for (int i = 0; i < 4; ++i) z[bj][n][i] = gelu_tanh_f(z[bj][n][i]);
                } else if (mode == 2) {
#pragma unroll
                    for (int n = 0; n < 2; ++n)
#pragma unroll
                        for (int i = 0; i < 4; ++i) { const float eu = fexp2(-1.4426950409f * z[0][n][i]), ev = fminf(fexp2(-1.4426950409f * z[1][n][i]), 1e30f);
                            z[1][n][i] = frcp(1.f + ev); z[0][n][i] = (1.f + ev) * frcp(1.f + eu); }
                }
                st_lines16(d0 + (size_t)rowg * ld, ld, lo, fr7, pack8(z[0][0], z[0][1]), pack8(z[1][0], z[1][1])); }
    }
};

struct GateOrder {
    int c;
    __device__ bool next(int i, Unit& u) const { if (i >= 2 || c >= 256) return false; const int pmi = c >> 4; u.pn = c & 15; u.pm = ((pmi < 8) ? pmi : pmi + 8) + 8 * i; return true; }
};
constexpr int SCAN_OFF = RING_BYTES + 9216;
template <int CTRL> __device__ __forceinline__ float dpp_old(float oldv, float x) { return __builtin_bit_cast(float, __builtin_amdgcn_update_dpp(__builtin_bit_cast(int, oldv), __builtin_bit_cast(int, x), CTRL, 0xf, 0xf, false)); }
__device__ __forceinline__ float bcast15(float x) { return __builtin_bit_cast(float, __builtin_amdgcn_ds_swizzle(__builtin_bit_cast(int, x), 0x1F0)); }
#define SCAN16_STEP(k) \
    "v_fmac_f32_dpp %4, %4, %0 row_shr:" #k " row_mask:0xf bank_mask:0xf\n\tv_fmac_f32_dpp %5, %5, %1 row_shr:" #k " row_mask:0xf bank_mask:0xf\n\t" \
    "v_fmac_f32_dpp %6, %6, %2 row_shr:" #k " row_mask:0xf bank_mask:0xf\n\tv_fmac_f32_dpp %7, %7, %3 row_shr:" #k " row_mask:0xf bank_mask:0xf\n\t" \
    "v_mul_f32_dpp %0, %0, %0 row_shr:" #k " row_mask:0xf bank_mask:0xf\n\tv_mul_f32_dpp %1, %1, %1 row_shr:" #k " row_mask:0xf bank_mask:0xf\n\t" \
    "v_mul_f32_dpp %2, %2, %2 row_shr:" #k " row_mask:0xf bank_mask:0xf\n\tv_mul_f32_dpp %3, %3, %3 row_shr:" #k " row_mask:0xf bank_mask:0xf\n\t"
__device__ __forceinline__ void scan16(f32x4& P, f32x4& H) {
    float p0 = P[0], p1 = P[1], p2 = P[2], p3 = P[3], h0 = H[0], h1 = H[1], h2 = H[2], h3 = H[3];
    asm("s_nop 1\n\t" SCAN16_STEP(1) SCAN16_STEP(2) SCAN16_STEP(4) SCAN16_STEP(8) "s_nop 0"
        : "+v"(p0), "+v"(p1), "+v"(p2), "+v"(p3), "+v"(h0), "+v"(h1), "+v"(h2), "+v"(h3));
    P = (f32x4){p0, p1, p2, p3}; H = (f32x4){h0, h1, h2, h3};
}
#undef SCAN16_STEP
struct EpiGates {
    static constexpr int PERM = 2; static constexpr bool AFTER_DRAIN = false, MIDK = false;
    const float* ba; const float* bx; const float* lruk; const bf16_t* xr; const bf16_t* gg; bf16_t* yab; unsigned long long* aggu; LAS unsigned char* lds; int midk_t;
    __device__ __forceinline__ void mid(Acc&, const Unit&, int, int, int, int) const {}
    __device__ __forceinline__ void operator()(const Acc& acc, const Unit& u, int ui, int wr, int wc, int fr, int fq) const {
        int tid; { int t_ = threadIdx.x; asm volatile("" : "+v"(t_)); tid = t_ & 511; fr = t_ & 15; fq = (t_ >> 4) & 3; }
        const int b = u.pm >> 4, pmb = u.pm & 15;
        const int row0 = u.pm * BM + wr * 64 + fr, chl0 = wc * 32 + 8 * fq, ch0 = u.pn * HALF + chl0;
        LAS float* CH = (LAS float*)(lds + SCAN_OFF); LAS float* CARRY = CH + 1024;
        f32x4 Pf[2][4][2], Hf[2][4][2];
        f32x4 vba[2], vbx[2], vk[2];
#pragma unroll
        for (int n = 0; n < 2; ++n) { vba[n] = *(const f32x4*)(ba + ch0 + 4 * n); vbx[n] = *(const f32x4*)(bx + ch0 + 4 * n); vk[n] = *(const f32x4*)(lruk + ch0 + 4 * n); }
#pragma unroll
        for (int ai = 0; ai < 2; ++ai) {
            f32x4 Pc[2] = {(f32x4){1.f, 1.f, 1.f, 1.f}, (f32x4){1.f, 1.f, 1.f, 1.f}}, Hc[2] = {(f32x4){0.f, 0.f, 0.f, 0.f}, (f32x4){0.f, 0.f, 0.f, 0.f}};
            const bf16_t* px = xr + (size_t)(row0 + ai * HALF) * DRNN + ch0; asm volatile("" : "+v"(px)); px = (const bf16_t*)(const __attribute__((address_space(1))) bf16_t*)(unsigned long long)px;
            u32x4 xw4[4];
#pragma unroll
            for (int m = 0; m < 4; ++m) { xw4[m] = *(const u32x4*)px; px += 16 * DRNN; }
#pragma unroll
            for (int m = 0; m < 4; ++m) { const u32x4 xw = xw4[m]; f32x4 xv[2]; unpack8(xw, xv[0], xv[1]);
#pragma unroll
                for (int n = 0; n < 2; ++n) { f32x4 Pv, Hv;
#pragma unroll
                    for (int i = 0; i < 4; ++i) { const float r = sigmoid_f(acc[ai][0][m][n][i] + vba[n][i]), g = sigmoid_f(acc[ai][1][m][n][i] + vbx[n][i]);
                        const float P = fexp2(1.4426950409f * vk[n][i] * r); Pv[i] = P; Hv[i] = __builtin_amdgcn_sqrtf(fmaxf(1.f - P * P, 0.f)) * (g * xv[n][i]); }
                    scan16(Pv, Hv);
#pragma unroll
                    for (int i = 0; i < 4; ++i) { const float P = Pv[i], H = Hv[i];
                        const float Pt = bcast15(P), Ht = bcast15(H);
                        Hf[ai][m][n][i] = P * Hc[n][i] + H; Pf[ai][m][n][i] = P * Pc[n][i];
                        Hc[n][i] = Pt * Hc[n][i] + Ht; Pc[n][i] = Pt * Pc[n][i]; }
                    asm volatile("" : "+v"(Hf[ai][m][n]), "+v"(Pf[ai][m][n]), "+v"(Hc[n]), "+v"(Pc[n]) :: "memory"); } }
            if (fr == 0) {
#pragma unroll
                for (int n = 0; n < 2; ++n) { *(LAS f32x4*)(CH + ((2 * ai + wr) * 2 + 0) * 128 + chl0 + 4 * n) = Pc[n]; *(LAS f32x4*)(CH + ((2 * ai + wr) * 2 + 1) * 128 + chl0 + 4 * n) = Hc[n]; } }
        }
        u32x4 gw8[2][4];
#pragma unroll
        for (int ai = 0; ai < 2; ++ai) { const bf16_t* pg = gg + (size_t)(row0 + ai * HALF) * DRNN + ch0; asm volatile("" : "+v"(pg)); pg = (const bf16_t*)(const __attribute__((address_space(1))) bf16_t*)(unsigned long long)pg;
#pragma unroll
            for (int m = 0; m < 4; ++m) { gw8[ai][m] = __builtin_nontemporal_load((const u32x4*)pg); pg += 16 * DRNN; } }
        asm volatile("s_waitcnt lgkmcnt(0)" ::: "memory"); __builtin_amdgcn_s_barrier(); asm volatile("" ::: "memory");
        {
            const int tc = tid & 127, jg = tid >> 7;
            unsigned long long* gbase = aggu + (size_t)(b * 16) * DRNN + u.pn * HALF + tc;
            if (jg == 0) { float P = 1.f, H = 0.f;
#pragma unroll
                for (int c = 0; c < 4; ++c) { const float p = CH[(c * 2 + 0) * 128 + tc], h = CH[(c * 2 + 1) * 128 + tc]; H = p * H + h; P = p * P; }
                __hip_atomic_store(gbase + (size_t)pmb * DRNN, ((unsigned long long)__float_as_uint(H) << 32) | (unsigned long long)__float_as_uint(-P), __ATOMIC_RELAXED, __HIP_MEMORY_SCOPE_AGENT); }
            float Pq = 1.f, Hq = 0.f;
            if (4 * jg < pmb) {
                unsigned long long gq[4]; unsigned spins = 0;
                for (;;) { bool ok = true;
#pragma unroll
                    for (int j = 0; j < 4; ++j) { gq[j] = 0x80000000ull; if (4 * jg + j < pmb) { gq[j] = __hip_atomic_load(gbase + (size_t)(4 * jg + j) * DRNN, __ATOMIC_RELAXED, __HIP_MEMORY_SCOPE_AGENT); ok = ok && ((gq[j] >> 31) & 1ull); } }
                    if (__all(ok) || ++spins > (1u << 20)) break;
                    __builtin_amdgcn_s_sleep(4); }
#pragma unroll
                for (int j = 0; j < 4; ++j) if (4 * jg + j < pmb) { const float p = -__uint_as_float((unsigned)gq[j]), h = __uint_as_float((unsigned)(gq[j] >> 32)); Hq = p * Hq + h; Pq = p * Pq; }
            }
            LAS float* PART = (LAS float*)(lds + TAB_OFF);
            PART[(jg * 2 + 0) * 128 + tc] = Pq; PART[(jg * 2 + 1) * 128 + tc] = Hq;
        }
        asm volatile("s_waitcnt lgkmcnt(0)" ::: "memory"); __builtin_amdgcn_s_barrier(); asm volatile("" ::: "memory");
        if (tid < 128) { const LAS float* PART = (const LAS float*)(lds + TAB_OFF); float hin = 0.f;
#pragma unroll
            for (int jg = 0; jg < 4; ++jg) hin = PART[(jg * 2 + 0) * 128 + tid] * hin + PART[(jg * 2 + 1) * 128 + tid];
            CARRY[tid] = hin; }
        asm volatile("s_waitcnt lgkmcnt(0)" ::: "memory"); __builtin_amdgcn_s_barrier(); asm volatile("" ::: "memory");
#pragma unroll
        for (int ai = 0; ai < 2; ++ai) {
            f32x4 hp[2];
#pragma unroll
            for (int n = 0; n < 2; ++n) { hp[n] = *(const LAS f32x4*)(CARRY + chl0 + 4 * n);
#pragma unroll
                for (int c = 0; c < 3; ++c) if (c < 2 * ai + wr) hp[n] = *(const LAS f32x4*)(CH + (c * 2 + 0) * 128 + chl0 + 4 * n) * hp[n] + *(const LAS f32x4*)(CH + (c * 2 + 1) * 128 + chl0 + 4 * n); }
            bf16_t* py = yab + (size_t)(row0 + ai * HALF) * 3072 + ch0; asm volatile("" : "+v"(py)); py = (bf16_t*)(__attribute__((address_space(1))) bf16_t*)(unsigned long long)py;
#pragma unroll
            for (int m = 0; m < 4; ++m) { const u32x4 gw = gw8[ai][m]; f32x4 g0, g1; unpack8(gw, g0, g1);
                *(u32x4*)py = pack8((Hf[ai][m][0] + Pf[ai][m][0] * hp[0]) * g0, (Hf[ai][m][1] + Pf[ai][m][1] * hp[1]) * g1); py += 16 * 3072; asm volatile("" ::: "memory"); }
        }
    }
};

struct EpiPool {
    static constexpr int PERM = 2; static constexpr bool AFTER_DRAIN = false, MIDK = false;
    const float* pb; const float* ps; bf16_t* yab; int midk_t;
    __device__ __forceinline__ void mid(Acc&, const Unit&, int, int, int, int) const {}
    __device__ __forceinline__ void operator()(const Acc& acc, const Unit& u, int ui, int wr, int wc, int fr, int fq) const {
        { int t_ = threadIdx.x; asm volatile("" : "+v"(t_)); fr = t_ & 15; fq = (t_ >> 4) & 3; }
        const int c0 = u.pn * BM + wc * 64 + 8 * fq; const bool lo = fr < 8; const int fr7 = fr & 7;
        f32x4 bv[2][2], sv[2][2];
#pragma unroll
        for (int bj = 0; bj < 2; ++bj)
#pragma unroll
            for (int n = 0; n < 2; ++n) { bv[bj][n] = *(const f32x4*)(pb + c0 + 32 * bj + 4 * n); sv[bj][n] = *(const f32x4*)(ps + c0 + 32 * bj + 4 * n); }
#pragma unroll
        for (int ai = 0; ai < 2; ++ai)
#pragma unroll
            for (int m = 0; m < 4; ++m) { bf16_t* p = yab + (size_t)(u.pm * BM + ai * HALF + wr * 64 + m * 16) * 3072 + 2048 + c0;
                st_lines16(p, 3072, lo, fr7, pack8((acc[ai][0][m][0] + bv[0][0]) * sv[0][0], (acc[ai][0][m][1] + bv[0][1]) * sv[0][1]), pack8((acc[ai][1][m][0] + bv[1][0]) * sv[1][0], (acc[ai][1][m][1] + bv[1][1]) * sv[1][1]));
                asm volatile("" ::: "memory"); }
    }
};

struct EpiWp {
    static constexpr int PERM = 0; static constexpr bool AFTER_DRAIN = false, MIDK = false;
    bf16_t* dst; int midk_t;
    __device__ __forceinline__ void mid(Acc&, const Unit&, int, int, int, int) const {}
    __device__ __forceinline__ void operator()(const Acc& acc, const Unit& u, int ui, int wr, int wc, int fr, int fq) const {
        { int t_ = threadIdx.x; asm volatile("" : "+v"(t_)); fr = t_ & 15; fq = (t_ >> 4) & 3; }
#pragma unroll
        for (int ai = 0; ai < 2; ++ai)
#pragma unroll
            for (int m = 0; m < 4; ++m) { const int k = ai * HALF + wr * 64 + m * 16 + fr;
#pragma unroll
                for (int bj = 0; bj < 2; ++bj)
#pragma unroll
                    for (int n = 0; n < 2; ++n)
#pragma unroll
                        for (int i = 0; i < 4; ++i) { const int c = 128 * bj + 32 * wc + 16 * n + 4 * fq + i;
                            dst[(size_t)(u.pn * BM + c) * 3072 + 256 * u.pm + k] = (bf16_t)(cvt_pk_bf16(acc[ai][bj][m][n][i], 0.f) & 0xffffu); }
                asm volatile("" ::: "memory"); }
    }
};

struct EpiMerge {
    static constexpr int PERM = 2; static constexpr bool AFTER_DRAIN = false, MIDK = true;
    const bf16_t* rg; bf16_t* merged; const LAS float* btab; int midk_t;
    __device__ __forceinline__ void mid(Acc& acc, const Unit& u, int wr, int wc, int fr, int fq) const {
        { int t_ = threadIdx.x; asm volatile("" : "+v"(t_)); fr = t_ & 15; fq = (t_ >> 4) & 3; }
        const int rc0 = 256 * (2 * u.pn + (wc >> 1)) + 128 * (wc & 1) + 8 * fq;
#pragma unroll
        for (int ai = 0; ai < 2; ++ai) { u32x4 h0[4], h1[4];
#pragma unroll
            for (int m = 0; m < 4; ++m) { const bf16_t* pr = rg + (size_t)(u.pm * BM + ai * HALF + wr * 64 + m * 16 + fr) * (2 * DM) + rc0; h0[m] = __builtin_nontemporal_load((const u32x4*)pr); h1[m] = __builtin_nontemporal_load((const u32x4*)(pr + 64)); }
#pragma unroll
            for (int m = 0; m < 4; ++m) {
                f32x4 a, b; unpack8(h0[m], a, b); acc[ai][0][m][0] *= a; acc[ai][0][m][1] *= b; unpack8(h1[m], a, b); acc[ai][1][m][0] *= a; acc[ai][1][m][1] *= b; }
            asm volatile("" ::: "memory"); }
    }
    __device__ __forceinline__ void operator()(const Acc& acc, const Unit& u, int ui, int wr, int wc, int fr, int fq) const {
        { int t_ = threadIdx.x; asm volatile("" : "+v"(t_)); fr = t_ & 15; fq = (t_ >> 4) & 3; }
        const int c0 = u.pn * BM + wc * 64 + 8 * fq; const bool lo = fr < 8; const int fr7 = fr & 7;
        const int rc0 = 256 * (2 * u.pn + (wc >> 1)) + 128 * (wc & 1) + 8 * fq + 32;
        f32x4 bv[2][2];
#pragma unroll
        for (int bj = 0; bj < 2; ++bj)
#pragma unroll
            for (int n = 0; n < 2; ++n) bv[bj][n] = *(const LAS f32x4*)(btab + wc * 64 + 32 * bj + 8 * fq + 4 * n);
#pragma unroll
        for (int ai = 0; ai < 2; ++ai) { u32x4 g0[4], g1[4];
#pragma unroll
            for (int m = 0; m < 4; ++m) { const bf16_t* pr = rg + (size_t)(u.pm * BM + ai * HALF + wr * 64 + m * 16 + fr) * (2 * DM) + rc0; g0[m] = __builtin_nontemporal_load((const u32x4*)pr); g1[m] = __builtin_nontemporal_load((const u32x4*)(pr + 64)); }
#pragma unroll
            for (int m = 0; m < 4; ++m) { const size_t goff = (size_t)(u.pm * BM + ai * HALF + wr * 64 + m * 16) * DM + c0;
                f32x4 a0, b0, a1, b1; unpack8(g0[m], a0, b0); unpack8(g1[m], a1, b1);
                st_lines16(merged + goff, DM, lo, fr7, pack8((acc[ai][0][m][0] + bv[0][0]) * a0, (acc[ai][0][m][1] + bv[0][1]) * b0), pack8((acc[ai][1][m][0] + bv[1][0]) * a1, (acc[ai][1][m][1] + bv[1][1]) * b1));
                asm volatile("" ::: "memory"); } }
    }
};

template <bool F32SRC>
struct EpiResid {
    static constexpr int PERM = 2; static constexpr bool AFTER_DRAIN = true, MIDK = false;
    const float* xsrc_f;
    const bf16_t* xsrc_b; const float* gsrc;
    bf16_t* xg; const float* gt; const float* gm; float* ss; int midk_t;
    __device__ __forceinline__ void mid(Acc&, const Unit&, int, int, int, int) const {}
    __device__ __forceinline__ void operator()(const Acc&, const Unit&, int, int, int, int, int) const {}
    __device__ __forceinline__ void fused(const Acc& acc, const Unit& u, int wr, int wc, int fr, int fq, LAS unsigned char* lds, int wid, int lane) const {
        { int t_ = threadIdx.x; asm volatile("" : "+v"(t_)); fr = t_ & 15; fq = (t_ >> 4) & 3; }
        const int b = u.pm >> 4, col0 = u.pn * BM + wc * 64 + 8 * fq;
        LAS float* P = (LAS float*)lds;
        const bool lo = fr < 8; const int fr7 = fr & 7;
        f32x4 gv[2][2], gmv[2][2], rgv[2][2];
#pragma unroll
        for (int bj = 0; bj < 2; ++bj)
#pragma unroll
            for (int n = 0; n < 2; ++n) { const size_t ci = (size_t)b * DM + col0 + 32 * bj + 4 * n; gv[bj][n] = *(const f32x4*)(gt + ci); gmv[bj][n] = *(const f32x4*)(gm + ci);
                if constexpr (!F32SRC) { const f32x4 gs = *(const f32x4*)(gsrc + ci); rgv[bj][n] = (f32x4){1.0f / gs[0], 1.0f / gs[1], 1.0f / gs[2], 1.0f / gs[3]}; } else rgv[bj][n] = (f32x4){1.f, 1.f, 1.f, 1.f}; }
#pragma unroll
        for (int ai = 0; ai < 2; ++ai) { f32x4 RA[4], RB[4];
            if constexpr (!F32SRC) {
#pragma unroll
                for (int m = 0; m < 4; ++m) ld_lines16_raw(xsrc_b + (size_t)(u.pm * BM + ai * HALF + wr * 64 + m * 16) * DM + col0, DM, lo, fr7, RA[m], RB[m]); }
#pragma unroll
            for (int m = 0; m < 4; ++m) { const size_t goff = (size_t)(u.pm * BM + ai * HALF + wr * 64 + m * 16) * DM + col0;
                float q = 0.f; u32x4 pk[2]; f32x4 x[2][2];
                if constexpr (F32SRC) {
#pragma unroll
                    for (int bj = 0; bj < 2; ++bj) ld_lines(xsrc_f + goff + 32 * bj, DM, lo, fr7, x[bj][0], x[bj][1], 4);
                } else { u32x4 h0, h1; lines16_fix(lo, RA[m], RB[m], h0, h1); unpack8(h0, x[0][0], x[0][1]); unpack8(h1, x[1][0], x[1][1]);
#pragma unroll
                    for (int bj = 0; bj < 2; ++bj) { x[bj][0] *= rgv[bj][0]; x[bj][1] *= rgv[bj][1]; } }
#pragma unroll
                for (int bj = 0; bj < 2; ++bj) { const f32x4 y0 = x[bj][0] + gv[bj][0] * acc[ai][bj][m][0], y1 = x[bj][1] + gv[bj][1] * acc[ai][bj][m][1];
                    q += ((y0[0] * y0[0] + y0[1] * y0[1]) + (y0[2] * y0[2] + y0[3] * y0[3])) + ((y1[0] * y1[0] + y1[1] * y1[1]) + (y1[2] * y1[2] + y1[3] * y1[3]));
                    pk[bj] = pack8(y0 * gmv[bj][0], y1 * gmv[bj][1]); }
                st_lines16(xg + goff, DM, lo, fr7, pk[0], pk[1]);
                q += __shfl_xor(q, 16); q += __shfl_xor(q, 32); if (fq == 0) P[(ai * HALF + wr * 64 + m * 16 + fr) * 4 + wc] = q;
                asm volatile("" ::: "memory"); } }
        asm volatile("s_waitcnt lgkmcnt(0)" ::: "memory"); __builtin_amdgcn_s_barrier(); asm volatile("" ::: "memory");
        const int t = wid * 64 + lane;
        if (t < 256) { const float s = (P[t * 4 + 0] + P[t * 4 + 1]) + (P[t * 4 + 2] + P[t * 4 + 3]); ss[(size_t)u.pn * M + u.pm * BM + t] = s; }
    }
};

struct EpiFinal {
    static constexpr int PERM = 2; static constexpr bool AFTER_DRAIN = true, MIDK = false;
    const bf16_t* xsrc_b; const float* gsrc; float* out; const float* gt; const float* fg; unsigned* fss; int midk_t;
    __device__ __forceinline__ void mid(Acc&, const Unit&, int, int, int, int) const {}
    __device__ __forceinline__ void operator()(const Acc&, const Unit&, int, int, int, int, int) const {}
    __device__ __forceinline__ void fused(const Acc& acc, const Unit& u, int wr, int wc, int fr, int fq, LAS unsigned char* lds, int wid, int lane) const {
        { int t_ = threadIdx.x; asm volatile("" : "+v"(t_)); fr = t_ & 15; fq = (t_ >> 4) & 3; }
        const int b = u.pm >> 4, col0 = u.pn * BM + wc * 64 + 8 * fq;
        LAS float* P = (LAS float*)lds;
        const bool lo = fr < 8; const int fr7 = fr & 7;
        f32x4 xn[2][2][4][2]; f32x4 gv[2][2], rgv[2][2];
#pragma unroll
        for (int bj = 0; bj < 2; ++bj)
#pragma unroll
            for (int n = 0; n < 2; ++n) { const size_t ci = (size_t)b * DM + col0 + 32 * bj + 4 * n; gv[bj][n] = *(const f32x4*)(gt + ci); const f32x4 gs = *(const f32x4*)(gsrc + ci); rgv[bj][n] = (f32x4){1.0f / gs[0], 1.0f / gs[1], 1.0f / gs[2], 1.0f / gs[3]}; }
#pragma unroll
        for (int ai = 0; ai < 2; ++ai) { f32x4 RA[4], RB[4];
#pragma unroll
            for (int m = 0; m < 4; ++m) ld_lines16_raw(xsrc_b + (size_t)(u.pm * BM + ai * HALF + wr * 64 + m * 16) * DM + col0, DM, lo, fr7, RA[m], RB[m]);
#pragma unroll
            for (int m = 0; m < 4; ++m) { float q = 0.f;
                u32x4 h0, h1; lines16_fix(lo, RA[m], RB[m], h0, h1); f32x4 xs[2][2]; unpack8(h0, xs[0][0], xs[0][1]); unpack8(h1, xs[1][0], xs[1][1]);
#pragma unroll
                for (int bj = 0; bj < 2; ++bj) { const f32x4 x0 = xs[bj][0] * rgv[bj][0], x1 = xs[bj][1] * rgv[bj][1];
                    const f32x4 v0 = x0 + gv[bj][0] * acc[ai][bj][m][0], v1 = x1 + gv[bj][1] * acc[ai][bj][m][1]; xn[ai][bj][m][0] = v0; xn[ai][bj][m][1] = v1;
                    q += ((v0[0] * v0[0] + v0[1] * v0[1]) + (v0[2] * v0[2] + v0[3] * v0[3])) + ((v1[0] * v1[0] + v1[1] * v1[1]) + (v1[2] * v1[2] + v1[3] * v1[3]));
                    asm volatile("" : "+v"(xn[ai][bj][m][0]), "+v"(xn[ai][bj][m][1]), "+v"(q) :: "memory"); }
                q += __shfl_xor(q, 16); q += __shfl_xor(q, 32); if (fq == 0) P[(ai * HALF + wr * 64 + m * 16 + fr) * 4 + wc] = q; } }
        asm volatile("s_waitcnt lgkmcnt(0)" ::: "memory"); __builtin_amdgcn_s_barrier(); asm volatile("" ::: "memory");
        const int t = wid * 64 + lane;
        if (t < 256) {
            const float s = (P[t * 4 + 0] + P[t * 4 + 1]) + (P[t * 4 + 2] + P[t * 4 + 3]);
            unsigned* w0 = fss + (size_t)u.pm * BM + t;
            __hip_atomic_store(w0 + (size_t)u.pn * M, __float_as_uint(-s), __ATOMIC_RELAXED, __HIP_MEMORY_SCOPE_AGENT);
            unsigned wv[8]; unsigned spins = 0;
            for (;;) { bool ok = true;
#pragma unroll
                for (int j = 0; j < 8; ++j) { wv[j] = __hip_atomic_load(w0 + (size_t)j * M, __ATOMIC_RELAXED, __HIP_MEMORY_SCOPE_AGENT); ok = ok && (wv[j] >> 31); }
                if (__all(ok) || ++spins > (1u << 20)) break;
                __builtin_amdgcn_s_sleep(4); }
            float tot = 0.f;
#pragma unroll
            for (int j = 0; j < 8; ++j) tot += -__uint_as_float(wv[j]);
            P[1024 + t] = __builtin_amdgcn_rsqf(tot * (1.0f / DM) + EPS);
        }
        asm volatile("s_waitcnt lgkmcnt(0)" ::: "memory"); __builtin_amdgcn_s_barrier(); asm volatile("" ::: "memory");
        f32x4 fv[2][2];
#pragma unroll
        for (int bj = 0; bj < 2; ++bj)
#pragma unroll
            for (int n = 0; n < 2; ++n) fv[bj][n] = *(const f32x4*)(fg + col0 + 32 * bj + 4 * n);
#pragma unroll
        for (int ai = 0; ai < 2; ++ai)
#pragma unroll
            for (int m = 0; m < 4; ++m) { const size_t goff = (size_t)(u.pm * BM + ai * HALF + wr * 64 + m * 16) * DM + col0; const float rs = P[1024 + ai * HALF + wr * 64 + m * 16 + fr];
#pragma unroll
                for (int bj = 0; bj < 2; ++bj) st_lines(out + goff + 32 * bj, DM, lo, fr7, xn[ai][bj][m][0] * rs * fv[bj][0], xn[ai][bj][m][1] * rs * fv[bj][1], 4);
                asm volatile("" ::: "memory"); }
    }
};

template <bool PREV> __device__ __forceinline__ f32x4 conv_taps(const f32x4 c, const f32x4 uu, const f32x4 pu, const f32x4 w1, const f32x4 w0) {
    float c0 = c[0], c1 = c[1], c2 = c[2], c3 = c[3];
    asm("s_nop 1\n\t"
        "v_fmac_f32_dpp %0, %4, %8 row_shr:1 row_mask:0xf bank_mask:0xf\n\t"
        "v_fmac_f32_dpp %1, %5, %9 row_shr:1 row_mask:0xf bank_mask:0xf\n\t"
        "v_fmac_f32_dpp %2, %6, %10 row_shr:1 row_mask:0xf bank_mask:0xf\n\t"
        "v_fmac_f32_dpp %3, %7, %11 row_shr:1 row_mask:0xf bank_mask:0xf\n\t"
        "v_fmac_f32_dpp %0, %4, %12 row_shr:2 row_mask:0xf bank_mask:0xf\n\t"
        "v_fmac_f32_dpp %1, %5, %13 row_shr:2 row_mask:0xf bank_mask:0xf\n\t"
        "v_fmac_f32_dpp %2, %6, %14 row_shr:2 row_mask:0xf bank_mask:0xf\n\t"
        "v_fmac_f32_dpp %3, %7, %15 row_shr:2 row_mask:0xf bank_mask:0xf"
        : "+v"(c0), "+v"(c1), "+v"(c2), "+v"(c3)
        : "v"(uu[0]), "v"(uu[1]), "v"(uu[2]), "v"(uu[3]), "v"(w1[0]), "v"(w1[1]), "v"(w1[2]), "v"(w1[3]), "v"(w0[0]), "v"(w0[1]), "v"(w0[2]), "v"(w0[3]));
    if constexpr (PREV) {
        asm("s_nop 1\n\t"
            "v_fmac_f32_dpp %0, %4, %8 row_shl:15 row_mask:0xf bank_mask:0xf\n\t"
            "v_fmac_f32_dpp %1, %5, %9 row_shl:15 row_mask:0xf bank_mask:0xf\n\t"
            "v_fmac_f32_dpp %2, %6, %10 row_shl:15 row_mask:0xf bank_mask:0xf\n\t"
            "v_fmac_f32_dpp %3, %7, %11 row_shl:15 row_mask:0xf bank_mask:0xf\n\t"
            "v_fmac_f32_dpp %0, %4, %12 row_shl:14 row_mask:0xf bank_mask:0xf\n\t"
            "v_fmac_f32_dpp %1, %5, %13 row_shl:14 row_mask:0xf bank_mask:0xf\n\t"
            "v_fmac_f32_dpp %2, %6, %14 row_shl:14 row_mask:0xf bank_mask:0xf\n\t"
            "v_fmac_f32_dpp %3, %7, %15 row_shl:14 row_mask:0xf bank_mask:0xf"
            : "+v"(c0), "+v"(c1), "+v"(c2), "+v"(c3)
            : "v"(pu[0]), "v"(pu[1]), "v"(pu[2]), "v"(pu[3]), "v"(w1[0]), "v"(w1[1]), "v"(w1[2]), "v"(w1[3]), "v"(w0[0]), "v"(w0[1]), "v"(w0[2]), "v"(w0[3]));
    }
    return (f32x4){c0, c1, c2, c3};
}
struct EpiUp {
    static constexpr int PERM = 1; static constexpr bool AFTER_DRAIN = false, MIDK = false;
    const LAS float* tab; const LAS float* btab; const float* cw; const float* cbias; bf16_t* act; float* uh; int midk_t;
    __device__ __forceinline__ void mid(Acc&, const Unit&, int, int, int, int) const {}
    __device__ __forceinline__ void operator()(const Acc& acc, const Unit& u, int ui, int wr, int wc, int fr, int fq) const {
        { int t_ = threadIdx.x; asm volatile("" : "+v"(t_)); fr = t_ & 15; fq = (t_ >> 4) & 3; }
        const int b = u.pm >> 4, lc0 = wc * 32 + 8 * fq;
        const LAS float* rtab = tab + ui * 256 + wr * 64 + fr;
        u32x2 keep[2][4];
#pragma unroll
        for (int n = 0; n < 2; ++n) {
            const int lc = lc0 + 4 * n, ca = u.pn * HALF + lc;
            f32x4 w0[2], w1[2], w2[2], cb[2], bv[2];
#pragma unroll
            for (int bj = 0; bj < 2; ++bj) { const int nc = bj * DFF + ca;
                w0[bj] = *(const f32x4*)(cw + nc); w1[bj] = *(const f32x4*)(cw + DUP + nc); w2[bj] = *(const f32x4*)(cw + 2 * DUP + nc); cb[bj] = *(const f32x4*)(cbias + nc);
                bv[bj] = *(const LAS f32x4*)(btab + ui * 256 + bj * HALF + lc); }
#pragma unroll
            for (int ai = 0; ai < 2; ++ai) {
                const int rbase = u.pm * BM + ai * HALF + wr * 64, sb = rbase >> 6;
                f32x4 pu[2] = {(f32x4){0.f, 0.f, 0.f, 0.f}, (f32x4){0.f, 0.f, 0.f, 0.f}};
#pragma unroll
                for (int m = 0; m < 4; ++m) { const int row = rbase + m * 16 + fr; const float rs = rtab[ai * HALF + m * 16];
                    f32x4 cv[2];
#pragma unroll
                    for (int bj = 0; bj < 2; ++bj) { const f32x4 uu = acc[ai][bj][m][n] * rs + bv[bj];
                        if (m == 0 && fr < 2) *(f32x4*)(uh + ((size_t)sb * 4 + fr) * DUP + u.pn * BM + bj * HALF + lc) = uu;
                        if (m == 3 && fr >= 14) *(f32x4*)(uh + ((size_t)sb * 4 + 2 + (fr - 14)) * DUP + u.pn * BM + bj * HALF + lc) = uu;
                        const f32x4 c = cb[bj] + w2[bj] * uu;
                        cv[bj] = m == 0 ? conv_taps<false>(c, uu, uu, w1[bj], w0[bj]) : conv_taps<true>(c, uu, pu[bj], w1[bj], w0[bj]); pu[bj] = uu; }
                    f32x4 o;
#pragma unroll
                    for (int i = 0; i < 4; ++i) o[i] = cv[0][i] * sigmoid_f(cv[0][i]) * cv[1][i];
                    { u32x2 w; w.x = cvt_pk_bf16(o[0], o[1]); w.y = cvt_pk_bf16(o[2], o[3]);
                      if (n == 0) keep[ai][m] = w; else if (!(m == 0 && fr < 2)) { u32x4 w4; w4.x = keep[ai][m].x; w4.y = keep[ai][m].y; w4.z = w.x; w4.w = w.y; *(u32x4*)(act + (size_t)(rbase + m * 16 + (fr & 7) + 8 * (wc & 1)) * DFF + u.pn * HALF + 64 * (wc >> 1) + 32 * (fr >> 3) + 8 * fq) = w4; } }
                    asm volatile("" ::: "memory"); }
            }
        }
    }
};
}

constexpr int PTR_OFF = RING_BYTES + 512;
__device__ __forceinline__ unsigned long long lds_ptr(LAS unsigned char* lds, int i) {
    const volatile LAS unsigned* p = (const volatile LAS unsigned*)(lds + PTR_OFF) + 2 * i;
    const unsigned lo = __builtin_amdgcn_readfirstlane(p[0]), hi = __builtin_amdgcn_readfirstlane(p[1]);
    return ((unsigned long long)hi << 32) | lo;
}

#define XB_TMO      128
#define XB_XCNT(j)  (256  + 64 * (j))
#define XB_XSUB(j)  (1280 + 64 * (j))
#define XB_XGEN(j)  (2304 + 64 * (j))
#define XB_TOP      3328
#define XB_TOPGEN   3392
#define XCD_BAR_WORDS 3456
#define XB_SPIN_CAP (1u << 18)
__device__ __forceinline__ unsigned xb_ld(unsigned* p)              { return __hip_atomic_load(p, __ATOMIC_RELAXED, __HIP_MEMORY_SCOPE_AGENT); }
__device__ __forceinline__ unsigned xb_add(unsigned* p, unsigned v) { return __hip_atomic_fetch_add(p, v, __ATOMIC_RELAXED, __HIP_MEMORY_SCOPE_AGENT); }
__device__ __forceinline__ unsigned xb_xcc_id() { return (unsigned)__builtin_amdgcn_s_getreg((3 << 11) | 20) & 0xFu; }
#define XB_SPIN(cond, bar) do { unsigned _sp = 0; while (cond) { __builtin_amdgcn_s_sleep(1); \
    if ((++_sp & 255u) == 0u) { if (xb_ld(&(bar)[XB_TMO])) break; if (_sp > XB_SPIN_CAP) { atomicAdd(&(bar)[XB_TMO], 1u); break; } } } } while (0)
struct XcdBarrier { unsigned* bar; unsigned x; volatile LAS unsigned* st; };
__device__ __forceinline__ XcdBarrier xcd_barrier_post(unsigned* bar, volatile LAS unsigned* st) {
    XcdBarrier b; b.bar = bar; b.x = xb_xcc_id(); b.st = st;
    if (threadIdx.x == 0) (void)xb_add(&bar[XB_XCNT(b.x)], 1u);
    return b;
}
__device__ __forceinline__ void xcd_barrier_complete(unsigned* bar, unsigned x, unsigned& nloc, unsigned& nx) {
    const unsigned G = gridDim.x * gridDim.y * gridDim.z;
    unsigned sum, cnt, mine, sp = 0u;
    for (;;) {
        sum = 0u; cnt = 0u; mine = 0u;
#pragma unroll
        for (unsigned j = 0; j < 16; ++j) { const unsigned c = xb_ld(&bar[XB_XCNT(j)]); sum += c; cnt += (c > 0u) ? 1u : 0u; mine = (j == x) ? c : mine; }
        if (sum == G) break;
        __builtin_amdgcn_s_sleep(1);
        if ((++sp & 255u) == 0u) { if (xb_ld(&bar[XB_TMO])) break; if (sp > XB_SPIN_CAP) { atomicAdd(&bar[XB_TMO], 1u); break; } }
    }
    nloc = mine > 0u ? mine : 1u; nx = cnt > 0u ? cnt : 1u;
}
__device__ __forceinline__ void xcd_barrier(LAS unsigned char* lds) {
    asm volatile("s_waitcnt vmcnt(0)" ::: "memory");
    __syncthreads();
    if (threadIdx.x == 0) {
        XcdBarrier b; b.bar = (unsigned*)(lds_ptr(lds, 27) + WS_CTL) + CW_BAR; b.x = xb_xcc_id(); b.st = (volatile LAS unsigned*)(lds + MISC_OFF) + 8;
        unsigned* bar = b.bar; unsigned bx_ = b.x;
        asm volatile("" : "+v"(bar), "+s"(bx_));
        __builtin_amdgcn_s_waitcnt(0);
        unsigned nloc = b.st[0], nx = b.st[1];
        if (nloc == 0u) { xcd_barrier_complete(bar, bx_, nloc, nx); b.st[0] = nloc; b.st[1] = nx; }
        const unsigned old = xb_add(&bar[XB_XSUB(bx_)], 1u);
        const unsigned gen = old / nloc;
        if (old + 1u == (gen + 1u) * nloc) {
            __builtin_amdgcn_fence(__ATOMIC_RELEASE, "agent");
            asm volatile("s_waitcnt vmcnt(0)" ::: "memory");
            const unsigned og = xb_add(&bar[XB_TOP], 1u);
            const unsigned tg = og / nx;
            if (og + 1u == (tg + 1u) * nx) xb_add(&bar[XB_TOPGEN], 1u);
            else XB_SPIN(xb_ld(&bar[XB_TOPGEN]) == tg, bar);
            __builtin_amdgcn_fence(__ATOMIC_ACQUIRE, "agent");
            xb_add(&bar[XB_XGEN(bx_)], 1u);
            asm volatile("s_waitcnt vmcnt(0)" ::: "memory");
        } else {
            XB_SPIN(xb_ld(&bar[XB_XGEN(bx_)]) == gen, bar);
            __builtin_amdgcn_fence(__ATOMIC_ACQUIRE, "agent");
            asm volatile("s_waitcnt vmcnt(0)" ::: "memory");
        }
    }
    __syncthreads();
}

struct Args { const float* in[26]; float* out; unsigned char* ws; int ph_lo, ph_hi; };
enum { I_X = 0, I_C, I_ADAW, I_ADAB, I_NMG, I_WIN, I_BIN, I_CONVW, I_CONVB, I_WA, I_BA, I_WX, I_BX, I_LAM, I_POOLW, I_POOLB, I_POOLS, I_PROJA, I_PROJB, I_WOUT, I_NFG, I_WUP, I_FCW, I_FCB, I_WDOWN, I_FING };

template <bool BIAS>
__device__ __forceinline__ void cvt_item(const float* src, int N, bf16_t* dst, int dpitch, int k0, int n0, int drow0, int dcol, int lane,
                                         const float* sh0 = nullptr, const float* sh1 = nullptr, float* bias0 = nullptr, float* bias1 = nullptr, const float* binit = nullptr, int dstep = 32, const float* shm = nullptr) {
    const int r = lane >> 3, q = lane & 7;
    f32x4 s0 = (f32x4){0.f, 0.f, 0.f, 0.f}, s1 = s0, t0 = s0, t1 = s0;
    f32x4 vv[2][8];
#pragma unroll
    for (int c = 0; c < 2; ++c)
#pragma unroll
        for (int j = 0; j < 8; ++j) vv[c][j] = __builtin_nontemporal_load((const f32x4*)(src + (size_t)(k0 + 8 * r + j) * N + n0 + 32 * c + 4 * q));
    if constexpr (BIAS) {
        const int kk = k0 + 8 * r; f32x4 a0 = *(const f32x4*)(sh0 + kk), a1 = *(const f32x4*)(sh0 + kk + 4), b0 = *(const f32x4*)(sh1 + kk), b1 = *(const f32x4*)(sh1 + kk + 4);
        if (shm) { const f32x4 m0 = *(const f32x4*)(shm + kk), m1 = *(const f32x4*)(shm + kk + 4); a0 *= m0; a1 *= m1; b0 *= m0; b1 *= m1; }
#pragma unroll
        for (int j = 0; j < 4; ++j) { s0 += a0[j] * vv[0][j] + a1[j] * vv[0][4 + j]; s1 += b0[j] * vv[0][j] + b1[j] * vv[0][4 + j]; t0 += a0[j] * vv[1][j] + a1[j] * vv[1][4 + j]; t1 += b0[j] * vv[1][j] + b1[j] * vv[1][4 + j]; }
    }
#pragma unroll
    for (int c = 0; c < 2; ++c) {
        const f32x4 (&v)[8] = vv[c];
#pragma unroll
        for (int i = 0; i < 4; ++i) { u32x4 w; w.x = cvt_pk_bf16(v[0][i], v[1][i]); w.y = cvt_pk_bf16(v[2][i], v[3][i]); w.z = cvt_pk_bf16(v[4][i], v[5][i]); w.w = cvt_pk_bf16(v[6][i], v[7][i]);
            *(u32x4*)(dst + (size_t)(drow0 + dstep * c + 4 * q + i) * dpitch + dcol + k0 + 8 * r) = w; }
    }
    if constexpr (BIAS) {
        const int ii = r & 3, cc = r >> 2, col = 32 * cc + 4 * q + ii;
        f32x4 k0 = cc ? t0 : s0, x0 = cc ? s0 : t0, k1 = cc ? t1 : s1, x1 = cc ? s1 : t1;
#pragma unroll
        for (int i = 0; i < 4; ++i) { k0[i] += __shfl_xor(x0[i], 32); k1[i] += __shfl_xor(x1[i], 32); }
        const bool h1 = (r & 2) != 0, h0 = (r & 1) != 0;
        float a0 = h1 ? k0[2] : k0[0], a1 = h1 ? k0[3] : k0[1], b0 = h1 ? k1[2] : k1[0], b1 = h1 ? k1[3] : k1[1];
        const float xa0 = h1 ? k0[0] : k0[2], xa1 = h1 ? k0[1] : k0[3], xb0 = h1 ? k1[0] : k1[2], xb1 = h1 ? k1[1] : k1[3];
        a0 += __shfl_xor(xa0, 16); a1 += __shfl_xor(xa1, 16); b0 += __shfl_xor(xb0, 16); b1 += __shfl_xor(xb1, 16);
        float v0 = h0 ? a1 : a0, v1 = h0 ? b1 : b0;
        v0 += __shfl_xor(h0 ? a0 : a1, 8); v1 += __shfl_xor(h0 ? b0 : b1, 8);
        if (binit) { const float bi = binit[n0 + col]; v0 += bi; v1 += bi; }
        const int brow = drow0 + dstep * cc + 4 * q + ii;
        bias0[brow] = v0; bias1[brow] = v1;
    }
}
constexpr int IT_WIN = (DM / 64) * (DIN / 64), IT_LRU = 16 * 16, IT_POOL = 4 * 16, IT_PA = 32 * 32, IT_PB = 16 * 32, IT_WO = 32 * 32, IT_WUP = 32 * (DUP / 64), IT_WD = (DFF / 64) * 32;
constexpr int IT_LAYER = IT_WIN + IT_PB + IT_LRU + IT_PA + IT_WO + IT_WUP + IT_WD;
__device__ __forceinline__ void cvt_one(const Args& a, int it, int lane) {
    const float* mod = (const float*)(a.ws + WS_MOD);
    {
        const int l = it / IT_LAYER; int r = it % IT_LAYER;
        bf16_t* wl = (bf16_t*)(a.ws + WS_W + (size_t)l * W_LAYER);
        const float* sh = mod + (size_t)l * NB * NADA;
        if (r < IT_WIN) { const int kb = r / (DIN / 64), nb = r % (DIN / 64), n0 = 64 * nb; int drow = n0;
            int dstep = 32;
            if (n0 >= 5120) { const int gsel = n0 - 5120, isb = gsel / 2048, ch = gsel % 2048; drow = 5120 + 256 * (ch / 128) + 64 * ((ch % 128) / 32) + 32 * isb; dstep = 64; }
            float* bo = (float*)(a.ws + WS_PB1) + ((size_t)(l * NB) * 32 + kb) * DIN;
            cvt_item<true>(a.in[I_WIN] + (size_t)l * DM * DIN, DIN, wl + W_BT1 / 2, DM, 64 * kb, n0, drow, 0, lane, sh, sh + NADA, bo, bo + (size_t)32 * DIN, kb == 0 ? a.in[I_BIN] + (size_t)l * DIN : nullptr, dstep); return; } r -= IT_WIN;
        if (r < IT_PB) { const int kb = r / 32, nb = r % 32;
            float* bo = (float*)(a.ws + WS_PB3) + ((size_t)(l * 2) * 16 + kb) * DM;
            cvt_item<true>(a.in[I_PROJB] + (size_t)l * DPOOL * DM, DM, wl + W_BT3 / 2, 3072, 64 * kb, 64 * nb, 64 * nb, 2048, lane, a.in[I_POOLB] + (size_t)l * DPOOL, a.in[I_POOLB] + (size_t)l * DPOOL, bo, bo + (size_t)16 * DM, nullptr, 32, a.in[I_POOLS] + (size_t)l * DPOOL); return; } r -= IT_PB;
        if (r < IT_LRU) { const int mat = r / 16, idx = r % 16, isx = mat / 8, h = mat % 8, kb = idx / 4, nb = idx % 4, n0 = 64 * nb;
            const float* src = a.in[isx ? I_WX : I_WA] + ((size_t)l * 8 + h) * 256 * 256;
            cvt_item<false>(src, 256, wl + W_BTG / 2, 256, 64 * kb, n0, 512 * h + 256 * (n0 / 128) + 64 * ((n0 % 128) / 32) + 32 * isx, 0, lane, nullptr, nullptr, nullptr, nullptr, nullptr, 64); return; } r -= IT_LRU;
        if (r < IT_PA) { const int kb = r / 32, nb = r % 32; cvt_item<false>(a.in[I_PROJA] + (size_t)l * DRNN * DM, DM, wl + W_BT3 / 2, 3072, 64 * kb, 64 * nb, 64 * nb, 0, lane); return; } r -= IT_PA;
        if (r < IT_WO) { const int kb = r / 32, nb = r % 32; cvt_item<false>(a.in[I_WOUT] + (size_t)l * DM * DM, DM, wl + W_BT4 / 2, DM, 64 * kb, 64 * nb, 64 * nb, 0, lane); return; } r -= IT_WO;
        if (r < IT_WUP) { const int kb = r / (DUP / 64), nb = r % (DUP / 64), n0 = 64 * nb, isl = n0 / DFF, ch = n0 % DFF;
            float* bo = (float*)(a.ws + WS_PB2) + ((size_t)(l * NB) * 32 + kb) * DUP;
            cvt_item<true>(a.in[I_WUP] + (size_t)l * DM * DUP, DUP, wl + W_BT5 / 2, DM, 64 * kb, n0, 256 * (ch / 128) + 128 * isl + (ch % 128), 0, lane, sh + 3 * DM, sh + NADA + 3 * DM, bo, bo + (size_t)32 * DUP, nullptr); return; } r -= IT_WUP;
        { const int kb = r / 32, nb = r % 32; cvt_item<false>(a.in[I_WDOWN] + (size_t)l * DFF * DM, DM, wl + W_BT6 / 2, DFF, 64 * kb, 64 * nb, 64 * nb, 0, lane); }
    }
}
__device__ __forceinline__ void p0_convert(const Args& a, int lo, int hi, int widx, int nw, int lane, unsigned* cnt = nullptr, int shard = 0) {
    if (cnt == nullptr) { for (int it = lo + widx; it < hi; it += nw) cvt_one(a, it, lane); return; }
    const int per = (hi - lo + 7) / 8, slo = lo + shard * per, shi = (slo + per < hi) ? slo + per : hi;
    unsigned base = 0; if (lane == 0) base = atomicAdd(cnt + 64 * shard, 2u);
    for (;;) {
        const int it0 = slo + (int)__builtin_amdgcn_readfirstlane(base);
        if (it0 >= shi) break;
        unsigned nbase = 0; if (lane == 0) nbase = atomicAdd(cnt + 64 * shard, 2u);
        cvt_one(a, it0, lane); if (it0 + 1 < shi) cvt_one(a, it0 + 1, lane);
        base = nbase;
    }
}
constexpr int CVT_A_LO = 0, CVT_A_HI = IT_WIN + IT_PB;
__host__ __device__ constexpr int cvt_b_lo(int l) { return l * IT_LAYER + IT_WIN + IT_PB; }
__host__ __device__ constexpr int cvt_b_hi(int l) { return (l + 1) * IT_LAYER - IT_WD; }
__host__ __device__ constexpr int cvt_c_lo(int l) { return (l + 1) * IT_LAYER - IT_WD; }
__host__ __device__ constexpr int cvt_c_hi(int l) { return l + 1 < NL ? (l + 1) * IT_LAYER + IT_WIN : (l + 1) * IT_LAYER; }
__device__ __forceinline__ void p0_ada(const Args& a, LAS unsigned char* lds, int G, int tid, int bx) {
    const int wave = tid >> 6, lane = tid & 63;
    LAS float* cact = (LAS float*)lds;
    LAS float* red = (LAS float*)(lds + 16384);
    for (int i = tid; i < NB * DM; i += 512) { const float v = a.in[I_C][i]; cact[i] = v * sigmoid_f(v); }
    __syncthreads();
    float* mod = (float*)(a.ws + WS_MOD);
    for (int un = bx; un < NL * (NADA / 32); un += G) {
        const int l = un / (NADA / 32), nb = un % (NADA / 32);
        const float* wsrc = a.in[I_ADAW] + (size_t)l * DM * NADA + nb * 32 + 4 * (lane & 7);
        f32x4 s0 = (f32x4){0.f, 0.f, 0.f, 0.f}, s1 = s0;
#pragma unroll 4
        for (int rg = wave; rg < 256; rg += 8) { const int k = rg * 8 + (lane >> 3); const f32x4 wv = __builtin_nontemporal_load((const f32x4*)(wsrc + (size_t)k * NADA)); s0 += cact[k] * wv; s1 += cact[DM + k] * wv; }
#pragma unroll
        for (int i = 0; i < 4; ++i) {
#pragma unroll
            for (int o = 8; o < 64; o <<= 1) { s0[i] += __shfl_xor(s0[i], o); s1[i] += __shfl_xor(s1[i], o); } }
        if (lane < 8) {
#pragma unroll
            for (int i = 0; i < 4; ++i) { red[(wave * 2 + 0) * 32 + 4 * lane + i] = s0[i]; red[(wave * 2 + 1) * 32 + 4 * lane + i] = s1[i]; } }
        __syncthreads();
        if (tid < 64) { const int b = tid >> 5, c = tid & 31; float s = 0.f;
#pragma unroll
            for (int w = 0; w < 8; ++w) s += red[(w * 2 + b) * 32 + c];
            mod[((size_t)l * NB + b) * NADA + nb * 32 + c] = s + a.in[I_ADAB][(size_t)l * NADA + nb * 32 + c]; }
        __syncthreads();
    }
}

__device__ __forceinline__ void p0b(const Args& a, int gw, int ngw, int lane, int gtid, int ngt) {
    const float* mod = (const float*)(a.ws + WS_MOD);
    for (int i = gtid; i < NL * NB * DM; i += ngt) { const int l = i / (NB * DM), b = (i / DM) % NB, c = i % DM; const float* mm = mod + ((size_t)l * NB + b) * NADA;
        ((float*)(a.ws + WS_GM1))[i] = a.in[I_NMG][l * DM + c] * (1.f + mm[DM + c]);
        ((float*)(a.ws + WS_GT1))[i] = mm[2 * DM + c];
        ((float*)(a.ws + WS_GM2))[i] = a.in[I_NFG][l * DM + c] * (1.f + mm[4 * DM + c]);
        ((float*)(a.ws + WS_GT2))[i] = mm[5 * DM + c]; }
    for (int i = gtid; i < NL * DRNN; i += ngt) { const float lam = a.in[I_LAM][i]; ((float*)(a.ws + WS_LRUK))[i] = -8.0f * log1pf(expf(-lam)); }
    p0_convert(a, CVT_A_LO, CVT_A_HI, gw, ngw, lane);
    for (int l = 1; l < NL; ++l) p0_convert(a, l * IT_LAYER + IT_WIN, l * IT_LAYER + IT_WIN + IT_PB, gw, ngw, lane);
    for (int i = gtid; i < NL * 4 * 256 * 256 / 4; i += ngt) { const int e = 4 * i, l = e / (4 * 65536), g = (e >> 16) & 3, j = e & 255;
        const f32x4 w = *(const f32x4*)(a.in[I_POOLW] + e) * *(const f32x4*)(a.in[I_POOLS] + (size_t)l * DPOOL + g * 256 + j);
        u32x2 pk; pk.x = cvt_pk_bf16(w[0], w[1]); pk.y = cvt_pk_bf16(w[2], w[3]);
        *(u32x2*)((bf16_t*)(a.ws + WS_W + (size_t)l * W_LAYER + W_BTP) + (e & (4 * 65536 - 1))) = pk; }
    float* ss = (float*)(a.ws + WS_SS); bf16_t* xg = (bf16_t*)(a.ws + WS_XG);
    for (int row = gw; row < M; row += ngw) { const int b = row / SEQ; const float* xr = a.in[I_X] + (size_t)row * DM; const float* mm = mod + (size_t)b * NADA + DM; float s = 0.f;
#pragma unroll
        for (int j = 0; j < 8; ++j) { const int c = (j * 64 + lane) * 4; const f32x4 xv = __builtin_nontemporal_load((const f32x4*)(xr + c)), gv = *(const f32x4*)(a.in[I_NMG] + c), sc = *(const f32x4*)(mm + c);
            s += (xv[0] * xv[0] + xv[1] * xv[1]) + (xv[2] * xv[2] + xv[3] * xv[3]); const f32x4 y = xv * (gv * (1.f + sc));
            u32x2 w; w.x = cvt_pk_bf16(y[0], y[1]); w.y = cvt_pk_bf16(y[2], y[3]); *(u32x2*)(xg + (size_t)row * DM + c) = w; }
        s = wave_sum(s);
        if (lane < 8) ss[(size_t)lane * M + row] = lane == 0 ? s : 0.f; }
}

__device__ __forceinline__ void build_xr_tile(const Args& a, int l, int pm, int head, int tid) {
    const int strip = tid >> 5, c = head * 256 + (tid & 31) * 8, row0 = pm * 256 + strip * 16, t0 = row0 % SEQ;
    const float* cw = a.in[I_CONVW] + (size_t)l * 4 * DRNN + c; const float* cb = a.in[I_CONVB] + (size_t)l * DRNN + c;
    f32x4 w0[4], w1[4];
#pragma unroll
    for (int k = 0; k < 4; ++k) { w0[k] = *(const f32x4*)(cw + (size_t)k * DRNN); w1[k] = *(const f32x4*)(cw + (size_t)k * DRNN + 4); }
    const f32x4 b0 = *(const f32x4*)cb, b1 = *(const f32x4*)(cb + 4);
    const bf16_t* src = (const bf16_t*)(a.ws + WS_XRNN) + (size_t)row0 * DRNN + c; bf16_t* dst = (bf16_t*)(a.ws + WS_XR) + (size_t)row0 * DRNN + c;
    u32x4 wr_[19];
#pragma unroll
    for (int d = 0; d < 3; ++d) { wr_[d] = (u32x4){0u, 0u, 0u, 0u}; if (t0 >= 3 - d) wr_[d] = *(const u32x4*)(src - (size_t)(3 - d) * DRNN); }
#pragma unroll
    for (int j = 0; j < 16; ++j) wr_[3 + j] = *(const u32x4*)(src + (size_t)j * DRNN);
    f32x4 h0[3], h1[3];
#pragma unroll
    for (int d = 0; d < 3; ++d) pg8::unpack8(wr_[d], h0[d], h1[d]);
#pragma unroll
    for (int j = 0; j < 16; ++j) { const u32x4 w = wr_[3 + j]; f32x4 x0, x1; pg8::unpack8(w, x0, x1);
        const f32x4 o0 = b0 + w0[0] * h0[0] + w0[1] * h0[1] + w0[2] * h0[2] + w0[3] * x0, o1 = b1 + w1[0] * h1[0] + w1[1] * h1[1] + w1[2] * h1[2] + w1[3] * x1;
        *(u32x4*)(dst + (size_t)j * DRNN) = pg8::pack8(o0, o1);
        h0[0] = h0[1]; h0[1] = h0[2]; h0[2] = x0; h1[0] = h1[1]; h1[1] = h1[2]; h1[2] = x1; }
}
template <int WIN>
__device__ __forceinline__ void build_pp_rows(const bf16_t* src, bf16_t* dst, int t0) {
    u32x4 w[15 + WIN];
#pragma unroll
    for (int d = 0; d < WIN - 1; ++d) { w[d] = (u32x4){0u, 0u, 0u, 0u}; if (t0 >= WIN - 1 - d) w[d] = *(const u32x4*)(src - (size_t)(WIN - 1 - d) * DPOOL); }
#pragma unroll
    for (int j = 0; j < 16; ++j) w[WIN - 1 + j] = *(const u32x4*)(src + (size_t)j * DPOOL);
    f32x4 s0 = (f32x4){0.f, 0.f, 0.f, 0.f}, s1 = s0;
#pragma unroll
    for (int d = WIN - 2; d >= 0; --d) { f32x4 y0, y1; pg8::unpack8(w[d], y0, y1); s0 += y0; s1 += y1; }
#pragma unroll
    for (int j = 0; j < 16; ++j) { const int t = t0 + j; f32x4 x0, x1; pg8::unpack8(w[WIN - 1 + j], x0, x1); s0 += x0; s1 += x1;
        const float inv = 1.0f / (float)((t + 1 < WIN) ? t + 1 : WIN);
        *(u32x4*)(dst + (size_t)j * 3072) = pg8::pack8(s0 * inv - x0, s1 * inv - x1);
        { f32x4 y0, y1; pg8::unpack8(w[j], y0, y1); s0 -= y0; s1 -= y1; } }
}
__device__ __forceinline__ void build_pp_tile(const Args& a, int pm, int g, int tid) {
    const int strip = tid >> 5, c = g * 256 + (tid & 31) * 8, row0 = pm * 256 + strip * 16, t0 = row0 % SEQ;
    const bf16_t* src = (const bf16_t*)(a.ws + WS_XPOOL) + (size_t)row0 * DPOOL + c; bf16_t* dst = (bf16_t*)(a.ws + WS_YAB) + (size_t)row0 * 3072 + 2048 + c;
    if (g == 0) build_pp_rows<2>(src, dst, t0); else if (g == 1) build_pp_rows<4>(src, dst, t0); else if (g == 2) build_pp_rows<8>(src, dst, t0); else build_pp_rows<16>(src, dst, t0);
}

__device__ __forceinline__ void p5_fixup(const Args& a, int l, int gtid, int ngt) {
    const float* uh = (const float*)(a.ws + WS_UH); bf16_t* act = (bf16_t*)(a.ws + WS_ACT);
    const float* cw = a.in[I_FCW] + (size_t)l * 3 * DUP; const float* cb = a.in[I_FCB] + (size_t)l * DUP;
    constexpr int NQ = DFF / 4;
    for (int it = gtid; it < 128 * 2 * NQ; it += ngt) { const int ch = 4 * (it % NQ), r = (it / NQ) & 1, sb = it / (2 * NQ), row = 64 * sb + r;
        const int j = ch / 128, w = ch % 128; const bool edge = (sb % 64) == 0; f32x4 cv[2]; const f32x4 z4 = (f32x4){0.f, 0.f, 0.f, 0.f};
#pragma unroll
        for (int bj = 0; bj < 2; ++bj) { const int tc = 256 * j + 128 * bj + w, nc = bj * DFF + ch;
            const f32x4 u0 = *(const f32x4*)(uh + ((size_t)sb * 4 + r) * DUP + tc);
            f32x4 u1 = z4, u2 = z4;
            if (r == 1) { u1 = *(const f32x4*)(uh + ((size_t)sb * 4 + 0) * DUP + tc); if (!edge) u2 = *(const f32x4*)(uh + ((size_t)(sb - 1) * 4 + 3) * DUP + tc); }
            else if (!edge) { u1 = *(const f32x4*)(uh + ((size_t)(sb - 1) * 4 + 3) * DUP + tc); u2 = *(const f32x4*)(uh + ((size_t)(sb - 1) * 4 + 2) * DUP + tc); }
            cv[bj] = *(const f32x4*)(cb + nc) + *(const f32x4*)(cw + 2 * DUP + nc) * u0 + *(const f32x4*)(cw + DUP + nc) * u1 + *(const f32x4*)(cw + nc) * u2; }
        f32x4 o;
#pragma unroll
        for (int i = 0; i < 4; ++i) o[i] = cv[0][i] * sigmoid_f(cv[0][i]) * cv[1][i];
        u32x2 pk; pk.x = cvt_pk_bf16(o[0], o[1]); pk.y = cvt_pk_bf16(o[2], o[3]);
        *(u32x2*)(act + (size_t)(row + 8 * ((ch >> 5) & 1)) * DFF + (ch & ~32)) = pk; }
}

__device__ __forceinline__ void p_final(const Args& a, int gw, int ngw, int lane) {
    const float* X = (const float*)(a.ws + WS_X); const float* ss = (const float*)(a.ws + WS_SS);
    for (int row = gw; row < M; row += ngw) { const float rs = pg8::row_rstd(ss, row);
#pragma unroll
        for (int j = 0; j < 8; ++j) { const int c = (j * 64 + lane) * 4; *(f32x4*)(a.out + (size_t)row * DM + c) = *(const f32x4*)(X + (size_t)row * DM + c) * rs * *(const f32x4*)(a.in[I_FING] + c); } }
}

constexpr int PH_P0A = 0, PH_P0B = 1, PH_LAYER0 = 2, PH_PER_LAYER = 7, PH_FINAL = -1000, N_PHASES = PH_LAYER0 + NL * PH_PER_LAYER;
__host__ __device__ constexpr int phase_kind(int ph) {
    if (ph == PH_P0A) return 0; if (ph == PH_P0B) return 1; if (ph == PH_FINAL) return 11;
    const int sub = (ph - PH_LAYER0) % PH_PER_LAYER;
    return sub == 0 ? 2 : sub == 1 ? 4 : 4 + sub;
}
template <int KIND, bool DUMMY = false>
__device__ __forceinline__ void run_kind(int ph, LAS unsigned char* lds) {
    int tid = threadIdx.x, bx = blockIdx.x, G = gridDim.x; asm volatile("" : "+v"(tid), "+s"(bx), "+s"(G));
    const int lane = tid & 63, wave = __builtin_amdgcn_readfirstlane(tid >> 6);
    const int vcu = (G % 8 == 0) ? (bx % 8) * (G / 8) + bx / 8 : bx;
    const int gw = vcu * NWAVES + wave, ngw = G * NWAVES, gtid = bx * 512 + tid, ngt = G * 512;
    Args a;
#pragma unroll
    for (int i = 0; i < 26; ++i) a.in[i] = (const float*)(const __attribute__((address_space(1))) float*)lds_ptr(lds, i);
    a.out = (float*)(__attribute__((address_space(1))) float*)lds_ptr(lds, 26); a.ws = (unsigned char*)(__attribute__((address_space(1))) unsigned char*)lds_ptr(lds, 27);
    asm volatile("" : "+s"(ph));
    const int l = (ph - PH_LAYER0) / PH_PER_LAYER;
    const bf16_t* wl = (const bf16_t*)(a.ws + WS_W + (size_t)l * W_LAYER);
    const float* ss = (const float*)(a.ws + WS_SS);
    pg8::StaticOrder S;
    if constexpr (KIND == 0) { p0_ada(a, lds, G, tid, bx); }
    else if constexpr (KIND == 1) { p0b(a, gw, ngw, lane, gtid, ngt); }
    else if constexpr (KIND == 11) { p_final(a, gw, ngw, lane); }
    else if constexpr (KIND == 2) {
        const int GGm = (G == 256 && !DUMMY) ? P1_GEMM_WGS : G;
        pg8::Gemm g{(const bf16_t*)(a.ws + WS_XG), wl + W_BT1 / 2, DM, DM, DM / 64, M / 256, DIN / 256, 31, 0}; S.init(g.nM, g.nN, GGm, bx);
        if (bx < GGm) {
        pg8::fill_tabs(lds, S, ss, (const float*)(a.ws + WS_PB1) + (size_t)(l * NB) * 32 * DIN, DIN, tid);
        pg8::EpiZ E{(const LAS float*)(lds + pg8::TAB_OFF), (const LAS float*)(lds + pg8::BTAB_OFF), (bf16_t*)(a.ws + WS_XRNN), (bf16_t*)(a.ws + WS_GG), (bf16_t*)(a.ws + WS_XPOOL), (bf16_t*)(a.ws + WS_RATIO), -1};
        pg8::gemm_phase<pg8::EpiZ, true>(lds, g, S, E);
        }
        if (!DUMMY && l == 0 && bx >= GGm) {
            for (int ll = 0; ll < NL; ++ll) { const bf16_t* wll = (const bf16_t*)(a.ws + WS_W + (size_t)ll * W_LAYER);
                pg8::Gemm gw_{wll + W_BTP / 2, wll + W_BT3 / 2 + 2048, 256, 3072, 4, 4, 8, 31, 0}; gw_.b_pm = 512;
                pg8::StaticOrder Sw; Sw.init(gw_.nM, gw_.nN, G - GGm, bx - GGm);
                pg8::EpiWp Ew{(bf16_t*)(a.ws + WS_W + (size_t)ll * W_LAYER + W_BT3) + 2048, -1};
                pg8::gemm_phase<pg8::EpiWp, true>(lds, gw_, Sw, Ew); } }
        if (!DUMMY) p0_convert(a, cvt_b_lo(l), cvt_b_hi(l), gw, ngw, lane, (unsigned*)(a.ws + WS_CTL) + CW_CVT + 512 * (2 * l), bx & 7);
    } else if constexpr (KIND == 4) {
        { pg8::Gemm g{(const bf16_t*)(a.ws + WS_XR), wl + W_BTG / 2, DRNN, 256, 4, M / 256, 16, 1, 256}; pg8::GateOrder GO{bx};
          { pg8::Unit u; for (int i = 0; i < 2 && GO.next(i, u); ++i) build_xr_tile(a, l, u.pm, u.pn >> 1, tid); }
          asm volatile("s_waitcnt vmcnt(0)" ::: "memory"); __syncthreads();
          pg8::EpiGates E{a.in[I_BA] + (size_t)l * DRNN, a.in[I_BX] + (size_t)l * DRNN, (const float*)(a.ws + WS_LRUK) + (size_t)l * DRNN, (const bf16_t*)(a.ws + WS_XR), (const bf16_t*)(a.ws + WS_GG), (bf16_t*)(a.ws + WS_YAB),
                          (unsigned long long*)(a.ws + WS_AGG) + (size_t)l * NB * 16 * DRNN, lds, -1};
          pg8::gemm_phase<pg8::EpiGates, true, pg8::GateOrder>(lds, g, GO, E); }
    } else if constexpr (KIND == 12) {
        { S.init(M / 256, 4, G, bx); pg8::Unit u; for (int i = 0; i < 8 && S.next(i, u); ++i) build_pp_tile(a, u.pm, u.pn, tid); }
    } else if constexpr (KIND == 6) {
        pg8::Gemm g{(const bf16_t*)(a.ws + WS_YAB), wl + W_BT3 / 2, 3072, 3072, 48, M / 256, DM / 256, 31, 0}; S.init(g.nM, g.nN, G, bx);
        { pg8::Unit u0;
          if (S.next(0, u0) && tid < 256) { const float* p = (const float*)(a.ws + WS_PB3) + (size_t)(l * 2) * 16 * DM + u0.pn * 256 + tid; float s = 0.f;
#pragma unroll
              for (int kb = 0; kb < 16; ++kb) s += p[(size_t)kb * DM];
              ((LAS float*)(lds + pg8::TAB_OFF))[tid] = s; }
          __syncthreads(); }
        pg8::EpiMerge E{(const bf16_t*)(a.ws + WS_RATIO), (bf16_t*)(a.ws + WS_MERGED), (const LAS float*)(lds + pg8::TAB_OFF), 32};
        pg8::gemm_phase<pg8::EpiMerge, false>(lds, g, S, E);
    } else if constexpr (KIND == 7) {
        pg8::Gemm g{(const bf16_t*)(a.ws + WS_MERGED), wl + W_BT4 / 2, DM, DM, DM / 64, M / 256, DM / 256, 31, 0}; S.init(g.nM, g.nN, G, bx);
        const float* gt1 = (const float*)(a.ws + WS_GT1) + (size_t)l * NB * DM; const float* gm2 = (const float*)(a.ws + WS_GM2) + (size_t)l * NB * DM;
        if (l == 0) { pg8::EpiResid<true> E{a.in[I_X], nullptr, nullptr, (bf16_t*)(a.ws + WS_XG), gt1, gm2, (float*)(a.ws + WS_SS), -1}; pg8::gemm_phase<pg8::EpiResid<true>, false>(lds, g, S, E); }
        else { pg8::EpiResid<false> E{nullptr, (const bf16_t*)(a.ws + WS_XG), (const float*)(a.ws + WS_GM1) + (size_t)l * NB * DM, (bf16_t*)(a.ws + WS_XG), gt1, gm2, (float*)(a.ws + WS_SS), -1}; pg8::gemm_phase<pg8::EpiResid<false>, false>(lds, g, S, E); }
    } else if constexpr (KIND == 8) {
        const int GGm = (G == 256 && !DUMMY) ? P5_GEMM_WGS : G;
        pg8::Gemm g{(const bf16_t*)(a.ws + WS_XG), wl + W_BT5 / 2, DM, DM, DM / 64, M / 256, DUP / 256, 31, 0}; S.init(g.nM, g.nN, GGm, bx);
        if (bx < GGm) {
        pg8::fill_tabs(lds, S, ss, (const float*)(a.ws + WS_PB2) + (size_t)(l * NB) * 32 * DUP, DUP, tid);
        pg8::EpiUp E{(const LAS float*)(lds + pg8::TAB_OFF), (const LAS float*)(lds + pg8::BTAB_OFF), a.in[I_FCW] + (size_t)l * 3 * DUP, a.in[I_FCB] + (size_t)l * DUP, (bf16_t*)(a.ws + WS_ACT), (float*)(a.ws + WS_UH), -1};
        pg8::gemm_phase<pg8::EpiUp, true>(lds, g, S, E);
        }
        if (!DUMMY) p0_convert(a, cvt_c_lo(l), cvt_c_hi(l), gw, ngw, lane, (unsigned*)(a.ws + WS_CTL) + CW_CVT + 512 * (2 * l + 1), bx & 7);
    } else if constexpr (KIND == 9) { p5_fixup(a, l, gtid, ngt);
    } else {
        pg8::Gemm g{(const bf16_t*)(a.ws + WS_ACT), wl + W_BT6 / 2, DFF, DFF, DFF / 64, M / 256, DM / 256, 31, 0, 1}; S.init(g.nM, g.nN, G, bx);
        if (l == NL - 1 && !DUMMY) {
            pg8::EpiFinal E{(const bf16_t*)(a.ws + WS_XG), (const float*)(a.ws + WS_GM2) + (size_t)l * NB * DM, a.out, (const float*)(a.ws + WS_GT2) + (size_t)l * NB * DM, a.in[I_FING], (unsigned*)(a.ws + WS_FSS), -1};
            pg8::gemm_phase<pg8::EpiFinal, false>(lds, g, S, E);
        } else {
        pg8::EpiResid<false> E{nullptr, (const bf16_t*)(a.ws + WS_XG), (const float*)(a.ws + WS_GM2) + (size_t)l * NB * DM, (bf16_t*)(a.ws + (DUMMY ? WS_RATIO : WS_XG)), (const float*)(a.ws + WS_GT2) + (size_t)l * NB * DM,
                        (const float*)(a.ws + WS_GM1) + (size_t)(l + 1 < NL ? l + 1 : l) * NB * DM, (float*)(a.ws + (DUMMY ? WS_AGG : WS_SS)), -1};
        pg8::gemm_phase<pg8::EpiResid<false>, false>(lds, g, S, E);
        }
    }
}
#define MK_PROLOGUE \
    extern __shared__ __attribute__((aligned(16))) unsigned char lds_raw[]; \
    LAS unsigned char* lds = (LAS unsigned char*)lds_raw; \
    const int tid = threadIdx.x; \
    volatile LAS unsigned* MISC = (volatile LAS unsigned*)(lds + MISC_OFF); \
    for (int u = tid; u < (LDS_BYTES - RING_BYTES) / 4; u += 512) ((LAS unsigned*)(lds + RING_BYTES))[u] = 0u; \
    __syncthreads(); \
    if (tid == 0) { LAS unsigned long long* pt = (LAS unsigned long long*)(lds + PTR_OFF); \
        _Pragma("unroll") for (int i = 0; i < 26; ++i) pt[i] = (unsigned long long)a.in[i]; \
        pt[26] = (unsigned long long)a.out; pt[27] = (unsigned long long)a.ws; } \
    __syncthreads();

#if MK_ONE_LAUNCH
template <int PH> __device__ __forceinline__ void run_from(LAS unsigned char* lds) {
    if constexpr (PH < N_PHASES) {
        if constexpr (PH == PROBE_PH) { run_kind<phase_kind(PH), true>(PH, lds); if constexpr (phase_kind(PH) == 4) run_kind<12, true>(PH, lds); xcd_barrier(lds); }
        run_kind<phase_kind(PH)>(PH, lds);
        if constexpr (phase_kind(PH) == 4) run_kind<12>(PH, lds);
        if constexpr (PH + 1 < N_PHASES) xcd_barrier(lds);
        run_from<PH + 1>(lds);
    }
}
__global__ void __launch_bounds__(NWAVES * 64, 2) mk_fwd(Args a) {
    MK_PROLOGUE
    (void)xcd_barrier_post((unsigned*)(a.ws + WS_CTL) + CW_BAR, MISC + 8);
    run_from<0>(lds);
}
#else
template <int KIND>
__global__ void __launch_bounds__(NWAVES * 64, 2) mk_phase(Args a) {
    MK_PROLOGUE
    (void)MISC;
    run_kind<KIND>(a.ph_lo, lds);
}
#endif

#if !MK_ONE_LAUNCH
template <int KIND> static void launch_kind(int grid, hipStream_t stream, const Args& a) {
    static bool attr = false;
    if (!attr) { (void)hipFuncSetAttribute((const void*)mk_phase<KIND>, hipFuncAttributeMaxDynamicSharedMemorySize, LDS_BYTES); attr = true; }
    hipLaunchKernelGGL(mk_phase<KIND>, dim3(grid), dim3(NWAVES * 64), LDS_BYTES, stream, a);
}
#endif
extern "C" void kernel_launch(void* const* d_in, const int* in_sizes, int n_in, void* d_out, int out_size, void* d_ws, size_t ws_size, hipStream_t stream) {
    static int grid = 0;
    if (grid == 0) {
        if (n_in != 26 || out_size != M * DM || ws_size < WS_END) { fprintf(stderr, "kernel_launch: unexpected problem (n_in %d out %d ws %zu need %zu)\n", n_in, out_size, ws_size, (size_t)WS_END); grid = -1; return; }
        int dev = 0, cus = 0;
        if (hipGetDevice(&dev) != hipSuccess || hipDeviceGetAttribute(&cus, hipDeviceAttributeMultiprocessorCount, dev) != hipSuccess) { grid = -1; return; }
#if MK_ONE_LAUNCH
        if (hipFuncSetAttribute((const void*)mk_fwd, hipFuncAttributeMaxDynamicSharedMemorySize, LDS_BYTES) != hipSuccess) { fprintf(stderr, "kernel_launch: hipFuncSetAttribute failed\n"); grid = -1; return; }
#endif
        (void)hipGetLastError();
        grid = cus;
        if (grid != 256) fprintf(stderr, "kernel_launch: %d CUs; the residual GEMM phases need exactly 256 workgroups\n", grid);
    }
    if (grid < 0) return;
    (void)hipMemsetAsync((char*)d_ws + WS_CTL, 0, CTL_ZERO_BYTES, stream);
    Args a{};
    for (int i = 0; i < 26; ++i) a.in[i] = (const float*)d_in[i];
    a.out = (float*)d_out; a.ws = (unsigned char*)d_ws;
#if MK_ONE_LAUNCH
    a.ph_lo = 0; a.ph_hi = N_PHASES;
    hipLaunchKernelGGL(mk_fwd, dim3(grid), dim3(NWAVES * 64), LDS_BYTES, stream, a);
#else
    for (int ph = 0; ph < N_PHASES; ++ph) { a.ph_lo = ph; a.ph_hi = ph + 1;
        switch (phase_kind(ph)) {
            case 0: launch_kind<0>(grid, stream, a); break;  case 1: launch_kind<1>(grid, stream, a); break;  case 2: launch_kind<2>(grid, stream, a); break;
            case 4: launch_kind<4>(grid, stream, a); launch_kind<12>(grid, stream, a); break;
            case 6: launch_kind<6>(grid, stream, a); break;  case 7: launch_kind<7>(grid, stream, a); break;  case 8: launch_kind<8>(grid, stream, a); break;
            case 9: launch_kind<9>(grid, stream, a); break;  case 10: launch_kind<10>(grid, stream, a); break; default: launch_kind<11>(grid, stream, a); break;
        } }
#endif
}
```

```cpp
#include <hip/hip_runtime.h>
#include <cstdio>
#include <cstdint>

#ifndef PROBE_PH
#define PROBE_PH -1
#endif
#ifndef P1_GEMM_WGS
#define P1_GEMM_WGS 232
#endif
#ifndef P5_GEMM_WGS
#define P5_GEMM_WGS 240
#endif
#ifndef MK_ONE_LAUNCH
#define MK_ONE_LAUNCH 1
#endif

#define GAS __attribute__((address_space(1)))
#define LAS __attribute__((address_space(3)))
typedef unsigned short bf16_t;
typedef short bf16x8 __attribute__((ext_vector_type(8)));
typedef float f32x4 __attribute__((ext_vector_type(4)));
typedef float f32x2 __attribute__((ext_vector_type(2)));
typedef unsigned u32x4 __attribute__((ext_vector_type(4)));
typedef unsigned u32x2 __attribute__((ext_vector_type(2)));

constexpr int NB = 2, SEQ = 4096, DM = 2048, M = NB * SEQ, DRNN = 2048, DPOOL = 1024, DIN = 9216, DFF = 5632, DUP = 11264, NADA = 12288, NL = 2;
constexpr float EPS = 1e-6f;
constexpr int NWAVES = 8;
constexpr int LDS_BYTES = 147456;
constexpr int RING_BYTES = 131072;
constexpr int MISC_OFF = RING_BYTES + 320;

constexpr size_t MiB = 1u << 20;
constexpr size_t WS_CTL = 0, CTL_ZERO_BYTES = 4 * MiB;
constexpr size_t WS_MOD = 1 * MiB;
constexpr size_t WS_GM1 = WS_MOD + (size_t)NL * NB * NADA * 4;
constexpr size_t WS_GT1 = WS_GM1 + (size_t)NL * NB * DM * 4;
constexpr size_t WS_GM2 = WS_GT1 + (size_t)NL * NB * DM * 4;
constexpr size_t WS_GT2 = WS_GM2 + (size_t)NL * NB * DM * 4;
constexpr size_t WS_LRUK = WS_GT2 + (size_t)NL * NB * DM * 4;
constexpr size_t WS_BIAS1 = WS_LRUK + (size_t)NL * DRNN * 4;
constexpr size_t WS_BIAS2 = WS_BIAS1 + (size_t)NL * NB * DIN * 4;
constexpr size_t WS_SS = WS_BIAS2 + (size_t)NL * NB * DUP * 4;
static_assert(WS_SS + 8 * (size_t)M * 4 <= 2 * MiB, "small region");
constexpr size_t WS_AGG = 2 * MiB;
constexpr size_t WS_FSS = 3 * MiB;
constexpr size_t WS_W = 4 * MiB;
constexpr size_t W_BT1 = 0, W_BTG = 36 * MiB, W_BTP = 38 * MiB, W_BT3 = 39 * MiB, W_BT4 = 51 * MiB, W_BT5 = 59 * MiB, W_BT6 = 103 * MiB, W_LAYER = 125 * MiB;
static_assert((size_t)DIN * DM * 2 == 36 * MiB && (size_t)DUP * DM * 2 == 44 * MiB && (size_t)DM * DFF * 2 == 22 * MiB, "weight sizes");
constexpr size_t WS_X = WS_W + 2 * W_LAYER;
constexpr size_t WS_PB1 = WS_X;
constexpr size_t WS_PB2 = WS_X + 16 * MiB;
static_assert((size_t)NL * NB * 32 * DIN * 4 <= 16 * MiB && (size_t)NL * NB * 32 * DUP * 4 <= 16 * MiB, "partial bias rows");
constexpr size_t WS_PB3 = WS_X + 32 * MiB;
constexpr size_t WS_XG = WS_X + 64 * MiB;
constexpr size_t WS_XRNN = WS_XG + 32 * MiB;
constexpr size_t WS_GG = WS_XRNN + 32 * MiB;
constexpr size_t WS_XPOOL = WS_GG + 32 * MiB;
constexpr size_t WS_RATIO = WS_XPOOL + 16 * MiB;
constexpr size_t WS_GB = WS_RATIO + 32 * MiB;
constexpr size_t WS_XR = WS_GB + 32 * MiB;
constexpr size_t WS_MERGED = WS_XR;
constexpr size_t WS_PP = WS_XR + 32 * MiB;
constexpr size_t WS_YAB = WS_PP + 16 * MiB;
constexpr size_t WS_AA = WS_YAB + 48 * MiB;
constexpr size_t WS_BB = WS_AA + 64 * MiB;
constexpr size_t WS_ACT = WS_AA;
constexpr size_t WS_UH = WS_ACT + 88 * MiB;
constexpr size_t WS_END = WS_BB + 64 * MiB;
static_assert(WS_UH + (size_t)128 * 4 * DUP * 4 <= WS_END, "ws map");
constexpr int CW_BAR = 4096;
constexpr int CW_CVT = 8192;

__device__ __forceinline__ unsigned cvt_pk_bf16(float lo, float hi) { unsigned r; asm("v_cvt_pk_bf16_f32 %0, %1, %2" : "=v"(r) : "v"(lo), "v"(hi)); return r; }
__device__ __forceinline__ float bf_lo(unsigned w) { return __uint_as_float(w << 16); }
__device__ __forceinline__ float bf_hi(unsigned w) { return __uint_as_float(w & 0xffff0000u); }
__device__ __forceinline__ float bf1(bf16_t h) { return __uint_as_float((unsigned)h << 16); }
__device__ __forceinline__ float fexp2(float x) { return __builtin_amdgcn_exp2f(x); }
__device__ __forceinline__ float frcp(float x) { return __builtin_amdgcn_rcpf(x); }
__device__ __forceinline__ float sigmoid_f(float x) { return frcp(1.f + fexp2(-1.4426950409f * x)); }
__device__ __forceinline__ float gelu_tanh_f(float x) { const float t = x + 0.044715f * x * x * x; return x * frcp(1.f + fexp2(-2.3022082f * t)); }
__device__ __forceinline__ float wave_sum(float v) {
#pragma unroll
    for (int o = 1; o < 64; o <<= 1) v += __shfl_xor(v, o);
    return v;
}
template <int CTRL> __device__ __forceinline__ float dpp0(float x) { return __builtin_bit_cast(float, __builtin_amdgcn_update_dpp(0, __builtin_bit_cast(int, x), CTRL, 0xf, 0xf, true)); }

namespace pg8 {
constexpr int BM = 256, BK = 64, HALF = 128, HTB = HALF * BK * 2, STAGE_BYTES = 8 * HTB, NXCD = 8, WGM = 4;
__host__ __device__ __forceinline__ int lds_byte(int r, int c) { const int st = (r >> 4) * 2 + (c >> 5), rr = r & 15, cc = c & 31, ob = rr * 64 + cc * 2; return st * 1024 + (ob ^ (((ob >> 9) & 1) << 5)); }
__host__ __device__ __forceinline__ void stage_rc(int b, int& R, int& C) { const int st = b / 1024, sb = b % 1024, swz = sb ^ (((sb >> 9) & 1) << 5); R = (st >> 1) * 16 + swz / 64; C = (st & 1) * 32 + (swz % 64) / 2; }
__host__ __device__ __forceinline__ int perm32(int rho) { const int n = rho >> 4, i = rho & 15; return 8 * (i >> 2) + 4 * n + (i & 3); }

struct Unit { int pm, pn; };
struct Gemm { const bf16_t* A; const bf16_t* Bt; int lda, ldb, nt, nM, nN, a_sh, a_mul, a_swz = 0, b_pm = 0; };

struct StaticOrder {
    int nM, nN, nwg, G, c;
    __device__ void init(int nM_, int nN_, int G_, int c_) { nM = nM_; nN = nN_; nwg = nM * nN; G = G_; c = c_; }
    __device__ bool next(int i, Unit& u) const {
        const long L = (long)i * G + c; if (L >= nwg) return false;
        int wgid = (int)L; { const int q = nwg / NXCD, r = nwg % NXCD, xcd = wgid % NXCD, off = wgid / NXCD; wgid = (xcd < r ? xcd * (q + 1) : r * (q + 1) + (xcd - r) * q) + off; }
        const int nig = WGM * nN, gid = wgid / nig, fm = gid * WGM, gsz = (nM - fm) < WGM ? (nM - fm) : WGM;
        u.pm = fm + ((wgid % nig) % gsz); u.pn = (wgid % nig) / gsz; return true;
    }
};

template <class Epi, bool ALIGN_EPI, class Sched = StaticOrder>
__device__ __forceinline__ void gemm_phase(LAS unsigned char* lds, const Gemm g, const Sched& S, const Epi& E) {
    int tid = threadIdx.x; asm volatile("" : "+v"(tid)); tid &= 511;
    const int wid = __builtin_amdgcn_readfirstlane(tid >> 6), lane = tid & 63, wr = wid >> 2, wc = wid & 3, fr = lane & 15, fq = lane >> 4;
    const int nt = g.nt;
    unsigned voffA[2], voffB[2];
#pragma unroll
    for (int i = 0; i < 2; ++i) { int R, C; stage_rc(tid * 16 + i * 8192, R, C); const int Rb = Epi::PERM == 2 ? ((R >> 5) * 64 + perm32(R & 31)) : Epi::PERM == 1 ? ((R & ~31) + perm32(R & 31)) : R;
        const int Ra = g.a_swz ? ((R & ~8) | (((C >> 5) & 1) << 3)) : R, Ca = g.a_swz ? ((C & ~32) | (((R >> 3) & 1) << 5)) : C;
        voffA[i] = (unsigned)(Ra * g.lda + Ca) * 2u; voffB[i] = (unsigned)(Rb * g.ldb + C) * 2u; }
    const size_t kstep = (size_t)(BK * 2);
    const size_t hstepA = (size_t)HALF * g.lda * 2, hstepB = (size_t)(Epi::PERM == 2 ? 32 : HALF) * g.ldb * 2;
    const size_t tstepA = 2 * hstepA, tstepB = (size_t)BM * g.ldb * 2;
    const unsigned ldsw = (unsigned)wid * 1024u;
    const int aoff = lds_byte(wr * 64 + fr, fq * 8), boff = lds_byte(wc * 32 + fr, fq * 8);
#define PG8_SA(b, h) (((b) * 2 + (h)) * HTB)
#define PG8_SB(b, h) ((4 + (b) * 2 + (h)) * HTB)
#define PG8_STAGE(bufoff, gbase, voff) do { _Pragma("unroll") for (int _i = 0; _i < 2; ++_i) \
        __builtin_amdgcn_global_load_lds((const unsigned*)((const char*)(gbase) + (voff)[_i]), (LAS unsigned*)(lds + (bufoff) + ldsw + _i * 8192), 16, 0, 0); } while (0)
#define PG8_LDA(dst, b, h) do { _Pragma("unroll") for (int m = 0; m < 4; ++m) _Pragma("unroll") for (int k = 0; k < 2; ++k) dst[m][k] = *(const LAS bf16x8*)(lds + PG8_SA(b, h) + aoff + m * 2048 + k * 1024); } while (0)
#define PG8_LDB(dst, b, h) do { _Pragma("unroll") for (int n = 0; n < 2; ++n) _Pragma("unroll") for (int k = 0; k < 2; ++k) dst[n][k] = *(const LAS bf16x8*)(lds + PG8_SB(b, h) + boff + n * 2048 + k * 1024); } while (0)
#define PG8_MMA(ai, bj, At, Bt) do { __builtin_amdgcn_s_setprio(1); _Pragma("unroll") for (int m = 0; m < 4; ++m) _Pragma("unroll") for (int n = 0; n < 2; ++n) _Pragma("unroll") for (int k = 0; k < 2; ++k) \
        acc[ai][bj][m][n] = __builtin_amdgcn_mfma_f32_16x16x32_bf16(Bt[n][k], At[m][k], acc[ai][bj][m][n], 0, 0, 0); __builtin_amdgcn_s_setprio(0); } while (0)
#define PG8_WAIT_V(n) asm volatile("s_waitcnt vmcnt(" #n ")" ::: "memory")
#define PG8_WAIT_L(n) asm volatile("s_waitcnt lgkmcnt(" #n ")" ::: "memory")
#define PG8_BAR __builtin_amdgcn_s_barrier()
#define PG8_SCHED __builtin_amdgcn_sched_barrier(0)
#define PG8_ABASE(u) ((const char*)g.A + (size_t)(u).pm * tstepA + (size_t)(((u).pn >> g.a_sh) * g.a_mul) * 2)
#define PG8_BBASE(u) ((const char*)g.Bt + (size_t)(u).pn * tstepB + (size_t)((u).pm * g.b_pm))
    Unit cur, nxt; int ui = 0;
    if (!S.next(0, cur)) return;
    f32x4 acc[2][2][4][2];
#pragma unroll
    for (int a = 0; a < 2; ++a)
#pragma unroll
        for (int b = 0; b < 2; ++b)
#pragma unroll
            for (int m = 0; m < 4; ++m)
#pragma unroll
                for (int n = 0; n < 2; ++n) acc[a][b][m][n] = (f32x4){0.f, 0.f, 0.f, 0.f};
    bf16x8 At[4][2], B0[2][2], B1[2][2];
    const char* cA = PG8_ABASE(cur); const char* cB = PG8_BBASE(cur);
    PG8_STAGE(PG8_SB(0, 0), cB, voffB); PG8_STAGE(PG8_SB(0, 1), cB + hstepB, voffB); PG8_STAGE(PG8_SA(0, 0), cA, voffA); PG8_STAGE(PG8_SA(0, 1), cA + hstepA, voffA);
    if (wr == 1) PG8_BAR;
    PG8_WAIT_V(2); PG8_BAR;
    PG8_STAGE(PG8_SB(1, 0), cB + kstep, voffB); PG8_STAGE(PG8_SA(1, 0), cA + kstep, voffA); PG8_STAGE(PG8_SB(1, 1), cB + hstepB + kstep, voffB);
    PG8_WAIT_V(6); PG8_BAR;
    for (;;) {
        const bool has_next = S.next(ui + 1, nxt);
        const char* nA = has_next ? PG8_ABASE(nxt) : cA; const char* nB = has_next ? PG8_BBASE(nxt) : cB;
#pragma unroll 1
        for (int t = 0; t < nt; t += 2) {
            const bool last = (t == nt - 2);
            if constexpr (Epi::MIDK) { if (t == E.midk_t) E.mid(acc, cur, wr, wc, fr, fq); }
            const char* a1 = cA + (size_t)(t + 1) * kstep;
            const char* a2 = last ? nA : cA + (size_t)(t + 2) * kstep; const char* b2 = last ? nB : cB + (size_t)(t + 2) * kstep;
            const char* a3 = a2 + kstep; const char* b3 = b2 + kstep;
            PG8_LDB(B0, 0, 0); PG8_LDB(B1, 0, 1); PG8_SCHED; PG8_LDA(At, 0, 0); PG8_STAGE(PG8_SA(1, 1), a1 + hstepA, voffA);
            PG8_WAIT_V(8); PG8_WAIT_L(0); PG8_BAR; PG8_MMA(0, 0, At, B0); PG8_MMA(0, 1, At, B1); PG8_BAR; PG8_SCHED;
            PG8_LDA(At, 0, 1); PG8_STAGE(PG8_SB(0, 0), b2, voffB); PG8_STAGE(PG8_SB(0, 1), b2 + hstepB, voffB); PG8_STAGE(PG8_SA(0, 0), a2, voffA);
            PG8_WAIT_V(8); PG8_WAIT_L(0); PG8_BAR; PG8_MMA(1, 0, At, B0); PG8_MMA(1, 1, At, B1); PG8_BAR; PG8_SCHED;
            PG8_LDB(B0, 1, 0); PG8_LDB(B1, 1, 1); PG8_SCHED; PG8_LDA(At, 1, 0); PG8_STAGE(PG8_SA(0, 1), a2 + hstepA, voffA);
            PG8_WAIT_V(8); PG8_WAIT_L(0); PG8_BAR; PG8_MMA(0, 0, At, B0); PG8_MMA(0, 1, At, B1); PG8_BAR; PG8_SCHED;
            PG8_LDA(At, 1, 1); PG8_STAGE(PG8_SB(1, 0), b3, voffB); PG8_STAGE(PG8_SB(1, 1), b3 + hstepB, voffB); PG8_STAGE(PG8_SA(1, 0), a3, voffA);
            PG8_WAIT_V(8); PG8_WAIT_L(0); PG8_BAR; PG8_MMA(1, 0, At, B0); PG8_MMA(1, 1, At, B1); PG8_BAR; PG8_SCHED;
        }
        if constexpr (ALIGN_EPI) { if (wr == 0) PG8_BAR; }
        if constexpr (!Epi::AFTER_DRAIN) { E(acc, cur, ui, wr, wc, fr, fq); }
        if (!has_next) break;
#pragma unroll
        for (int a = 0; a < 2; ++a)
#pragma unroll
            for (int b = 0; b < 2; ++b)
#pragma unroll
                for (int m = 0; m < 4; ++m)
#pragma unroll
                    for (int n = 0; n < 2; ++n) acc[a][b][m][n] = (f32x4){0.f, 0.f, 0.f, 0.f};
        cur = nxt; cA = nA; cB = nB; ++ui;
        if constexpr (ALIGN_EPI) { if (wr == 1) PG8_BAR; }
    }
    PG8_WAIT_V(0);
    if constexpr (!ALIGN_EPI) { if (wr == 0) PG8_BAR; }
    PG8_BAR;
    if constexpr (Epi::AFTER_DRAIN) { E.fused(acc, cur, wr, wc, fr, fq, lds, wid, lane); }
#undef PG8_SA
#undef PG8_SB
#undef PG8_STAGE
#undef PG8_LDA
#undef PG8_LDB
#undef PG8_MMA
#undef PG8_WAIT_V
#undef PG8_WAIT_L
#undef PG8_BAR
#undef PG8_SCHED
#undef PG8_ABASE
#undef PG8_BBASE
}

typedef f32x4 Acc[2][2][4][2];
__device__ __forceinline__ float ror8_1(float x) { float r; asm volatile("s_nop 1\n\tv_mov_b32_dpp %0, %1 row_ror:8 row_mask:0xf bank_mask:0xf" : "=v"(r) : "v"(x)); return r; }
__device__ __forceinline__ f32x4 ror8(const f32x4 v) { f32x4 r; r[0] = ror8_1(v[0]); r[1] = ror8_1(v[1]); r[2] = ror8_1(v[2]); r[3] = ror8_1(v[3]); return r; }
__device__ __forceinline__ f32x4 sel4(bool c, const f32x4 a, const f32x4 b) { f32x4 r;
#pragma unroll
    for (int i = 0; i < 4; ++i) r[i] = c ? a[i] : b[i]; return r; }
__device__ __forceinline__ void ld_lines(const float* p, int ldf, bool lo, int fr7, f32x4& n0, f32x4& n1, int hoff = 16) {
    const float* q = p + (size_t)fr7 * ldf + (lo ? 0 : hoff); const f32x4 A = __builtin_nontemporal_load((const f32x4*)q), B = __builtin_nontemporal_load((const f32x4*)(q + (size_t)8 * ldf));
    n0 = sel4(lo, A, ror8(B)); n1 = sel4(lo, ror8(A), B); }
__device__ __forceinline__ void st_lines(float* p, int ldf, bool lo, int fr7, const f32x4 n0, const f32x4 n1, int hoff = 16) {
    float* q = p + (size_t)fr7 * ldf + (lo ? 0 : hoff); *(f32x4*)q = sel4(lo, n0, ror8(n1)); *(f32x4*)(q + (size_t)8 * ldf) = sel4(lo, ror8(n0), n1); }
__device__ __forceinline__ u32x4 asu(const f32x4 v) { return __builtin_bit_cast(u32x4, v); }
__device__ __forceinline__ f32x4 asf(const u32x4 v) { return __builtin_bit_cast(f32x4, v); }
__device__ __forceinline__ void st_lines16(bf16_t* p, int ld, bool lo, int fr7, const u32x4 h0, const u32x4 h1) {
    bf16_t* q = p + (size_t)fr7 * ld + (lo ? 0 : 32); *(u32x4*)q = asu(sel4(lo, asf(h0), ror8(asf(h1)))); *(u32x4*)(q + (size_t)8 * ld) = asu(sel4(lo, ror8(asf(h0)), asf(h1))); }
__device__ __forceinline__ void ld_lines16_raw(const bf16_t* p, int ld, bool lo, int fr7, f32x4& A, f32x4& B) { const bf16_t* q = p + (size_t)fr7 * ld + (lo ? 0 : 32); A = asf(*(const u32x4*)q); B = asf(*(const u32x4*)(q + (size_t)8 * ld)); }
__device__ __forceinline__ void lines16_fix(bool lo, const f32x4 A, const f32x4 B, u32x4& h0, u32x4& h1) { h0 = asu(sel4(lo, A, ror8(B))); h1 = asu(sel4(lo, ror8(A), B)); }
__device__ __forceinline__ void ld_lines16(const bf16_t* p, int ld, bool lo, int fr7, u32x4& h0, u32x4& h1) {
    const bf16_t* q = p + (size_t)fr7 * ld + (lo ? 0 : 32); const f32x4 A = asf(*(const u32x4*)q), B = asf(*(const u32x4*)(q + (size_t)8 * ld));
    h0 = asu(sel4(lo, A, ror8(B))); h1 = asu(sel4(lo, ror8(A), B)); }

constexpr int TAB_OFF = RING_BYTES + 1024;

__device__ __forceinline__ float row_rstd(const float* ss, int row) {
    float s = 0.f;
#pragma unroll
    for (int j = 0; j < 8; ++j) s += ss[(size_t)j * M + row];
    return __builtin_amdgcn_rsqf(s * (1.0f / DM) + EPS);
}
__device__ __forceinline__ u32x4 pack8(const f32x4 a, const f32x4 b) { u32x4 w; w.x = cvt_pk_bf16(a[0], a[1]); w.y = cvt_pk_bf16(a[2], a[3]); w.z = cvt_pk_bf16(b[0], b[1]); w.w = cvt_pk_bf16(b[2], b[3]); return w; }
__device__ __forceinline__ void unpack8(const u32x4 w, f32x4& a, f32x4& b) { a = (f32x4){bf_lo(w.x), bf_hi(w.x), bf_lo(w.y), bf_hi(w.y)}; b = (f32x4){bf_lo(w.z), bf_hi(w.z), bf_lo(w.w), bf_hi(w.w)}; }

__device__ __forceinline__ void fill_rstd_tab(LAS unsigned char* lds, const StaticOrder& S, const float* ss, int tid) {
    LAS float* tab = (LAS float*)(lds + TAB_OFF); Unit u;
    for (int i = 0; i < 8 && S.next(i, u); ++i) if (tid < 256) tab[i * 256 + tid] = row_rstd(ss, u.pm * BM + tid);
    __syncthreads();
}
constexpr int BTAB_OFF = RING_BYTES + 9216;
__device__ __forceinline__ void fill_tabs(LAS unsigned char* lds, const StaticOrder& S, const float* ss, const float* pb, int ncols, int tid) {
    LAS float* tab = (LAS float*)(lds + TAB_OFF); LAS float* bt = (LAS float*)(lds + BTAB_OFF); LAS float* bh = (LAS float*)lds;
    const int c = tid & 255, h = tid >> 8;
    Unit u0; S.next(0, u0);
    float sb[6], sr[3];
#pragma unroll
    for (int i = 0; i < 6; ++i) { Unit u; if (!S.next(i, u)) u = u0; const float* p = pb + (size_t)((u.pm >> 4) * 32 + 16 * h) * ncols + u.pn * BM + c; float s = 0.f;
#pragma unroll
        for (int kb = 0; kb < 16; ++kb) s += p[(size_t)kb * ncols];
        sb[i] = s; }
#pragma unroll
    for (int j = 0; j < 3; ++j) { Unit u; if (!S.next(2 * j + h, u)) u = u0; sr[j] = row_rstd(ss, u.pm * BM + c); }
#pragma unroll
    for (int j = 0; j < 3; ++j) tab[(2 * j + h) * 256 + c] = sr[j];
    if (h) {
#pragma unroll
        for (int i = 0; i < 6; ++i) bh[i * 256 + c] = sb[i]; }
    __syncthreads();
    if (!h) {
#pragma unroll
        for (int i = 0; i < 6; ++i) bt[i * 256 + c] = sb[i] + bh[i * 256 + c]; }
    __syncthreads();
}
struct EpiZ {
    static constexpr int PERM = 2; static constexpr bool AFTER_DRAIN = false, MIDK = false;
    const LAS float* tab; const LAS float* btab; bf16_t* xrnn; bf16_t* gg; bf16_t* xpool; bf16_t* rg; int midk_t;
    __device__ __forceinline__ void mid(Acc&, const Unit&, int, int, int, int) const {}
    __device__ __forceinline__ void operator()(const Acc& acc, const Unit& u, int ui, int wr, int wc, int fr, int fq) const {
        { int t_ = threadIdx.x; asm volatile("" : "+v"(t_)); fr = t_ & 15; fq = (t_ >> 4) & 3; }
        const int row0 = u.pm * BM + wr * 64, b = u.pm >> 4, lc0 = wc * 64 + 8 * fq; const bool lo = fr < 8; const int fr7 = fr & 7;
        const LAS float* rtab = tab + ui * 256 + wr * 64 + fr;
        const LAS float* bp = btab + ui * 256 + lc0;
        f32x4 bv[2][2];
#pragma unroll
        for (int bj = 0; bj < 2; ++bj)
#pragma unroll
            for (int n = 0; n < 2; ++n) bv[bj][n] = *(const LAS f32x4*)(bp + 32 * bj + 4 * n);
        bf16_t* d0; int ld, mode = 0;
        if (u.pn < 8) { d0 = xrnn + u.pn * BM + lc0; ld = DRNN; }
        else if (u.pn < 16) { d0 = gg + (u.pn - 8) * BM + lc0; ld = DRNN; mode = 1; }
        else if (u.pn < 20) { d0 = xpool + (u.pn - 16) * BM + lc0; ld = DPOOL; }
        else { d0 = rg + (u.pn - 20) * BM + lc0; ld = 2 * DM; mode = 2; }
#pragma unroll
        for (int ai = 0; ai < 2; ++ai)
#pragma unroll
            for (int m = 0; m < 4; ++m) { const int rowg = row0 + ai * HALF + m * 16; const float rs = rtab[ai * HALF + m * 16];
                f32x4 z[2][2];
#pragma unroll
                for (int bj = 0; bj < 2; ++bj)
#pragma unroll
                    for (int n = 0; n < 2; ++n) z[bj][n] = acc[ai][bj][m][n] * rs + bv[bj][n];
                if (mode == 1) {
#pragma unroll
                    for (int bj = 0; bj < 2; ++bj)
#pragma unroll
                        for (int n = 0; n < 2; ++n)
#pragma unroll
                            for (int i = 0; i < 4; ++i) z[bj][n][i] = gelu_tanh_f(z[bj][n][i]);
                } else if (mode == 2) {
#pragma unroll
                    for (int n = 0; n < 2; ++n)
#pragma unroll
                        for (int i = 0; i < 4; ++i) { const float eu = fexp2(-1.4426950409f * z[0][n][i]), ev = fminf(fexp2(-1.4426950409f * z[1][n][i]), 1e30f);
                            z[1][n][i] = frcp(1.f + ev); z[0][n][i] = (1.f + ev) * frcp(1.f + eu); }
                }
                st_lines16(d0 + (size_t)rowg * ld, ld, lo, fr7, pack8(z[0][0], z[0][1]), pack8(z[1][0], z[1][1])); }
    }
};

struct GateOrder {
    int c;
    __device__ bool next(int i, Unit& u) const { if (i >= 2 || c >= 256) return false; const int pmi = c >> 4; u.pn = c & 15; u.pm = ((pmi < 8) ? pmi : pmi + 8) + 8 * i; return true; }
};
constexpr int SCAN_OFF = RING_BYTES + 9216;
template <int CTRL> __device__ __forceinline__ float dpp_old(float oldv, float x) { return __builtin_bit_cast(float, __builtin_amdgcn_update_dpp(__builtin_bit_cast(int, oldv), __builtin_bit_cast(int, x), CTRL, 0xf, 0xf, false)); }
__device__ __forceinline__ float bcast15(float x) { return __builtin_bit_cast(float, __builtin_amdgcn_ds_swizzle(__builtin_bit_cast(int, x), 0x1F0)); }
#define SCAN16_STEP(k) \
    "v_fmac_f32_dpp %4, %4, %0 row_shr:" #k " row_mask:0xf bank_mask:0xf\n\tv_fmac_f32_dpp %5, %5, %1 row_shr:" #k " row_mask:0xf bank_mask:0xf\n\t" \
    "v_fmac_f32_dpp %6, %6, %2 row_shr:" #k " row_mask:0xf bank_mask:0xf\n\tv_fmac_f32_dpp %7, %7, %3 row_shr:" #k " row_mask:0xf bank_mask:0xf\n\t" \
    "v_mul_f32_dpp %0, %0, %0 row_shr:" #k " row_mask:0xf bank_mask:0xf\n\tv_mul_f32_dpp %1, %1, %1 row_shr:" #k " row_mask:0xf bank_mask:0xf\n\t" \
    "v_mul_f32_dpp %2, %2, %2 row_shr:" #k " row_mask:0xf bank_mask:0xf\n\tv_mul_f32_dpp %3, %3, %3 row_shr:" #k " row_mask:0xf bank_mask:0xf\n\t"
__device__ __forceinline__ void scan16(f32x4& P, f32x4& H) {
    float p0 = P[0], p1 = P[1], p2 = P[2], p3 = P[3], h0 = H[0], h1 = H[1], h2 = H[2], h3 = H[3];
    asm("s_nop 1\n\t" SCAN16_STEP(1) SCAN16_STEP(2) SCAN16_STEP(4) SCAN16_STEP(8) "s_nop 0"
        : "+v"(p0), "+v"(p1), "+v"(p2), "+v"(p3), "+v"(h0), "+v"(h1), "+v"(h2), "+v"(h3));
    P = (f32x4){p0, p1, p2, p3}; H = (f32x4){h0, h1, h2, h3};
}
#undef SCAN16_STEP
struct EpiGates {
    static constexpr int PERM = 2; static constexpr bool AFTER_DRAIN = false, MIDK = false;
    const float* ba; const float* bx; const float* lruk; const bf16_t* xr; const bf16_t* gg; bf16_t* yab; unsigned long long* aggu; LAS unsigned char* lds; int midk_t;
    __device__ __forceinline__ void mid(Acc&, const Unit&, int, int, int, int) const {}
    __device__ __forceinline__ void operator()(const Acc& acc, const Unit& u, int ui, int wr, int wc, int fr, int fq) const {
        int tid; { int t_ = threadIdx.x; asm volatile("" : "+v"(t_)); tid = t_ & 511; fr = t_ & 15; fq = (t_ >> 4) & 3; }
        const int b = u.pm >> 4, pmb = u.pm & 15;
        const int row0 = u.pm * BM + wr * 64 + fr, chl0 = wc * 32 + 8 * fq, ch0 = u.pn * HALF + chl0;
        LAS float* CH = (LAS float*)(lds + SCAN_OFF); LAS float* CARRY = CH + 1024;
        f32x4 Pf[2][4][2], Hf[2][4][2];
        f32x4 vba[2], vbx[2], vk[2];
#pragma unroll
        for (int n = 0; n < 2; ++n) { vba[n] = *(const f32x4*)(ba + ch0 + 4 * n); vbx[n] = *(const f32x4*)(bx + ch0 + 4 * n); vk[n] = *(const f32x4*)(lruk + ch0 + 4 * n); }
#pragma unroll
        for (int ai = 0; ai < 2; ++ai) {
            f32x4 Pc[2] = {(f32x4){1.f, 1.f, 1.f, 1.f}, (f32x4){1.f, 1.f, 1.f, 1.f}}, Hc[2] = {(f32x4){0.f, 0.f, 0.f, 0.f}, (f32x4){0.f, 0.f, 0.f, 0.f}};
            const bf16_t* px = xr + (size_t)(row0 + ai * HALF) * DRNN + ch0; asm volatile("" : "+v"(px)); px = (const bf16_t*)(const __attribute__((address_space(1))) bf16_t*)(unsigned long long)px;
            u32x4 xw4[4];
#pragma unroll
            for (int m = 0; m < 4; ++m) { xw4[m] = *(const u32x4*)px; px += 16 * DRNN; }
#pragma unroll
            for (int m = 0; m < 4; ++m) { const u32x4 xw = xw4[m]; f32x4 xv[2]; unpack8(xw, xv[0], xv[1]);
#pragma unroll
                for (int n = 0; n < 2; ++n) { f32x4 Pv, Hv;
#pragma unroll
                    for (int i = 0; i < 4; ++i) { const float r = sigmoid_f(acc[ai][0][m][n][i] + vba[n][i]), g = sigmoid_f(acc[ai][1][m][n][i] + vbx[n][i]);
                        const float P = fexp2(1.4426950409f * vk[n][i] * r); Pv[i] = P; Hv[i] = __builtin_amdgcn_sqrtf(fmaxf(1.f - P * P, 0.f)) * (g * xv[n][i]); }
                    scan16(Pv, Hv);
#pragma unroll
                    for (int i = 0; i < 4; ++i) { const float P = Pv[i], H = Hv[i];
                        const float Pt = bcast15(P), Ht = bcast15(H);
                        Hf[ai][m][n][i] = P * Hc[n][i] + H; Pf[ai][m][n][i] = P * Pc[n][i];
                        Hc[n][i] = Pt * Hc[n][i] + Ht; Pc[n][i] = Pt * Pc[n][i]; }
                    asm volatile("" : "+v"(Hf[ai][m][n]), "+v"(Pf[ai][m][n]), "+v"(Hc[n]), "+v"(Pc[n]) :: "memory"); } }
            if (fr == 0) {
#pragma unroll
                for (int n = 0; n < 2; ++n) { *(LAS f32x4*)(CH + ((2 * ai + wr) * 2 + 0) * 128 + chl0 + 4 * n) = Pc[n]; *(LAS f32x4*)(CH + ((2 * ai + wr) * 2 + 1) * 128 + chl0 + 4 * n) = Hc[n]; } }
        }
        u32x4 gw8[2][4];
#pragma unroll
        for (int ai = 0; ai < 2; ++ai) { const bf16_t* pg = gg + (size_t)(row0 + ai * HALF) * DRNN + ch0; asm volatile("" : "+v"(pg)); pg = (const bf16_t*)(const __attribute__((address_space(1))) bf16_t*)(unsigned long long)pg;
#pragma unroll
            for (int m = 0; m < 4; ++m) { gw8[ai][m] = __builtin_nontemporal_load((const u32x4*)pg); pg += 16 * DRNN; } }
        asm volatile("s_waitcnt lgkmcnt(0)" ::: "memory"); __builtin_amdgcn_s_barrier(); asm volatile("" ::: "memory");
        {
            const int tc = tid & 127, jg = tid >> 7;
            unsigned long long* gbase = aggu + (size_t)(b * 16) * DRNN + u.pn * HALF + tc;
            if (jg == 0) { float P = 1.f, H = 0.f;
#pragma unroll
                for (int c = 0; c < 4; ++c) { const float p = CH[(c * 2 + 0) * 128 + tc], h = CH[(c * 2 + 1) * 128 + tc]; H = p * H + h; P = p * P; }
                __hip_atomic_store(gbase + (size_t)pmb * DRNN, ((unsigned long long)__float_as_uint(H) << 32) | (unsigned long long)__float_as_uint(-P), __ATOMIC_RELAXED, __HIP_MEMORY_SCOPE_AGENT); }
            float Pq = 1.f, Hq = 0.f;
            if (4 * jg < pmb) {
                unsigned long long gq[4]; unsigned spins = 0;
                for (;;) { bool ok = true;
#pragma unroll
                    for (int j = 0; j < 4; ++j) { gq[j] = 0x80000000ull; if (4 * jg + j < pmb) { gq[j] = __hip_atomic_load(gbase + (size_t)(4 * jg + j) * DRNN, __ATOMIC_RELAXED, __HIP_MEMORY_SCOPE_AGENT); ok = ok && ((gq[j] >> 31) & 1ull); } }
                    if (__all(ok) || ++spins > (1u << 20)) break;
                    __builtin_amdgcn_s_sleep(4); }
#pragma unroll
                for (int j = 0; j < 4; ++j) if (4 * jg + j < pmb) { const float p = -__uint_as_float((unsigned)gq[j]), h = __uint_as_float((unsigned)(gq[j] >> 32)); Hq = p * Hq + h; Pq = p * Pq; }
            }
            LAS float* PART = (LAS float*)(lds + TAB_OFF);
            PART[(jg * 2 + 0) * 128 + tc] = Pq; PART[(jg * 2 + 1) * 128 + tc] = Hq;
        }
        asm volatile("s_waitcnt lgkmcnt(0)" ::: "memory"); __builtin_amdgcn_s_barrier(); asm volatile("" ::: "memory");
        if (tid < 128) { const LAS float* PART = (const LAS float*)(lds + TAB_OFF); float hin = 0.f;
#pragma unroll
            for (int jg = 0; jg < 4; ++jg) hin = PART[(jg * 2 + 0) * 128 + tid] * hin + PART[(jg * 2 + 1) * 128 + tid];
            CARRY[tid] = hin; }
        asm volatile("s_waitcnt lgkmcnt(0)" ::: "memory"); __builtin_amdgcn_s_barrier(); asm volatile("" ::: "memory");
#pragma unroll
        for (int ai = 0; ai < 2; ++ai) {
            f32x4 hp[2];
#pragma unroll
            for (int n = 0; n < 2; ++n) { hp[n] = *(const LAS f32x4*)(CARRY + chl0 + 4 * n);
#pragma unroll
                for (int c = 0; c < 3; ++c) if (c < 2 * ai + wr) hp[n] = *(const LAS f32x4*)(CH + (c * 2 + 0) * 128 + chl0 + 4 * n) * hp[n] + *(const LAS f32x4*)(CH + (c * 2 + 1) * 128 + chl0 + 4 * n); }
            bf16_t* py = yab + (size_t)(row0 + ai * HALF) * 3072 + ch0; asm volatile("" : "+v"(py)); py = (bf16_t*)(__attribute__((address_space(1))) bf16_t*)(unsigned long long)py;
#pragma unroll
            for (int m = 0; m < 4; ++m) { const u32x4 gw = gw8[ai][m]; f32x4 g0, g1; unpack8(gw, g0, g1);
                *(u32x4*)py = pack8((Hf[ai][m][0] + Pf[ai][m][0] * hp[0]) * g0, (Hf[ai][m][1] + Pf[ai][m][1] * hp[1]) * g1); py += 16 * 3072; asm volatile("" ::: "memory"); }
        }
    }
};

struct EpiPool {
    static constexpr int PERM = 2; static constexpr bool AFTER_DRAIN = false, MIDK = false;
    const float* pb; const float* ps; bf16_t* yab; int midk_t;
    __device__ __forceinline__ void mid(Acc&, const Unit&, int, int, int, int) const {}
    __device__ __forceinline__ void operator()(const Acc& acc, const Unit& u, int ui, int wr, int wc, int fr, int fq) const {
        { int t_ = threadIdx.x; asm volatile("" : "+v"(t_)); fr = t_ & 15; fq = (t_ >> 4) & 3; }
        const int c0 = u.pn * BM + wc * 64 + 8 * fq; const bool lo = fr < 8; const int fr7 = fr & 7;
        f32x4 bv[2][2], sv[2][2];
#pragma unroll
        for (int bj = 0; bj < 2; ++bj)
#pragma unroll
            for (int n = 0; n < 2; ++n) { bv[bj][n] = *(const f32x4*)(pb + c0 + 32 * bj + 4 * n); sv[bj][n] = *(const f32x4*)(ps + c0 + 32 * bj + 4 * n); }
#pragma unroll
        for (int ai = 0; ai < 2; ++ai)
#pragma unroll
            for (int m = 0; m < 4; ++m) { bf16_t* p = yab + (size_t)(u.pm * BM + ai * HALF + wr * 64 + m * 16) * 3072 + 2048 + c0;
                st_lines16(p, 3072, lo, fr7, pack8((acc[ai][0][m][0] + bv[0][0]) * sv[0][0], (acc[ai][0][m][1] + bv[0][1]) * sv[0][1]), pack8((acc[ai][1][m][0] + bv[1][0]) * sv[1][0], (acc[ai][1][m][1] + bv[1][1]) * sv[1][1]));
                asm volatile("" ::: "memory"); }
    }
};

struct EpiWp {
    static constexpr int PERM = 0; static constexpr bool AFTER_DRAIN = false, MIDK = false;
    bf16_t* dst; int midk_t;
    __device__ __forceinline__ void mid(Acc&, const Unit&, int, int, int, int) const {}
    __device__ __forceinline__ void operator()(const Acc& acc, const Unit& u, int ui, int wr, int wc, int fr, int fq) const {
        { int t_ = threadIdx.x; asm volatile("" : "+v"(t_)); fr = t_ & 15; fq = (t_ >> 4) & 3; }
#pragma unroll
        for (int ai = 0; ai < 2; ++ai)
#pragma unroll
            for (int m = 0; m < 4; ++m) { const int k = ai * HALF + wr * 64 + m * 16 + fr;
#pragma unroll
                for (int bj = 0; bj < 2; ++bj)
#pragma unroll
                    for (int n = 0; n < 2; ++n)
#pragma unroll
                        for (int i = 0; i < 4; ++i) { const int c = 128 * bj + 32 * wc + 16 * n + 4 * fq + i;
                            dst[(size_t)(u.pn * BM + c) * 3072 + 256 * u.pm + k] = (bf16_t)(cvt_pk_bf16(acc[ai][bj][m][n][i], 0.f) & 0xffffu); }
                asm volatile("" ::: "memory"); }
    }
};

struct EpiMerge {
    static constexpr int PERM = 2; static constexpr bool AFTER_DRAIN = false, MIDK = true;
    const bf16_t* rg; bf16_t* merged; const LAS float* btab; int midk_t;
    __device__ __forceinline__ void mid(Acc& acc, const Unit& u, int wr, int wc, int fr, int fq) const {
        { int t_ = threadIdx.x; asm volatile("" : "+v"(t_)); fr = t_ & 15; fq = (t_ >> 4) & 3; }
        const int rc0 = 256 * (2 * u.pn + (wc >> 1)) + 128 * (wc & 1) + 8 * fq;
#pragma unroll
        for (int ai = 0; ai < 2; ++ai) { u32x4 h0[4], h1[4];
#pragma unroll
            for (int m = 0; m < 4; ++m) { const bf16_t* pr = rg + (size_t)(u.pm * BM + ai * HALF + wr * 64 + m * 16 + fr) * (2 * DM) + rc0; h0[m] = __builtin_nontemporal_load((const u32x4*)pr); h1[m] = __builtin_nontemporal_load((const u32x4*)(pr + 64)); }
#pragma unroll
            for (int m = 0; m < 4; ++m) {
                f32x4 a, b; unpack8(h0[m], a, b); acc[ai][0][m][0] *= a; acc[ai][0][m][1] *= b; unpack8(h1[m], a, b); acc[ai][1][m][0] *= a; acc[ai][1][m][1] *= b; }
            asm volatile("" ::: "memory"); }
    }
    __device__ __forceinline__ void operator()(const Acc& acc, const Unit& u, int ui, int wr, int wc, int fr, int fq) const {
        { int t_ = threadIdx.x; asm volatile("" : "+v"(t_)); fr = t_ & 15; fq = (t_ >> 4) & 3; }
        const int c0 = u.pn * BM + wc * 64 + 8 * fq; const bool lo = fr < 8; const int fr7 = fr & 7;
        const int rc0 = 256 * (2 * u.pn + (wc >> 1)) + 128 * (wc & 1) + 8 * fq + 32;
        f32x4 bv[2][2];
#pragma unroll
        for (int bj = 0; bj < 2; ++bj)
#pragma unroll
            for (int n = 0; n < 2; ++n) bv[bj][n] = *(const LAS f32x4*)(btab + wc * 64 + 32 * bj + 8 * fq + 4 * n);
#pragma unroll
        for (int ai = 0; ai < 2; ++ai) { u32x4 g0[4], g1[4];
#pragma unroll
            for (int m = 0; m < 4; ++m) { const bf16_t* pr = rg + (size_t)(u.pm * BM + ai * HALF + wr * 64 + m * 16 + fr) * (2 * DM) + rc0; g0[m] = __builtin_nontemporal_load((const u32x4*)pr); g1[m] = __builtin_nontemporal_load((const u32x4*)(pr + 64)); }
#pragma unroll
            for (int m = 0; m < 4; ++m) { const size_t goff = (size_t)(u.pm * BM + ai * HALF + wr * 64 + m * 16) * DM + c0;
                f32x4 a0, b0, a1, b1; unpack8(g0[m], a0, b0); unpack8(g1[m], a1, b1);
                st_lines16(merged + goff, DM, lo, fr7, pack8((acc[ai][0][m][0] + bv[0][0]) * a0, (acc[ai][0][m][1] + bv[0][1]) * b0), pack8((acc[ai][1][m][0] + bv[1][0]) * a1, (acc[ai][1][m][1] + bv[1][1]) * b1));
                asm volatile("" ::: "memory"); } }
    }
};

template <bool F32SRC>
struct EpiResid {
    static constexpr int PERM = 2; static constexpr bool AFTER_DRAIN = true, MIDK = false;
    const float* xsrc_f;
    const bf16_t* xsrc_b; const float* gsrc;
    bf16_t* xg; const float* gt; const float* gm; float* ss; int midk_t;
    __device__ __forceinline__ void mid(Acc&, const Unit&, int, int, int, int) const {}
    __device__ __forceinline__ void operator()(const Acc&, const Unit&, int, int, int, int, int) const {}
    __device__ __forceinline__ void fused(const Acc& acc, const Unit& u, int wr, int wc, int fr, int fq, LAS unsigned char* lds, int wid, int lane) const {
        { int t_ = threadIdx.x; asm volatile("" : "+v"(t_)); fr = t_ & 15; fq = (t_ >> 4) & 3; }
        const int b = u.pm >> 4, col0 = u.pn * BM + wc * 64 + 8 * fq;
        LAS float* P = (LAS float*)lds;
        const bool lo = fr < 8; const int fr7 = fr & 7;
        f32x4 gv[2][2], gmv[2][2], rgv[2][2];
#pragma unroll
        for (int bj = 0; bj < 2; ++bj)
#pragma unroll
            for (int n = 0; n < 2; ++n) { const size_t ci = (size_t)b * DM + col0 + 32 * bj + 4 * n; gv[bj][n] = *(const f32x4*)(gt + ci); gmv[bj][n] = *(const f32x4*)(gm + ci);
                if constexpr (!F32SRC) { const f32x4 gs = *(const f32x4*)(gsrc + ci); rgv[bj][n] = (f32x4){1.0f / gs[0], 1.0f / gs[1], 1.0f / gs[2], 1.0f / gs[3]}; } else rgv[bj][n] = (f32x4){1.f, 1.f, 1.f, 1.f}; }
#pragma unroll
        for (int ai = 0; ai < 2; ++ai) { f32x4 RA[4], RB[4];
            if constexpr (!F32SRC) {
#pragma unroll
                for (int m = 0; m < 4; ++m) ld_lines16_raw(xsrc_b + (size_t)(u.pm * BM + ai * HALF + wr * 64 + m * 16) * DM + col0, DM, lo, fr7, RA[m], RB[m]); }
#pragma unroll
            for (int m = 0; m < 4; ++m) { const size_t goff = (size_t)(u.pm * BM + ai * HALF + wr * 64 + m * 16) * DM + col0;
                float q = 0.f; u32x4 pk[2]; f32x4 x[2][2];
                if constexpr (F32SRC) {
#pragma unroll
                    for (int bj = 0; bj < 2; ++bj) ld_lines(xsrc_f + goff + 32 * bj, DM, lo, fr7, x[bj][0], x[bj][1], 4);
                } else { u32x4 h0, h1; lines16_fix(lo, RA[m], RB[m], h0, h1); unpack8(h0, x[0][0], x[0][1]); unpack8(h1, x[1][0], x[1][1]);
#pragma unroll
                    for (int bj = 0; bj < 2; ++bj) { x[bj][0] *= rgv[bj][0]; x[bj][1] *= rgv[bj][1]; } }
#pragma unroll
                for (int bj = 0; bj < 2; ++bj) { const f32x4 y0 = x[bj][0] + gv[bj][0] * acc[ai][bj][m][0], y1 = x[bj][1] + gv[bj][1] * acc[ai][bj][m][1];
                    q += ((y0[0] * y0[0] + y0[1] * y0[1]) + (y0[2] * y0[2] + y0[3] * y0[3])) + ((y1[0] * y1[0] + y1[1] * y1[1]) + (y1[2] * y1[2] + y1[3] * y1[3]));
                    pk[bj] = pack8(y0 * gmv[bj][0], y1 * gmv[bj][1]); }
                st_lines16(xg + goff, DM, lo, fr7, pk[0], pk[1]);
                q += __shfl_xor(q, 16); q += __shfl_xor(q, 32); if (fq == 0) P[(ai * HALF + wr * 64 + m * 16 + fr) * 4 + wc] = q;
                asm volatile("" ::: "memory"); } }
        asm volatile("s_waitcnt lgkmcnt(0)" ::: "memory"); __builtin_amdgcn_s_barrier(); asm volatile("" ::: "memory");
        const int t = wid * 64 + lane;
        if (t < 256) { const float s = (P[t * 4 + 0] + P[t * 4 + 1]) + (P[t * 4 + 2] + P[t * 4 + 3]); ss[(size_t)u.pn * M + u.pm * BM + t] = s; }
    }
};

struct EpiFinal {
    static constexpr int PERM = 2; static constexpr bool AFTER_DRAIN = true, MIDK = false;
    const bf16_t* xsrc_b; const float* gsrc; float* out; const float* gt; const float* fg; unsigned* fss; int midk_t;
    __device__ __forceinline__ void mid(Acc&, const Unit&, int, int, int, int) const {}
    __device__ __forceinline__ void operator()(const Acc&, const Unit&, int, int, int, int, int) const {}
    __device__ __forceinline__ void fused(const Acc& acc, const Unit& u, int wr, int wc, int fr, int fq, LAS unsigned char* lds, int wid, int lane) const {
        { int t_ = threadIdx.x; asm volatile("" : "+v"(t_)); fr = t_ & 15; fq = (t_ >> 4) & 3; }
        const int b = u.pm >> 4, col0 = u.pn * BM + wc * 64 + 8 * fq;
        LAS float* P = (LAS float*)lds;
        const bool lo = fr < 8; const int fr7 = fr & 7;
        f32x4 xn[2][2][4][2]; f32x4 gv[2][2], rgv[2][2];
#pragma unroll
        for (int bj = 0; bj < 2; ++bj)
#pragma unroll
            for (int n = 0; n < 2; ++n) { const size_t ci = (size_t)b * DM + col0 + 32 * bj + 4 * n; gv[bj][n] = *(const f32x4*)(gt + ci); const f32x4 gs = *(const f32x4*)(gsrc + ci); rgv[bj][n] = (f32x4){1.0f / gs[0], 1.0f / gs[1], 1.0f / gs[2], 1.0f / gs[3]}; }
#pragma unroll
        for (int ai = 0; ai < 2; ++ai) { f32x4 RA[4], RB[4];
#pragma unroll
            for (int m = 0; m < 4; ++m) ld_lines16_raw(xsrc_b + (size_t)(u.pm * BM + ai * HALF + wr * 64 + m * 16) * DM + col0, DM, lo, fr7, RA[m], RB[m]);
#pragma unroll
            for (int m = 0; m < 4; ++m) { float q = 0.f;
                u32x4 h0, h1; lines16_fix(lo, RA[m], RB[m], h0, h1); f32x4 xs[2][2]; unpack8(h0, xs[0][0], xs[0][1]); unpack8(h1, xs[1][0], xs[1][1]);
#pragma unroll
                for (int bj = 0; bj < 2; ++bj) { const f32x4 x0 = xs[bj][0] * rgv[bj][0], x1 = xs[bj][1] * rgv[bj][1];
                    const f32x4 v0 = x0 + gv[bj][0] * acc[ai][bj][m][0], v1 = x1 + gv[bj][1] * acc[ai][bj][m][1]; xn[ai][bj][m][0] = v0; xn[ai][bj][m][1] = v1;
                    q += ((v0[0] * v0[0] + v0[1] * v0[1]) + (v0[2] * v0[2] + v0[3] * v0[3])) + ((v1[0] * v1[0] + v1[1] * v1[1]) + (v1[2] * v1[2] + v1[3] * v1[3]));
                    asm volatile("" : "+v"(xn[ai][bj][m][0]), "+v"(xn[ai][bj][m][1]), "+v"(q) :: "memory"); }
                q += __shfl_xor(q, 16); q += __shfl_xor(q, 32); if (fq == 0) P[(ai * HALF + wr * 64 + m * 16 + fr) * 4 + wc] = q; } }
        asm volatile("s_waitcnt lgkmcnt(0)" ::: "memory"); __builtin_amdgcn_s_barrier(); asm volatile("" ::: "memory");
        const int t = wid * 64 + lane;
        if (t < 256) {
            const float s = (P[t * 4 + 0] + P[t * 4 + 1]) + (P[t * 4 + 2] + P[t * 4 + 3]);
            unsigned* w0 = fss + (size_t)u.pm * BM + t;
            __hip_atomic_store(w0 + (size_t)u.pn * M, __float_as_uint(-s), __ATOMIC_RELAXED, __HIP_MEMORY_SCOPE_AGENT);
            unsigned wv[8]; unsigned spins = 0;
            for (;;) { bool ok = true;
#pragma unroll
                for (int j = 0; j < 8; ++j) { wv[j] = __hip_atomic_load(w0 + (size_t)j * M, __ATOMIC_RELAXED, __HIP_MEMORY_SCOPE_AGENT); ok = ok && (wv[j] >> 31); }
                if (__all(ok) || ++spins > (1u << 20)) break;
                __builtin_amdgcn_s_sleep(4); }
            float tot = 0.f;
#pragma unroll
            for (int j = 0; j < 8; ++j) tot += -__uint_as_float(wv[j]);
            P[1024 + t] = __builtin_amdgcn_rsqf(tot * (1.0f / DM) + EPS);
        }
        asm volatile("s_waitcnt lgkmcnt(0)" ::: "memory"); __builtin_amdgcn_s_barrier(); asm volatile("" ::: "memory");
        f32x4 fv[2][2];
#pragma unroll
        for (int bj = 0; bj < 2; ++bj)
#pragma unroll
            for (int n = 0; n < 2; ++n) fv[bj][n] = *(const f32x4*)(fg + col0 + 32 * bj + 4 * n);
#pragma unroll
        for (int ai = 0; ai < 2; ++ai)
#pragma unroll
            for (int m = 0; m < 4; ++m) { const size_t goff = (size_t)(u.pm * BM + ai * HALF + wr * 64 + m * 16) * DM + col0; const float rs = P[1024 + ai * HALF + wr * 64 + m * 16 + fr];
#pragma unroll
                for (int bj = 0; bj < 2; ++bj) st_lines(out + goff + 32 * bj, DM, lo, fr7, xn[ai][bj][m][0] * rs * fv[bj][0], xn[ai][bj][m][1] * rs * fv[bj][1], 4);
                asm volatile("" ::: "memory"); }
    }
};

template <bool PREV> __device__ __forceinline__ f32x4 conv_taps(const f32x4 c, const f32x4 uu, const f32x4 pu, const f32x4 w1, const f32x4 w0) {
    float c0 = c[0], c1 = c[1], c2 = c[2], c3 = c[3];
    asm("s_nop 1\n\t"
        "v_fmac_f32_dpp %0, %4, %8 row_shr:1 row_mask:0xf bank_mask:0xf\n\t"
        "v_fmac_f32_dpp %1, %5, %9 row_shr:1 row_mask:0xf bank_mask:0xf\n\t"
        "v_fmac_f32_dpp %2, %6, %10 row_shr:1 row_mask:0xf bank_mask:0xf\n\t"
        "v_fmac_f32_dpp %3, %7, %11 row_shr:1 row_mask:0xf bank_mask:0xf\n\t"
        "v_fmac_f32_dpp %0, %4, %12 row_shr:2 row_mask:0xf bank_mask:0xf\n\t"
        "v_fmac_f32_dpp %1, %5, %13 row_shr:2 row_mask:0xf bank_mask:0xf\n\t"
        "v_fmac_f32_dpp %2, %6, %14 row_shr:2 row_mask:0xf bank_mask:0xf\n\t"
        "v_fmac_f32_dpp %3, %7, %15 row_shr:2 row_mask:0xf bank_mask:0xf"
        : "+v"(c0), "+v"(c1), "+v"(c2), "+v"(c3)
        : "v"(uu[0]), "v"(uu[1]), "v"(uu[2]), "v"(uu[3]), "v"(w1[0]), "v"(w1[1]), "v"(w1[2]), "v"(w1[3]), "v"(w0[0]), "v"(w0[1]), "v"(w0[2]), "v"(w0[3]));
    if constexpr (PREV) {
        asm("s_nop 1\n\t"
            "v_fmac_f32_dpp %0, %4, %8 row_shl:15 row_mask:0xf bank_mask:0xf\n\t"
            "v_fmac_f32_dpp %1, %5, %9 row_shl:15 row_mask:0xf bank_mask:0xf\n\t"
            "v_fmac_f32_dpp %2, %6, %10 row_shl:15 row_mask:0xf bank_mask:0xf\n\t"
            "v_fmac_f32_dpp %3, %7, %11 row_shl:15 row_mask:0xf bank_mask:0xf\n\t"
            "v_fmac_f32_dpp %0, %4, %12 row_shl:14 row_mask:0xf bank_mask:0xf\n\t"
            "v_fmac_f32_dpp %1, %5, %13 row_shl:14 row_mask:0xf bank_mask:0xf\n\t"
            "v_fmac_f32_dpp %2, %6, %14 row_shl:14 row_mask:0xf bank_mask:0xf\n\t"
            "v_fmac_f32_dpp %3, %7, %15 row_shl:14 row_mask:0xf bank_mask:0xf"
            : "+v"(c0), "+v"(c1), "+v"(c2), "+v"(c3)
            : "v"(pu[0]), "v"(pu[1]), "v"(pu[2]), "v"(pu[3]), "v"(w1[0]), "v"(w1[1]), "v"(w1[2]), "v"(w1[3]), "v"(w0[0]), "v"(w0[1]), "v"(w0[2]), "v"(w0[3]));
    }
    return (f32x4){c0, c1, c2, c3};
}
struct EpiUp {
    static constexpr int PERM = 1; static constexpr bool AFTER_DRAIN = false, MIDK = false;
    const LAS float* tab; const LAS float* btab; const float* cw; const float* cbias; bf16_t* act; float* uh; int midk_t;
    __device__ __forceinline__ void mid(Acc&, const Unit&, int, int, int, int) const {}
    __device__ __forceinline__ void operator()(const Acc& acc, const Unit& u, int ui, int wr, int wc, int fr, int fq) const {
        { int t_ = threadIdx.x; asm volatile("" : "+v"(t_)); fr = t_ & 15; fq = (t_ >> 4) & 3; }
        const int b = u.pm >> 4, lc0 = wc * 32 + 8 * fq;
        const LAS float* rtab = tab + ui * 256 + wr * 64 + fr;
        u32x2 keep[2][4];
#pragma unroll
        for (int n = 0; n < 2; ++n) {
            const int lc = lc0 + 4 * n, ca = u.pn * HALF + lc;
            f32x4 w0[2], w1[2], w2[2], cb[2], bv[2];
#pragma unroll
            for (int bj = 0; bj < 2; ++bj) { const int nc = bj * DFF + ca;
                w0[bj] = *(const f32x4*)(cw + nc); w1[bj] = *(const f32x4*)(cw + DUP + nc); w2[bj] = *(const f32x4*)(cw + 2 * DUP + nc); cb[bj] = *(const f32x4*)(cbias + nc);
                bv[bj] = *(const LAS f32x4*)(btab + ui * 256 + bj * HALF + lc); }
#pragma unroll
            for (int ai = 0; ai < 2; ++ai) {
                const int rbase = u.pm * BM + ai * HALF + wr * 64, sb = rbase >> 6;
                f32x4 pu[2] = {(f32x4){0.f, 0.f, 0.f, 0.f}, (f32x4){0.f, 0.f, 0.f, 0.f}};
#pragma unroll
                for (int m = 0; m < 4; ++m) { const int row = rbase + m * 16 + fr; const float rs = rtab[ai * HALF + m * 16];
                    f32x4 cv[2];
#pragma unroll
                    for (int bj = 0; bj < 2; ++bj) { const f32x4 uu = acc[ai][bj][m][n] * rs + bv[bj];
                        if (m == 0 && fr < 2) *(f32x4*)(uh + ((size_t)sb * 4 + fr) * DUP + u.pn * BM + bj * HALF + lc) = uu;
                        if (m == 3 && fr >= 14) *(f32x4*)(uh + ((size_t)sb * 4 + 2 + (fr - 14)) * DUP + u.pn * BM + bj * HALF + lc) = uu;
                        const f32x4 c = cb[bj] + w2[bj] * uu;
                        cv[bj] = m == 0 ? conv_taps<false>(c, uu, uu, w1[bj], w0[bj]) : conv_taps<true>(c, uu, pu[bj], w1[bj], w0[bj]); pu[bj] = uu; }
                    f32x4 o;
#pragma unroll
                    for (int i = 0; i < 4; ++i) o[i] = cv[0][i] * sigmoid_f(cv[0][i]) * cv[1][i];
                    { u32x2 w; w.x = cvt_pk_bf16(o[0], o[1]); w.y = cvt_pk_bf16(o[2], o[3]);
                      if (n == 0) keep[ai][m] = w; else if (!(m == 0 && fr < 2)) { u32x4 w4; w4.x = keep[ai][m].x; w4.y = keep[ai][m].y; w4.z = w.x; w4.w = w.y; *(u32x4*)(act + (size_t)(rbase + m * 16 + (fr & 7) + 8 * (wc & 1)) * DFF + u.pn * HALF + 64 * (wc >> 1) + 32 * (fr >> 3) + 8 * fq) = w4; } }
                    asm volatile("" ::: "memory"); }
            }
        }
    }
};
}

constexpr int PTR_OFF = RING_BYTES + 512;
__device__ __forceinline__ unsigned long long lds_ptr(LAS unsigned char* lds, int i) {
    const volatile LAS unsigned* p = (const volatile LAS unsigned*)(lds + PTR_OFF) + 2 * i;
    const unsigned lo = __builtin_amdgcn_readfirstlane(p[0]), hi = __builtin_amdgcn_readfirstlane(p[1]);
    return ((unsigned long long)hi << 32) | lo;
}

#define XB_TMO      128
#define XB_XCNT(j)  (256  + 64 * (j))
#define XB_XSUB(j)  (1280 + 64 * (j))
#define XB_XGEN(j)  (2304 + 64 * (j))
#define XB_TOP      3328
#define XB_TOPGEN   3392
#define XCD_BAR_WORDS 3456
#define XB_SPIN_CAP (1u << 18)
__device__ __forceinline__ unsigned xb_ld(unsigned* p)              { return __hip_atomic_load(p, __ATOMIC_RELAXED, __HIP_MEMORY_SCOPE_AGENT); }
__device__ __forceinline__ unsigned xb_add(unsigned* p, unsigned v) { return __hip_atomic_fetch_add(p, v, __ATOMIC_RELAXED, __HIP_MEMORY_SCOPE_AGENT); }
__device__ __forceinline__ unsigned xb_xcc_id() { return (unsigned)__builtin_amdgcn_s_getreg((3 << 11) | 20) & 0xFu; }
#define XB_SPIN(cond, bar) do { unsigned _sp = 0; while (cond) { __builtin_amdgcn_s_sleep(1); \
    if ((++_sp & 255u) == 0u) { if (xb_ld(&(bar)[XB_TMO])) break; if (_sp > XB_SPIN_CAP) { atomicAdd(&(bar)[XB_TMO], 1u); break; } } } } while (0)
struct XcdBarrier { unsigned* bar; unsigned x; volatile LAS unsigned* st; };
__device__ __forceinline__ XcdBarrier xcd_barrier_post(unsigned* bar, volatile LAS unsigned* st) {
    XcdBarrier b; b.bar = bar; b.x = xb_xcc_id(); b.st = st;
    if (threadIdx.x == 0) (void)xb_add(&bar[XB_XCNT(b.x)], 1u);
    return b;
}
__device__ __forceinline__ void xcd_barrier_complete(unsigned* bar, unsigned x, unsigned& nloc, unsigned& nx) {
    const unsigned G = gridDim.x * gridDim.y * gridDim.z;
    unsigned sum, cnt, mine, sp = 0u;
    for (;;) {
        sum = 0u; cnt = 0u; mine = 0u;
#pragma unroll
        for (unsigned j = 0; j < 16; ++j) { const unsigned c = xb_ld(&bar[XB_XCNT(j)]); sum += c; cnt += (c > 0u) ? 1u : 0u; mine = (j == x) ? c : mine; }
        if (sum == G) break;
        __builtin_amdgcn_s_sleep(1);
        if ((++sp & 255u) == 0u) { if (xb_ld(&bar[XB_TMO])) break; if (sp > XB_SPIN_CAP) { atomicAdd(&bar[XB_TMO], 1u); break; } }
    }
    nloc = mine > 0u ? mine : 1u; nx = cnt > 0u ? cnt : 1u;
}
__device__ __forceinline__ void xcd_barrier(LAS unsigned char* lds) {
    asm volatile("s_waitcnt vmcnt(0)" ::: "memory");
    __syncthreads();
    if (threadIdx.x == 0) {
        XcdBarrier b; b.bar = (unsigned*)(lds_ptr(lds, 27) + WS_CTL) + CW_BAR; b.x = xb_xcc_id(); b.st = (volatile LAS unsigned*)(lds + MISC_OFF) + 8;
        unsigned* bar = b.bar; unsigned bx_ = b.x;
        asm volatile("" : "+v"(bar), "+s"(bx_));
        __builtin_amdgcn_s_waitcnt(0);
        unsigned nloc = b.st[0], nx = b.st[1];
        if (nloc == 0u) { xcd_barrier_complete(bar, bx_, nloc, nx); b.st[0] = nloc; b.st[1] = nx; }
        const unsigned old = xb_add(&bar[XB_XSUB(bx_)], 1u);
        const unsigned gen = old / nloc;
        if (old + 1u == (gen + 1u) * nloc) {
            __builtin_amdgcn_fence(__ATOMIC_RELEASE, "agent");
            asm volatile("s_waitcnt vmcnt(0)" ::: "memory");
            const unsigned og = xb_add(&bar[XB_TOP], 1u);
            const unsigned tg = og / nx;
            if (og + 1u == (tg + 1u) * nx) xb_add(&bar[XB_TOPGEN], 1u);
            else XB_SPIN(xb_ld(&bar[XB_TOPGEN]) == tg, bar);
            __builtin_amdgcn_fence(__ATOMIC_ACQUIRE, "agent");
            xb_add(&bar[XB_XGEN(bx_)], 1u);
            asm volatile("s_waitcnt vmcnt(0)" ::: "memory");
        } else {
            XB_SPIN(xb_ld(&bar[XB_XGEN(bx_)]) == gen, bar);
            __builtin_amdgcn_fence(__ATOMIC_ACQUIRE, "agent");
            asm volatile("s_waitcnt vmcnt(0)" ::: "memory");
        }
    }
    __syncthreads();
}

struct Args { const float* in[26]; float* out; unsigned char* ws; int ph_lo, ph_hi; };
enum { I_X = 0, I_C, I_ADAW, I_ADAB, I_NMG, I_WIN, I_BIN, I_CONVW, I_CONVB, I_WA, I_BA, I_WX, I_BX, I_LAM, I_POOLW, I_POOLB, I_POOLS, I_PROJA, I_PROJB, I_WOUT, I_NFG, I_WUP, I_FCW, I_FCB, I_WDOWN, I_FING };

template <bool BIAS>
__device__ __forceinline__ void cvt_item(const float* src, int N, bf16_t* dst, int dpitch, int k0, int n0, int drow0, int dcol, int lane,
                                         const float* sh0 = nullptr, const float* sh1 = nullptr, float* bias0 = nullptr, float* bias1 = nullptr, const float* binit = nullptr, int dstep = 32, const float* shm = nullptr) {
    const int r = lane >> 3, q = lane & 7;
    f32x4 s0 = (f32x4){0.f, 0.f, 0.f, 0.f}, s1 = s0, t0 = s0, t1 = s0;
    f32x4 vv[2][8];
#pragma unroll
    for (int c = 0; c < 2; ++c)
#pragma unroll
        for (int j = 0; j < 8; ++j) vv[c][j] = __builtin_nontemporal_load((const f32x4*)(src + (size_t)(k0 + 8 * r + j) * N + n0 + 32 * c + 4 * q));
    if constexpr (BIAS) {
        const int kk = k0 + 8 * r; f32x4 a0 = *(const f32x4*)(sh0 + kk), a1 = *(const f32x4*)(sh0 + kk + 4), b0 = *(const f32x4*)(sh1 + kk), b1 = *(const f32x4*)(sh1 + kk + 4);
        if (shm) { const f32x4 m0 = *(const f32x4*)(shm + kk), m1 = *(const f32x4*)(shm + kk + 4); a0 *= m0; a1 *= m1; b0 *= m0; b1 *= m1; }
#pragma unroll
        for (int j = 0; j < 4; ++j) { s0 += a0[j] * vv[0][j] + a1[j] * vv[0][4 + j]; s1 += b0[j] * vv[0][j] + b1[j] * vv[0][4 + j]; t0 += a0[j] * vv[1][j] + a1[j] * vv[1][4 + j]; t1 += b0[j] * vv[1][j] + b1[j] * vv[1][4 + j]; }
    }
#pragma unroll
    for (int c = 0; c < 2; ++c) {
        const f32x4 (&v)[8] = vv[c];
#pragma unroll
        for (int i = 0; i < 4; ++i) { u32x4 w; w.x = cvt_pk_bf16(v[0][i], v[1][i]); w.y = cvt_pk_bf16(v[2][i], v[3][i]); w.z = cvt_pk_bf16(v[4][i], v[5][i]); w.w = cvt_pk_bf16(v[6][i], v[7][i]);
            *(u32x4*)(dst + (size_t)(drow0 + dstep * c + 4 * q + i) * dpitch + dcol + k0 + 8 * r) = w; }
    }
    if constexpr (BIAS) {
        const int ii = r & 3, cc = r >> 2, col = 32 * cc + 4 * q + ii;
        f32x4 k0 = cc ? t0 : s0, x0 = cc ? s0 : t0, k1 = cc ? t1 : s1, x1 = cc ? s1 : t1;
#pragma unroll
        for (int i = 0; i < 4; ++i) { k0[i] += __shfl_xor(x0[i], 32); k1[i] += __shfl_xor(x1[i], 32); }
        const bool h1 = (r & 2) != 0, h0 = (r & 1) != 0;
        float a0 = h1 ? k0[2] : k0[0], a1 = h1 ? k0[3] : k0[1], b0 = h1 ? k1[2] : k1[0], b1 = h1 ? k1[3] : k1[1];
        const float xa0 = h1 ? k0[0] : k0[2], xa1 = h1 ? k0[1] : k0[3], xb0 = h1 ? k1[0] : k1[2], xb1 = h1 ? k1[1] : k1[3];
        a0 += __shfl_xor(xa0, 16); a1 += __shfl_xor(xa1, 16); b0 += __shfl_xor(xb0, 16); b1 += __shfl_xor(xb1, 16);
        float v0 = h0 ? a1 : a0, v1 = h0 ? b1 : b0;
        v0 += __shfl_xor(h0 ? a0 : a1, 8); v1 += __shfl_xor(h0 ? b0 : b1, 8);
        if (binit) { const float bi = binit[n0 + col]; v0 += bi; v1 += bi; }
        const int brow = drow0 + dstep * cc + 4 * q + ii;
        bias0[brow] = v0; bias1[brow] = v1;
    }
}
constexpr int IT_WIN = (DM / 64) * (DIN / 64), IT_LRU = 16 * 16, IT_POOL = 4 * 16, IT_PA = 32 * 32, IT_PB = 16 * 32, IT_WO = 32 * 32, IT_WUP = 32 * (DUP / 64), IT_WD = (DFF / 64) * 32;
constexpr int IT_LAYER = IT_WIN + IT_PB + IT_LRU + IT_PA + IT_WO + IT_WUP + IT_WD;
__device__ __forceinline__ void cvt_one(const Args& a, int it, int lane) {
    const float* mod = (const float*)(a.ws + WS_MOD);
    {
        const int l = it / IT_LAYER; int r = it % IT_LAYER;
        bf16_t* wl = (bf16_t*)(a.ws + WS_W + (size_t)l * W_LAYER);
        const float* sh = mod + (size_t)l * NB * NADA;
        if (r < IT_WIN) { const int kb = r / (DIN / 64), nb = r % (DIN / 64), n0 = 64 * nb; int drow = n0;
            int dstep = 32;
            if (n0 >= 5120) { const int gsel = n0 - 5120, isb = gsel / 2048, ch = gsel % 2048; drow = 5120 + 256 * (ch / 128) + 64 * ((ch % 128) / 32) + 32 * isb; dstep = 64; }
            float* bo = (float*)(a.ws + WS_PB1) + ((size_t)(l * NB) * 32 + kb) * DIN;
            cvt_item<true>(a.in[I_WIN] + (size_t)l * DM * DIN, DIN, wl + W_BT1 / 2, DM, 64 * kb, n0, drow, 0, lane, sh, sh + NADA, bo, bo + (size_t)32 * DIN, kb == 0 ? a.in[I_BIN] + (size_t)l * DIN : nullptr, dstep); return; } r -= IT_WIN;
        if (r < IT_PB) { const int kb = r / 32, nb = r % 32;
            float* bo = (float*)(a.ws + WS_PB3) + ((size_t)(l * 2) * 16 + kb) * DM;
            cvt_item<true>(a.in[I_PROJB] + (size_t)l * DPOOL * DM, DM, wl + W_BT3 / 2, 3072, 64 * kb, 64 * nb, 64 * nb, 2048, lane, a.in[I_POOLB] + (size_t)l * DPOOL, a.in[I_POOLB] + (size_t)l * DPOOL, bo, bo + (size_t)16 * DM, nullptr, 32, a.in[I_POOLS] + (size_t)l * DPOOL); return; } r -= IT_PB;
        if (r < IT_LRU) { const int mat = r / 16, idx = r % 16, isx = mat / 8, h = mat % 8, kb = idx / 4, nb = idx % 4, n0 = 64 * nb;
            const float* src = a.in[isx ? I_WX : I_WA] + ((size_t)l * 8 + h) * 256 * 256;
            cvt_item<false>(src, 256, wl + W_BTG / 2, 256, 64 * kb, n0, 512 * h + 256 * (n0 / 128) + 64 * ((n0 % 128) / 32) + 32 * isx, 0, lane, nullptr, nullptr, nullptr, nullptr, nullptr, 64); return; } r -= IT_LRU;
        if (r < IT_PA) { const int kb = r / 32, nb = r % 32; cvt_item<false>(a.in[I_PROJA] + (size_t)l * DRNN * DM, DM, wl + W_BT3 / 2, 3072, 64 * kb, 64 * nb, 64 * nb, 0, lane); return; } r -= IT_PA;
        if (r < IT_WO) { const int kb = r / 32, nb = r % 32; cvt_item<false>(a.in[I_WOUT] + (size_t)l * DM * DM, DM, wl + W_BT4 / 2, DM, 64 * kb, 64 * nb, 64 * nb, 0, lane); return; } r -= IT_WO;
        if (r < IT_WUP) { const int kb = r / (DUP / 64), nb = r % (DUP / 64), n0 = 64 * nb, isl = n0 / DFF, ch = n0 % DFF;
            float* bo = (float*)(a.ws + WS_PB2) + ((size_t)(l * NB) * 32 + kb) * DUP;
            cvt_item<true>(a.in[I_WUP] + (size_t)l * DM * DUP, DUP, wl + W_BT5 / 2, DM, 64 * kb, n0, 256 * (ch / 128) + 128 * isl + (ch % 128), 0, lane, sh + 3 * DM, sh + NADA + 3 * DM, bo, bo + (size_t)32 * DUP, nullptr); return; } r -= IT_WUP;
        { const int kb = r / 32, nb = r % 32; cvt_item<false>(a.in[I_WDOWN] + (size_t)l * DFF * DM, DM, wl + W_BT6 / 2, DFF, 64 * kb, 64 * nb, 64 * nb, 0, lane); }
    }
}
__device__ __forceinline__ void p0_convert(const Args& a, int lo, int hi, int widx, int nw, int lane, unsigned* cnt = nullptr, int shard = 0) {
    if (cnt == nullptr) { for (int it = lo + widx; it < hi; it += nw) cvt_one(a, it, lane); return; }
    const int per = (hi - lo + 7) / 8, slo = lo + shard * per, shi = (slo + per < hi) ? slo + per : hi;
    unsigned base = 0; if (lane == 0) base = atomicAdd(cnt + 64 * shard, 2u);
    for (;;) {
        const int it0 = slo + (int)__builtin_amdgcn_readfirstlane(base);
        if (it0 >= shi) break;
        unsigned nbase = 0; if (lane == 0) nbase = atomicAdd(cnt + 64 * shard, 2u);
        cvt_one(a, it0, lane); if (it0 + 1 < shi) cvt_one(a, it0 + 1, lane);
        base = nbase;
    }
}
constexpr int CVT_A_LO = 0, CVT_A_HI = IT_WIN + IT_PB;
__host__ __device__ constexpr int cvt_b_lo(int l) { return l * IT_LAYER + IT_WIN + IT_PB; }
__host__ __device__ constexpr int cvt_b_hi(int l) { return (l + 1) * IT_LAYER - IT_WD; }
__host__ __device__ constexpr int cvt_c_lo(int l) { return (l + 1) * IT_LAYER - IT_WD; }
__host__ __device__ constexpr int cvt_c_hi(int l) { return l + 1 < NL ? (l + 1) * IT_LAYER + IT_WIN : (l + 1) * IT_LAYER; }
__device__ __forceinline__ void p0_ada(const Args& a, LAS unsigned char* lds, int G, int tid, int bx) {
    const int wave = tid >> 6, lane = tid & 63;
    LAS float* cact = (LAS float*)lds;
    LAS float* red = (LAS float*)(lds + 16384);
    for (int i = tid; i < NB * DM; i += 512) { const float v = a.in[I_C][i]; cact[i] = v * sigmoid_f(v); }
    __syncthreads();
    float* mod = (float*)(a.ws + WS_MOD);
    constexpr int NU = NL * (NADA / 32);
    int un[3]; const float* wsrc[3];
#pragma unroll
    for (int j = 0; j < 3; ++j) { un[j] = 3 * bx + j;       const int uu = un[j] < NU ? un[j] : bx; const int l = uu / (NADA / 32), nb = uu % (NADA / 32);
        wsrc[j] = a.in[I_ADAW] + (size_t)l * DM * NADA + nb * 32 + 4 * (lane & 7); }
    f32x4 s0[3], s1[3];
#pragma unroll
    for (int j = 0; j < 3; ++j) { s0[j] = (f32x4){0.f, 0.f, 0.f, 0.f}; s1[j] = s0[j]; }
#pragma unroll 4
    for (int rg = wave; rg < 256; rg += 8) { const int k = rg * 8 + (lane >> 3); const float c0 = cact[k], c1 = cact[DM + k];
#pragma unroll
        for (int j = 0; j < 3; ++j) { const f32x4 wv = __builtin_nontemporal_load((const f32x4*)(wsrc[j] + (size_t)k * NADA)); s0[j] += c0 * wv; s1[j] += c1 * wv; } }
#pragma unroll
    for (int j = 0; j < 3; ++j) {
#pragma unroll
        for (int i = 0; i < 4; ++i) {
#pragma unroll
            for (int o = 8; o < 64; o <<= 1) { s0[j][i] += __shfl_xor(s0[j][i], o); s1[j][i] += __shfl_xor(s1[j][i], o); } }
        if (lane < 8) {
#pragma unroll
            for (int i = 0; i < 4; ++i) { red[((j * 8 + wave) * 2 + 0) * 32 + 4 * lane + i] = s0[j][i]; red[((j * 8 + wave) * 2 + 1) * 32 + 4 * lane + i] = s1[j][i]; } } }
    __syncthreads();
    if (tid < 192) { const int j = tid >> 6, b = (tid >> 5) & 1, c = tid & 31;
        if (un[j] < NU) { const int l = un[j] / (NADA / 32), nb = un[j] % (NADA / 32); float s = 0.f;
#pragma unroll
            for (int w = 0; w < 8; ++w) s += red[((j * 8 + w) * 2 + b) * 32 + c];
            mod[((size_t)l * NB + b) * NADA + nb * 32 + c] = s + a.in[I_ADAB][(size_t)l * NADA + nb * 32 + c]; } }
    __syncthreads();
}

__device__ __forceinline__ void p0b(const Args& a, int gw, int ngw, int lane, int gtid, int ngt) {
    const float* mod = (const float*)(a.ws + WS_MOD);
    for (int i = gtid; i < NL * NB * DM; i += ngt) { const int l = i / (NB * DM), b = (i / DM) % NB, c = i % DM; const float* mm = mod + ((size_t)l * NB + b) * NADA;
        ((float*)(a.ws + WS_GM1))[i] = a.in[I_NMG][l * DM + c] * (1.f + mm[DM + c]);
        ((float*)(a.ws + WS_GT1))[i] = mm[2 * DM + c];
        ((float*)(a.ws + WS_GM2))[i] = a.in[I_NFG][l * DM + c] * (1.f + mm[4 * DM + c]);
        ((float*)(a.ws + WS_GT2))[i] = mm[5 * DM + c]; }
    for (int i = gtid; i < NL * DRNN; i += ngt) { const float lam = a.in[I_LAM][i]; ((float*)(a.ws + WS_LRUK))[i] = -8.0f * log1pf(expf(-lam)); }
    p0_convert(a, CVT_A_LO, CVT_A_HI, gw, ngw, lane);
    for (int l = 1; l < NL; ++l) p0_convert(a, l * IT_LAYER + IT_WIN, l * IT_LAYER + IT_WIN + IT_PB, gw, ngw, lane);
    for (int i = gtid; i < NL * 4 * 256 * 256 / 4; i += ngt) { const int e = 4 * i, l = e / (4 * 65536), g = (e >> 16) & 3, j = e & 255;
        const f32x4 w = *(const f32x4*)(a.in[I_POOLW] + e) * *(const f32x4*)(a.in[I_POOLS] + (size_t)l * DPOOL + g * 256 + j);
        u32x2 pk; pk.x = cvt_pk_bf16(w[0], w[1]); pk.y = cvt_pk_bf16(w[2], w[3]);
        *(u32x2*)((bf16_t*)(a.ws + WS_W + (size_t)l * W_LAYER + W_BTP) + (e & (4 * 65536 - 1))) = pk; }
    float* ss = (float*)(a.ws + WS_SS); bf16_t* xg = (bf16_t*)(a.ws + WS_XG);
    for (int row = gw; row < M; row += ngw) { const int b = row / SEQ; const float* xr = a.in[I_X] + (size_t)row * DM; const float* mm = mod + (size_t)b * NADA + DM; float s = 0.f;
#pragma unroll
        for (int j = 0; j < 8; ++j) { const int c = (j * 64 + lane) * 4; const f32x4 xv = __builtin_nontemporal_load((const f32x4*)(xr + c)), gv = *(const f32x4*)(a.in[I_NMG] + c), sc = *(const f32x4*)(mm + c);
            s += (xv[0] * xv[0] + xv[1] * xv[1]) + (xv[2] * xv[2] + xv[3] * xv[3]); const f32x4 y = xv * (gv * (1.f + sc));
            u32x2 w; w.x = cvt_pk_bf16(y[0], y[1]); w.y = cvt_pk_bf16(y[2], y[3]); *(u32x2*)(xg + (size_t)row * DM + c) = w; }
        s = wave_sum(s);
        if (lane < 8) ss[(size_t)lane * M + row] = lane == 0 ? s : 0.f; }
}

__device__ __forceinline__ void build_xr_tile(const Args& a, int l, int pm, int head, int tid) {
    const int strip = tid >> 5, c = head * 256 + (tid & 31) * 8, row0 = pm * 256 + strip * 16, t0 = row0 % SEQ;
    const float* cw = a.in[I_CONVW] + (size_t)l * 4 * DRNN + c; const float* cb = a.in[I_CONVB] + (size_t)l * DRNN + c;
    f32x4 w0[4], w1[4];
#pragma unroll
    for (int k = 0; k < 4; ++k) { w0[k] = *(const f32x4*)(cw + (size_t)k * DRNN); w1[k] = *(const f32x4*)(cw + (size_t)k * DRNN + 4); }
    const f32x4 b0 = *(const f32x4*)cb, b1 = *(const f32x4*)(cb + 4);
    const bf16_t* src = (const bf16_t*)(a.ws + WS_XRNN) + (size_t)row0 * DRNN + c; bf16_t* dst = (bf16_t*)(a.ws + WS_XR) + (size_t)row0 * DRNN + c;
    u32x4 wr_[19];
#pragma unroll
    for (int d = 0; d < 3; ++d) { wr_[d] = (u32x4){0u, 0u, 0u, 0u}; if (t0 >= 3 - d) wr_[d] = *(const u32x4*)(src - (size_t)(3 - d) * DRNN); }
#pragma unroll
    for (int j = 0; j < 16; ++j) wr_[3 + j] = *(const u32x4*)(src + (size_t)j * DRNN);
    f32x4 h0[3], h1[3];
#pragma unroll
    for (int d = 0; d < 3; ++d) pg8::unpack8(wr_[d], h0[d], h1[d]);
#pragma unroll
    for (int j = 0; j < 16; ++j) { const u32x4 w = wr_[3 + j]; f32x4 x0, x1; pg8::unpack8(w, x0, x1);
        const f32x4 o0 = b0 + w0[0] * h0[0] + w0[1] * h0[1] + w0[2] * h0[2] + w0[3] * x0, o1 = b1 + w1[0] * h1[0] + w1[1] * h1[1] + w1[2] * h1[2] + w1[3] * x1;
        *(u32x4*)(dst + (size_t)j * DRNN) = pg8::pack8(o0, o1);
        h0[0] = h0[1]; h0[1] = h0[2]; h0[2] = x0; h1[0] = h1[1]; h1[1] = h1[2]; h1[2] = x1; }
}
template <int WIN>
__device__ __forceinline__ void build_pp_rows(const bf16_t* src, bf16_t* dst, int t0) {
    u32x4 w[15 + WIN];
#pragma unroll
    for (int d = 0; d < WIN - 1; ++d) { w[d] = (u32x4){0u, 0u, 0u, 0u}; if (t0 >= WIN - 1 - d) w[d] = *(const u32x4*)(src - (size_t)(WIN - 1 - d) * DPOOL); }
#pragma unroll
    for (int j = 0; j < 16; ++j) w[WIN - 1 + j] = *(const u32x4*)(src + (size_t)j * DPOOL);
    f32x4 s0 = (f32x4){0.f, 0.f, 0.f, 0.f}, s1 = s0;
#pragma unroll
    for (int d = WIN - 2; d >= 0; --d) { f32x4 y0, y1; pg8::unpack8(w[d], y0, y1); s0 += y0; s1 += y1; }
#pragma unroll
    for (int j = 0; j < 16; ++j) { const int t = t0 + j; f32x4 x0, x1; pg8::unpack8(w[WIN - 1 + j], x0, x1); s0 += x0; s1 += x1;
        const float inv = 1.0f / (float)((t + 1 < WIN) ? t + 1 : WIN);
        *(u32x4*)(dst + (size_t)j * 3072) = pg8::pack8(s0 * inv - x0, s1 * inv - x1);
        { f32x4 y0, y1; pg8::unpack8(w[j], y0, y1); s0 -= y0; s1 -= y1; } }
}
__device__ __forceinline__ void build_pp_tile(const Args& a, int pm, int g, int tid) {
    const int strip = tid >> 5, c = g * 256 + (tid & 31) * 8, row0 = pm * 256 + strip * 16, t0 = row0 % SEQ;
    const bf16_t* src = (const bf16_t*)(a.ws + WS_XPOOL) + (size_t)row0 * DPOOL + c; bf16_t* dst = (bf16_t*)(a.ws + WS_YAB) + (size_t)row0 * 3072 + 2048 + c;
    if (g == 0) build_pp_rows<2>(src, dst, t0); else if (g == 1) build_pp_rows<4>(src, dst, t0); else if (g == 2) build_pp_rows<8>(src, dst, t0); else build_pp_rows<16>(src, dst, t0);
}

__device__ __forceinline__ void p5_fixup(const Args& a, int l, int gtid, int ngt) {
    const float* uh = (const float*)(a.ws + WS_UH); bf16_t* act = (bf16_t*)(a.ws + WS_ACT);
    const float* cw = a.in[I_FCW] + (size_t)l * 3 * DUP; const float* cb = a.in[I_FCB] + (size_t)l * DUP;
    constexpr int NQ = DFF / 4;
    for (int it = gtid; it < 128 * 2 * NQ; it += ngt) { const int ch = 4 * (it % NQ), r = (it / NQ) & 1, sb = it / (2 * NQ), row = 64 * sb + r;
        const int j = ch / 128, w = ch % 128; const bool edge = (sb % 64) == 0; f32x4 cv[2]; const f32x4 z4 = (f32x4){0.f, 0.f, 0.f, 0.f};
#pragma unroll
        for (int bj = 0; bj < 2; ++bj) { const int tc = 256 * j + 128 * bj + w, nc = bj * DFF + ch;
            const f32x4 u0 = *(const f32x4*)(uh + ((size_t)sb * 4 + r) * DUP + tc);
            f32x4 u1 = z4, u2 = z4;
            if (r == 1) { u1 = *(const f32x4*)(uh + ((size_t)sb * 4 + 0) * DUP + tc); if (!edge) u2 = *(const f32x4*)(uh + ((size_t)(sb - 1) * 4 + 3) * DUP + tc); }
            else if (!edge) { u1 = *(const f32x4*)(uh + ((size_t)(sb - 1) * 4 + 3) * DUP + tc); u2 = *(const f32x4*)(uh + ((size_t)(sb - 1) * 4 + 2) * DUP + tc); }
            cv[bj] = *(const f32x4*)(cb + nc) + *(const f32x4*)(cw + 2 * DUP + nc) * u0 + *(const f32x4*)(cw + DUP + nc) * u1 + *(const f32x4*)(cw + nc) * u2; }
        f32x4 o;
#pragma unroll
        for (int i = 0; i < 4; ++i) o[i] = cv[0][i] * sigmoid_f(cv[0][i]) * cv[1][i];
        u32x2 pk; pk.x = cvt_pk_bf16(o[0], o[1]); pk.y = cvt_pk_bf16(o[2], o[3]);
        *(u32x2*)(act + (size_t)(row + 8 * ((ch >> 5) & 1)) * DFF + (ch & ~32)) = pk; }
}

__device__ __forceinline__ void p_final(const Args& a, int gw, int ngw, int lane) {
    const float* X = (const float*)(a.ws + WS_X); const float* ss = (const float*)(a.ws + WS_SS);
    for (int row = gw; row < M; row += ngw) { const float rs = pg8::row_rstd(ss, row);
#pragma unroll
        for (int j = 0; j < 8; ++j) { const int c = (j * 64 + lane) * 4; *(f32x4*)(a.out + (size_t)row * DM + c) = *(const f32x4*)(X + (size_t)row * DM + c) * rs * *(const f32x4*)(a.in[I_FING] + c); } }
}

constexpr int PH_P0A = 0, PH_P0B = 1, PH_LAYER0 = 2, PH_PER_LAYER = 7, PH_FINAL = -1000, N_PHASES = PH_LAYER0 + NL * PH_PER_LAYER;
__host__ __device__ constexpr int phase_kind(int ph) {
    if (ph == PH_P0A) return 0; if (ph == PH_P0B) return 1; if (ph == PH_FINAL) return 11;
    const int sub = (ph - PH_LAYER0) % PH_PER_LAYER;
    return sub == 0 ? 2 : sub == 1 ? 4 : 4 + sub;
}
template <int KIND, bool DUMMY = false>
__device__ __forceinline__ void run_kind(int ph, LAS unsigned char* lds) {
    int tid = threadIdx.x, bx = blockIdx.x, G = gridDim.x; asm volatile("" : "+v"(tid), "+s"(bx), "+s"(G));
    const int lane = tid & 63, wave = __builtin_amdgcn_readfirstlane(tid >> 6);
    const int vcu = (G % 8 == 0) ? (bx % 8) * (G / 8) + bx / 8 : bx;
    const int gw = vcu * NWAVES + wave, ngw = G * NWAVES, gtid = bx * 512 + tid, ngt = G * 512;
    Args a;
#pragma unroll
    for (int i = 0; i < 26; ++i) a.in[i] = (const float*)(const __attribute__((address_space(1))) float*)lds_ptr(lds, i);
    a.out = (float*)(__attribute__((address_space(1))) float*)lds_ptr(lds, 26); a.ws = (unsigned char*)(__attribute__((address_space(1))) unsigned char*)lds_ptr(lds, 27);
    asm volatile("" : "+s"(ph));
    const int l = (ph - PH_LAYER0) / PH_PER_LAYER;
    const bf16_t* wl = (const bf16_t*)(a.ws + WS_W + (size_t)l * W_LAYER);
    const float* ss = (const float*)(a.ws + WS_SS);
    pg8::StaticOrder S;
    if constexpr (KIND == 0) { p0_ada(a, lds, G, tid, bx); }
    else if constexpr (KIND == 1) { p0b(a, gw, ngw, lane, gtid, ngt); }
    else if constexpr (KIND == 11) { p_final(a, gw, ngw, lane); }
    else if constexpr (KIND == 2) {
        const int GGm = (G == 256 && !DUMMY) ? P1_GEMM_WGS : G;
        pg8::Gemm g{(const bf16_t*)(a.ws + WS_XG), wl + W_BT1 / 2, DM, DM, DM / 64, M / 256, DIN / 256, 31, 0}; S.init(g.nM, g.nN, GGm, bx);
        if (bx < GGm) {
        pg8::fill_tabs(lds, S, ss, (const float*)(a.ws + WS_PB1) + (size_t)(l * NB) * 32 * DIN, DIN, tid);
        pg8::EpiZ E{(const LAS float*)(lds + pg8::TAB_OFF), (const LAS float*)(lds + pg8::BTAB_OFF), (bf16_t*)(a.ws + WS_XRNN), (bf16_t*)(a.ws + WS_GG), (bf16_t*)(a.ws + WS_XPOOL), (bf16_t*)(a.ws + WS_RATIO), -1};
        pg8::gemm_phase<pg8::EpiZ, true>(lds, g, S, E);
        }
        if (!DUMMY && l == 0 && bx >= GGm) {
            for (int ll = 0; ll < NL; ++ll) { const bf16_t* wll = (const bf16_t*)(a.ws + WS_W + (size_t)ll * W_LAYER);
                pg8::Gemm gw_{wll + W_BTP / 2, wll + W_BT3 / 2 + 2048, 256, 3072, 4, 4, 8, 31, 0}; gw_.b_pm = 512;
                pg8::StaticOrder Sw; Sw.init(gw_.nM, gw_.nN, G - GGm, bx - GGm);
                pg8::EpiWp Ew{(bf16_t*)(a.ws + WS_W + (size_t)ll * W_LAYER + W_BT3) + 2048, -1};
                pg8::gemm_phase<pg8::EpiWp, true>(lds, gw_, Sw, Ew); } }
        if (!DUMMY) p0_convert(a, cvt_b_lo(l), cvt_b_hi(l), gw, ngw, lane, (unsigned*)(a.ws + WS_CTL) + CW_CVT + 512 * (2 * l), bx & 7);
    } else if constexpr (KIND == 4) {
        { pg8::Gemm g{(const bf16_t*)(a.ws + WS_XR), wl + W_BTG / 2, DRNN, 256, 4, M / 256, 16, 1, 256}; pg8::GateOrder GO{bx};
          { pg8::Unit u; for (int i = 0; i < 2 && GO.next(i, u); ++i) build_xr_tile(a, l, u.pm, u.pn >> 1, tid); }
          asm volatile("s_waitcnt vmcnt(0)" ::: "memory"); __syncthreads();
          pg8::EpiGates E{a.in[I_BA] + (size_t)l * DRNN, a.in[I_BX] + (size_t)l * DRNN, (const float*)(a.ws + WS_LRUK) + (size_t)l * DRNN, (const bf16_t*)(a.ws + WS_XR), (const bf16_t*)(a.ws + WS_GG), (bf16_t*)(a.ws + WS_YAB),
                          (unsigned long long*)(a.ws + WS_AGG) + (size_t)l * NB * 16 * DRNN, lds, -1};
          pg8::gemm_phase<pg8::EpiGates, true, pg8::GateOrder>(lds, g, GO, E); }
    } else if constexpr (KIND == 12) {
        { S.init(M / 256, 4, G, bx); pg8::Unit u; for (int i = 0; i < 8 && S.next(i, u); ++i) build_pp_tile(a, u.pm, u.pn, tid); }
    } else if constexpr (KIND == 6) {
        pg8::Gemm g{(const bf16_t*)(a.ws + WS_YAB), wl + W_BT3 / 2, 3072, 3072, 48, M / 256, DM / 256, 31, 0}; S.init(g.nM, g.nN, G, bx);
        { pg8::Unit u0;
          if (S.next(0, u0) && tid < 256) { const float* p = (const float*)(a.ws + WS_PB3) + (size_t)(l * 2) * 16 * DM + u0.pn * 256 + tid; float s = 0.f;
#pragma unroll
              for (int kb = 0; kb < 16; ++kb) s += p[(size_t)kb * DM];
              ((LAS float*)(lds + pg8::TAB_OFF))[tid] = s; }
          __syncthreads(); }
        pg8::EpiMerge E{(const bf16_t*)(a.ws + WS_RATIO), (bf16_t*)(a.ws + WS_MERGED), (const LAS float*)(lds + pg8::TAB_OFF), 32};
        pg8::gemm_phase<pg8::EpiMerge, false>(lds, g, S, E);
    } else if constexpr (KIND == 7) {
        pg8::Gemm g{(const bf16_t*)(a.ws + WS_MERGED), wl + W_BT4 / 2, DM, DM, DM / 64, M / 256, DM / 256, 31, 0}; S.init(g.nM, g.nN, G, bx);
        const float* gt1 = (const float*)(a.ws + WS_GT1) + (size_t)l * NB * DM; const float* gm2 = (const float*)(a.ws + WS_GM2) + (size_t)l * NB * DM;
        if (l == 0) { pg8::EpiResid<true> E{a.in[I_X], nullptr, nullptr, (bf16_t*)(a.ws + WS_XG), gt1, gm2, (float*)(a.ws + WS_SS), -1}; pg8::gemm_phase<pg8::EpiResid<true>, false>(lds, g, S, E); }
        else { pg8::EpiResid<false> E{nullptr, (const bf16_t*)(a.ws + WS_XG), (const float*)(a.ws + WS_GM1) + (size_t)l * NB * DM, (bf16_t*)(a.ws + WS_XG), gt1, gm2, (float*)(a.ws + WS_SS), -1}; pg8::gemm_phase<pg8::EpiResid<false>, false>(lds, g, S, E); }
    } else if constexpr (KIND == 8) {
        const int GGm = (G == 256 && !DUMMY) ? P5_GEMM_WGS : G;
        pg8::Gemm g{(const bf16_t*)(a.ws + WS_XG), wl + W_BT5 / 2, DM, DM, DM / 64, M / 256, DUP / 256, 31, 0}; S.init(g.nM, g.nN, GGm, bx);
        if (bx < GGm) {
        pg8::fill_tabs(lds, S, ss, (const float*)(a.ws + WS_PB2) + (size_t)(l * NB) * 32 * DUP, DUP, tid);
        pg8::EpiUp E{(const LAS float*)(lds + pg8::TAB_OFF), (const LAS float*)(lds + pg8::BTAB_OFF), a.in[I_FCW] + (size_t)l * 3 * DUP, a.in[I_FCB] + (size_t)l * DUP, (bf16_t*)(a.ws + WS_ACT), (float*)(a.ws + WS_UH), -1};
        pg8::gemm_phase<pg8::EpiUp, true>(lds, g, S, E);
        }
        if (!DUMMY) p0_convert(a, cvt_c_lo(l), cvt_c_hi(l), gw, ngw, lane, (unsigned*)(a.ws + WS_CTL) + CW_CVT + 512 * (2 * l + 1), bx & 7);
    } else if constexpr (KIND == 9) { p5_fixup(a, l, gtid, ngt);
    } else {
        pg8::Gemm g{(const bf16_t*)(a.ws + WS_ACT), wl + W_BT6 / 2, DFF, DFF, DFF / 64, M / 256, DM / 256, 31, 0, 1}; S.init(g.nM, g.nN, G, bx);
        if (l == NL - 1 && !DUMMY) {
            pg8::EpiFinal E{(const bf16_t*)(a.ws + WS_XG), (const float*)(a.ws + WS_GM2) + (size_t)l * NB * DM, a.out, (const float*)(a.ws + WS_GT2) + (size_t)l * NB * DM, a.in[I_FING], (unsigned*)(a.ws + WS_FSS), -1};
            pg8::gemm_phase<pg8::EpiFinal, false>(lds, g, S, E);
        } else {
        pg8::EpiResid<false> E{nullptr, (const bf16_t*)(a.ws + WS_XG), (const float*)(a.ws + WS_GM2) + (size_t)l * NB * DM, (bf16_t*)(a.ws + (DUMMY ? WS_RATIO : WS_XG)), (const float*)(a.ws + WS_GT2) + (size_t)l * NB * DM,
                        (const float*)(a.ws + WS_GM1) + (size_t)(l + 1 < NL ? l + 1 : l) * NB * DM, (float*)(a.ws + (DUMMY ? WS_AGG : WS_SS)), -1};
        pg8::gemm_phase<pg8::EpiResid<false>, false>(lds, g, S, E);
        }
    }
}
#define MK_PROLOGUE \
    extern __shared__ __attribute__((aligned(16))) unsigned char lds_raw[]; \
    LAS unsigned char* lds = (LAS unsigned char*)lds_raw; \
    const int tid = threadIdx.x; \
    volatile LAS unsigned* MISC = (volatile LAS unsigned*)(lds + MISC_OFF); \
    for (int u = tid; u < (LDS_BYTES - RING_BYTES) / 4; u += 512) ((LAS unsigned*)(lds + RING_BYTES))[u] = 0u; \
    __syncthreads(); \
    if (tid == 0) { LAS unsigned long long* pt = (LAS unsigned long long*)(lds + PTR_OFF); \
        _Pragma("unroll") for (int i = 0; i < 26; ++i) pt[i] = (unsigned long long)a.in[i]; \
        pt[26] = (unsigned long long)a.out; pt[27] = (unsigned long long)a.ws; } \
    __syncthreads();

#if MK_ONE_LAUNCH
template <int PH> __device__ __forceinline__ void run_from(LAS unsigned char* lds) {
    if constexpr (PH < N_PHASES) {
        if constexpr (PH == PROBE_PH) { run_kind<phase_kind(PH), true>(PH, lds); if constexpr (phase_kind(PH) == 4) run_kind<12, true>(PH, lds); xcd_barrier(lds); }
        run_kind<phase_kind(PH)>(PH, lds);
        if constexpr (phase_kind(PH) == 4) run_kind<12>(PH, lds);
        if constexpr (PH + 1 < N_PHASES) xcd_barrier(lds);
        run_from<PH + 1>(lds);
    }
}
__global__ void __launch_bounds__(NWAVES * 64, 2) mk_fwd(Args a) {
    MK_PROLOGUE
    (void)xcd_barrier_post((unsigned*)(a.ws + WS_CTL) + CW_BAR, MISC + 8);
    run_from<0>(lds);
}
#else
template <int KIND>
__global__ void __launch_bounds__(NWAVES * 64, 2) mk_phase(Args a) {
    MK_PROLOGUE
    (void)MISC;
    run_kind<KIND>(a.ph_lo, lds);
}
#endif

#if !MK_ONE_LAUNCH
template <int KIND> static void launch_kind(int grid, hipStream_t stream, const Args& a) {
    static bool attr = false;
    if (!attr) { (void)hipFuncSetAttribute((const void*)mk_phase<KIND>, hipFuncAttributeMaxDynamicSharedMemorySize, LDS_BYTES); attr = true; }
    hipLaunchKernelGGL(mk_phase<KIND>, dim3(grid), dim3(NWAVES * 64), LDS_BYTES, stream, a);
}
#endif
extern "C" void kernel_launch(void* const* d_in, const int* in_sizes, int n_in, void* d_out, int out_size, void* d_ws, size_t ws_size, hipStream_t stream) {
    static int grid = 0;
    if (grid == 0) {
        if (n_in != 26 || out_size != M * DM || ws_size < WS_END) { fprintf(stderr, "kernel_launch: unexpected problem (n_in %d out %d ws %zu need %zu)\n", n_in, out_size, ws_size, (size_t)WS_END); grid = -1; return; }
        int dev = 0, cus = 0;
        if (hipGetDevice(&dev) != hipSuccess || hipDeviceGetAttribute(&cus, hipDeviceAttributeMultiprocessorCount, dev) != hipSuccess) { grid = -1; return; }
#if MK_ONE_LAUNCH
        if (hipFuncSetAttribute((const void*)mk_fwd, hipFuncAttributeMaxDynamicSharedMemorySize, LDS_BYTES) != hipSuccess) { fprintf(stderr, "kernel_launch: hipFuncSetAttribute failed\n"); grid = -1; return; }
#endif
        (void)hipGetLastError();
        grid = cus;
        if (grid != 256) fprintf(stderr, "kernel_launch: %d CUs; the residual GEMM phases need exactly 256 workgroups\n", grid);
    }
    if (grid < 0) return;
    (void)hipMemsetAsync((char*)d_ws + WS_CTL, 0, CTL_ZERO_BYTES, stream);
    Args a{};
    for (int i = 0; i < 26; ++i) a.in[i] = (const float*)d_in[i];
    a.out = (float*)d_out; a.ws = (unsigned char*)d_ws;
#if MK_ONE_LAUNCH
    a.ph_lo = 0; a.ph_hi = N_PHASES;
    hipLaunchKernelGGL(mk_fwd, dim3(grid), dim3(NWAVES * 64), LDS_BYTES, stream, a);
#else
    for (int ph = 0; ph < N_PHASES; ++ph) { a.ph_lo = ph; a.ph_hi = ph + 1;
        switch (phase_kind(ph)) {
            case 0: launch_kind<0>(grid, stream, a); break;  case 1: launch_kind<1>(grid, stream, a); break;  case 2: launch_kind<2>(grid, stream, a); break;
            case 4: launch_kind<4>(grid, stream, a); launch_kind<12>(grid, stream, a); break;
            case 6: launch_kind<6>(grid, stream, a); break;  case 7: launch_kind<7>(grid, stream, a); break;  case 8: launch_kind<8>(grid, stream, a); break;
            case 9: launch_kind<9>(grid, stream, a); break;  case 10: launch_kind<10>(grid, stream, a); break; default: launch_kind<11>(grid, stream, a); break;
        } }
#endif
}
```
